# Optimizing an MI355X kernel written in HIP

```python
import math
import jax, jax.numpy as jnp
from jax import lax
import numpy as np

D_MODEL = 1024
BATCH = 16
SEQ = 2048
DEPTH = 1

MEM_LEN = 256
EPS = 1e-6
ROPE_THETA = 10000.0
NEG = -1e30
ATT_HEAD_DIM = 64
ATT_SLOTS = 8
DIL_GROUPS = ((128, 1), (512, 4), (2048, 16))
N_GROUPS = 3
ATT_HEADS = ATT_SLOTS * N_GROUPS
ATT_QKV = ATT_HEADS * ATT_HEAD_DIM
ATT_OUT = ATT_SLOTS * ATT_HEAD_DIM
ML_HEADS = 4
ML_HEAD_DIM = 128
ML_WIDTH = ML_HEADS * ML_HEAD_DIM
ML_GATES = 4 * ML_HEADS
ML_CHUNK = 128
ML_CONV = 5
CX_HEADS = 4
CX_HEAD_DIM = 128
CX_WIDTH = CX_HEADS * CX_HEAD_DIM
N_BRANCH = 3
N_IN = 3 * ATT_QKV + 4 * ML_WIDTH + ML_GATES + CX_WIDTH + N_BRANCH * D_MODEL
D_FF = 2816

kernel_name = "hybrid_dilated_mlstm_memxattn_block"


def rmsnorm(x, g):
    xf = x.astype(jnp.float32)
    y = xf * lax.rsqrt(jnp.mean(xf * xf, axis=-1, keepdims=True) + EPS)
    return (y * g.astype(jnp.float32)).astype(x.dtype)


def swiglu(h, w_in, w_out):
    gate, up = jnp.split(h @ w_in, 2, axis=-1)
    return (jax.nn.silu(gate) * up) @ w_out


def rope(x):
    s, d = x.shape[1], x.shape[-1]
    inv = ROPE_THETA ** (-jnp.arange(0, d, 2, dtype=jnp.float32) / d)
    ang = jnp.arange(s, dtype=jnp.float32)[:, None] * inv[None, :]
    cos = jnp.cos(ang)[None, :, None, :]
    sin = jnp.sin(ang)[None, :, None, :]
    xf = x.astype(jnp.float32)
    x1, x2 = jnp.split(xf, 2, axis=-1)
    return jnp.concatenate([x1 * cos - x2 * sin, x2 * cos + x1 * sin], axis=-1).astype(x.dtype)


def banded_attention(q, k, v, radius):
    blk = radius
    n, d = q.shape[-2], q.shape[-1]
    lead = q.shape[:-2]
    nb = -(-n // blk)
    npad = nb * blk
    zl = [(0, 0)] * len(lead)
    qb = jnp.pad(q, zl + [(0, npad - n), (0, 0)]).reshape(*lead, nb, blk, d)
    kp = jnp.pad(k, zl + [(blk, npad - n + blk), (0, 0)]).reshape(*lead, nb + 2, blk, d)
    vp = jnp.pad(v, zl + [(blk, npad - n + blk), (0, 0)]).reshape(*lead, nb + 2, blk, d)
    kw = jnp.concatenate([kp[..., 0:nb, :, :], kp[..., 1:nb + 1, :, :], kp[..., 2:nb + 2, :, :]], axis=-2)
    vw = jnp.concatenate([vp[..., 0:nb, :, :], vp[..., 1:nb + 1, :, :], vp[..., 2:nb + 2, :, :]], axis=-2)
    s = jnp.einsum('...nqd,...nkd->...nqk', qb, kw).astype(jnp.float32)
    qpos = jnp.arange(nb)[:, None] * blk + jnp.arange(blk)[None, :]
    kpos = jnp.arange(nb)[:, None] * blk - blk + jnp.arange(3 * blk)[None, :]
    valid = ((jnp.abs(qpos[:, :, None] - kpos[:, None, :]) <= radius)
             & (kpos[:, None, :] >= 0) & (kpos[:, None, :] < n))
    s = jnp.where(valid, s, NEG)
    m = jnp.max(s, axis=-1, keepdims=True)
    p = jnp.exp(s - m)
    l = jnp.sum(p, axis=-1)
    out = jnp.einsum('...nqk,...nkd->...nqd', p.astype(v.dtype), vw).astype(jnp.float32) / l[..., None]
    lse = m[..., 0] + jnp.log(l)
    out = out.reshape(*lead, npad, d)[..., :n, :]
    lse = lse.reshape(*lead, npad)[..., :n]
    return out, lse


def dilated_attention(q, k, v):
    b, s, _, d = q.shape
    outs, lses = [], []
    for g, (w, r) in enumerate(DIL_GROUPS):
        sl = slice(g * ATT_SLOTS, (g + 1) * ATT_SLOTS)

        def to_res(t):
            return t[:, :, sl].reshape(b, s // r, r, ATT_SLOTS, d).transpose(0, 3, 2, 1, 4)

        o, lse = banded_attention(to_res(q), to_res(k), to_res(v), (w // 2) // r)
        outs.append(o.transpose(0, 3, 2, 1, 4).reshape(b, s, ATT_SLOTS, d))
        lses.append(lse.transpose(0, 3, 2, 1).reshape(b, s, ATT_SLOTS))
    alpha = jax.nn.softmax(jnp.stack(lses, axis=0), axis=0)
    out = jnp.sum(alpha[..., None] * jnp.stack(outs, axis=0), axis=0)
    return out.reshape(b, s, ATT_OUT)


def centred_dwconv(x, w, bias):
    c = x.shape[-1]
    y = lax.conv_general_dilated(x, w[:, None, :].astype(x.dtype), window_strides=(1,), padding='SAME',
                                 dimension_numbers=('NWC', 'WIO', 'NWC'), feature_group_count=c)
    return y + bias.astype(x.dtype)


def mlstm_chunkwise(q, k, v, log_i, log_f):
    b, h, s, d = q.shape
    L = ML_CHUNK
    nc = s // L
    chunk = lambda t: jnp.moveaxis(t.reshape(b, h, nc, L, *t.shape[3:]), 2, 0)
    tril = jnp.tril(jnp.ones((L, L), dtype=bool))

    def step(carry, xs):
        C, n, m = carry
        qc, kc, vc, li, lf = xs
        bcum = jnp.cumsum(lf, axis=-1)
        gtot = bcum[..., -1]
        dmat = jnp.where(tril, bcum[..., :, None] - bcum[..., None, :] + li[..., None, :], NEG)
        inter = bcum + m[..., None]
        mt = jnp.maximum(jnp.max(dmat, axis=-1), inter)
        wts = jnp.exp(dmat - mt[..., None])
        w_inter = jnp.exp(inter - mt)
        sc = jnp.einsum('bhtd,bhsd->bhts', qc, kc) * wts
        num = jnp.einsum('bhts,bhsd->bhtd', sc, vc) + w_inter[..., None] * jnp.einsum('bhvk,bhtk->bhtv', C, qc)
        den = jnp.sum(sc, axis=-1) + w_inter * jnp.einsum('bhk,bhtk->bht', n, qc)
        hout = num / jnp.maximum(jnp.abs(den), jnp.exp(-mt))[..., None]
        a = gtot[..., None] - bcum + li
        m_new = jnp.maximum(gtot + m, jnp.max(a, axis=-1))
        decay = jnp.exp(gtot + m - m_new)
        wk = jnp.exp(a - m_new[..., None])
        C_new = decay[..., None, None] * C + jnp.einsum('bhs,bhsv,bhsk->bhvk', wk, vc, kc)
        n_new = decay[..., None] * n + jnp.einsum('bhs,bhsk->bhk', wk, kc)
        return (C_new, n_new, m_new), hout

    init = (jnp.zeros((b, h, d, d), jnp.float32), jnp.zeros((b, h, d), jnp.float32),
            jnp.zeros((b, h), jnp.float32))
    _, hs = lax.scan(step, init, (chunk(q), chunk(k), chunk(v), chunk(log_i), chunk(log_f)))
    return jnp.moveaxis(hs, 0, 2).reshape(b, h, s, d)


def setup_inputs(seed: int = 0) -> dict:
    key = jax.random.key(seed)
    ks = iter(jax.random.split(key, 32))
    f32 = jnp.float32
    nrm = lambda shape, fan_in: jax.random.normal(next(ks), shape, f32) * (fan_in ** -0.5)
    gain = lambda shape: 1.0 + 0.02 * jax.random.normal(next(ks), shape, f32)
    small = lambda shape: 0.02 * jax.random.normal(next(ks), shape, f32)
    x = jax.random.normal(next(ks), (BATCH, SEQ, D_MODEL), f32)
    mem = jax.random.normal(next(ks), (BATCH, MEM_LEN, D_MODEL), f32)
    norm_ffn1 = gain((DEPTH, D_MODEL))
    w_ffn1_in = nrm((DEPTH, D_MODEL, 2 * D_FF), D_MODEL)
    w_ffn1_out = nrm((DEPTH, D_FF, D_MODEL), D_FF)
    norm_mix = gain((DEPTH, D_MODEL))
    norm_mem = gain((DEPTH, D_MODEL))
    w_in = nrm((DEPTH, D_MODEL, N_IN), D_MODEL)
    att_q_gain = gain((DEPTH, ATT_HEAD_DIM))
    att_k_gain = gain((DEPTH, ATT_HEAD_DIM))
    ml_conv_w = nrm((DEPTH, ML_CONV, 2 * ML_WIDTH), ML_CONV)
    ml_conv_b = small((DEPTH, 2 * ML_WIDTH))
    forget_offset = (jnp.array([0.0, 1.0, 0.0, 1.0], f32)[:, None]
                     * jnp.linspace(3.0, 6.0, ML_HEADS, dtype=f32)[None, :])
    ml_gate_b = (0.1 * jax.random.normal(next(ks), (DEPTH, 4, ML_HEADS), f32)
                 + forget_offset[None]).reshape(DEPTH, ML_GATES)
    ml_out_gain = gain((DEPTH, ML_WIDTH))
    cx_q_gain = gain((DEPTH, CX_HEAD_DIM))
    cx_k_gain = gain((DEPTH, CX_HEAD_DIM))
    w_mem_kv = nrm((DEPTH, D_MODEL, 2 * CX_WIDTH), D_MODEL)
    mix_gate_b = small((DEPTH, N_BRANCH * D_MODEL))
    w_br_att = nrm((DEPTH, ATT_OUT, D_MODEL), ATT_OUT)
    w_br_ml = nrm((DEPTH, ML_WIDTH, D_MODEL), ML_WIDTH)
    w_br_cx = nrm((DEPTH, CX_WIDTH, D_MODEL), CX_WIDTH)
    w_out = nrm((DEPTH, D_MODEL, D_MODEL), D_MODEL)
    norm_ffn2 = gain((DEPTH, D_MODEL))
    w_ffn2_in = nrm((DEPTH, D_MODEL, 2 * D_FF), D_MODEL)
    w_ffn2_out = nrm((DEPTH, D_FF, D_MODEL), D_FF)
    norm_final = gain((DEPTH, D_MODEL))
    return {"x": x, "mem": mem, "norm_ffn1": norm_ffn1, "w_ffn1_in": w_ffn1_in, "w_ffn1_out": w_ffn1_out,
            "norm_mix": norm_mix, "norm_mem": norm_mem, "w_in": w_in, "att_q_gain": att_q_gain,
            "att_k_gain": att_k_gain, "ml_conv_w": ml_conv_w, "ml_conv_b": ml_conv_b, "ml_gate_b": ml_gate_b,
            "ml_out_gain": ml_out_gain, "cx_q_gain": cx_q_gain, "cx_k_gain": cx_k_gain, "w_mem_kv": w_mem_kv,
            "mix_gate_b": mix_gate_b, "w_br_att": w_br_att, "w_br_ml": w_br_ml, "w_br_cx": w_br_cx,
            "w_out": w_out, "norm_ffn2": norm_ffn2, "w_ffn2_in": w_ffn2_in, "w_ffn2_out": w_ffn2_out,
            "norm_final": norm_final}


def reference(x, mem, norm_ffn1, w_ffn1_in, w_ffn1_out, norm_mix, norm_mem, w_in, att_q_gain, att_k_gain,
              ml_conv_w, ml_conv_b, ml_gate_b, ml_out_gain, cx_q_gain, cx_k_gain, w_mem_kv, mix_gate_b,
              w_br_att, w_br_ml, w_br_cx, w_out, norm_ffn2, w_ffn2_in, w_ffn2_out, norm_final):
    b, s, dm = x.shape
    mlen = mem.shape[1]
    sizes = (ATT_QKV, ATT_QKV, ATT_QKV, ML_WIDTH, ML_WIDTH, ML_WIDTH, ML_WIDTH, ML_GATES, CX_WIDTH,
             N_BRANCH * D_MODEL)
    split_pts = np.cumsum(np.array(sizes))[:-1].tolist()
    for l in range(DEPTH):
        x = x + 0.5 * swiglu(rmsnorm(x, norm_ffn1[l]), w_ffn1_in[l], w_ffn1_out[l])
        h = rmsnorm(x, norm_mix[l])
        aq, ak, av, mq, mk, mv, mo, mif, cq, gts = jnp.split(h @ w_in[l], split_pts, axis=-1)

        ah = lambda t: t.reshape(b, s, ATT_HEADS, ATT_HEAD_DIM)
        aq = rope(rmsnorm(ah(aq), att_q_gain[l])) * (ATT_HEAD_DIM ** -0.5)
        ak = rope(rmsnorm(ah(ak), att_k_gain[l]))
        y_att = dilated_attention(aq, ak, ah(av)).astype(x.dtype)

        mqk = jax.nn.silu(centred_dwconv(jnp.concatenate([mq, mk], axis=-1), ml_conv_w[l], ml_conv_b[l]))
        mq, mk = jnp.split(mqk, 2, axis=-1)
        mh = lambda t: t.reshape(b, s, ML_HEADS, ML_HEAD_DIM).transpose(0, 2, 1, 3).astype(jnp.float32)
        q_m = mh(mq) * (ML_HEAD_DIM ** -0.5)
        k_m, v_m = mh(mk), mh(mv)
        gates = (mif + ml_gate_b[l]).astype(jnp.float32).reshape(b, s, 4, ML_HEADS).transpose(2, 0, 3, 1)
        li_f, fp_f, li_b, fp_b = gates[0], gates[1], gates[2], gates[3]
        h_f = mlstm_chunkwise(q_m, k_m, v_m, li_f, jax.nn.log_sigmoid(fp_f))
        fl = lambda t: jnp.flip(t, axis=2)
        h_b = fl(mlstm_chunkwise(fl(q_m), fl(k_m), fl(v_m), fl(li_b), fl(jax.nn.log_sigmoid(fp_b))))
        hm = (h_f + h_b).transpose(0, 2, 1, 3)
        hm = hm * lax.rsqrt(jnp.mean(hm * hm, axis=-1, keepdims=True) + EPS)
        hm = hm.reshape(b, s, ML_WIDTH) * ml_out_gain[l].astype(jnp.float32)
        y_ml = (hm * jax.nn.sigmoid(mo.astype(jnp.float32))).astype(x.dtype)

        cq = rmsnorm(cq.reshape(b, s, CX_HEADS, CX_HEAD_DIM), cx_q_gain[l]) * (CX_HEAD_DIM ** -0.5)
        ck, cv = jnp.split(rmsnorm(mem, norm_mem[l]) @ w_mem_kv[l], 2, axis=-1)
        ck = rmsnorm(ck.reshape(b, mlen, CX_HEADS, CX_HEAD_DIM), cx_k_gain[l])
        cv = cv.reshape(b, mlen, CX_HEADS, CX_HEAD_DIM)
        p = jax.nn.softmax(jnp.einsum('bqhd,bkhd->bhqk', cq, ck).astype(jnp.float32), axis=-1)
        y_cx = jnp.einsum('bhqk,bkhd->bqhd', p.astype(cv.dtype), cv).reshape(b, s, CX_WIDTH).astype(x.dtype)

        g = jax.nn.sigmoid((gts + mix_gate_b[l]).astype(jnp.float32)).astype(x.dtype).reshape(b, s, N_BRANCH, dm)
        merged = (g[:, :, 0] * (y_att @ w_br_att[l]) + g[:, :, 1] * (y_ml @ w_br_ml[l])
                  + g[:, :, 2] * (y_cx @ w_br_cx[l]))
        x = x + merged @ w_out[l]

        x = x + 0.5 * swiglu(rmsnorm(x, norm_ffn2[l]), w_ffn2_in[l], w_ffn2_out[l])
        x = rmsnorm(x, norm_final[l])
    return x
```

```cpp
#include <hip/hip_runtime.h>
#include <hip/hip_cooperative_groups.h>
#include <cstdio>
#include <cstdint>
namespace cg = cooperative_groups;

#define LAS __attribute__((address_space(3)))
#define DI __device__ __forceinline__
typedef unsigned short bf16_t;
typedef short bf16x8 __attribute__((ext_vector_type(8)));
typedef short s16x4 __attribute__((ext_vector_type(4)));
typedef float f32x4 __attribute__((ext_vector_type(4)));
typedef float f32x16 __attribute__((ext_vector_type(16)));
typedef unsigned u32x4 __attribute__((ext_vector_type(4)));
typedef unsigned u32x2 __attribute__((ext_vector_type(2)));

constexpr int T_ = 32768, TG = 16384, NGRP = 2, BL = 8, S_ = 2048, DM = 1024, DFF = 2816, MEMROWS = 4096;
constexpr int NWIN = 10496, NIN = 10256;
constexpr float EPS = 1e-6f;
constexpr float NEGF = -1e30f;

constexpr size_t MiB = 1u << 20;
constexpr size_t WS_CTL = 0;
constexpr size_t WS_W1 = 1 * MiB, WS_W2 = 12 * MiB, WS_WIN = 18 * MiB, WS_WMEM = 39 * MiB, WS_WBR = 41 * MiB, WS_WOUT = 44 * MiB, WS_W3 = 46 * MiB, WS_W4 = 57 * MiB;
constexpr size_t WS_ROPE = 63 * MiB;
constexpr size_t WS_SSM = 63 * MiB + 512 * 1024;
constexpr size_t WS_PART = 64 * MiB;
constexpr size_t SS_STRIDE = 131072;
constexpr size_t WS_CKV = 66 * MiB;
constexpr size_t WS_XB = 74 * MiB;
constexpr size_t WS_ACT = 138 * MiB;
constexpr size_t WS_AQ = 138 * MiB, WS_AK = 186 * MiB, WS_AV = 234 * MiB;
constexpr size_t WS_MQ = 282 * MiB;
constexpr size_t WS_MK = 298 * MiB, WS_MV = 314 * MiB, WS_MO = 330 * MiB, WS_CQ = 346 * MiB;
constexpr size_t WS_GTS = 362 * MiB;
constexpr size_t WS_MIF = 458 * MiB;
constexpr size_t WS_LSE = 459 * MiB;
constexpr size_t WS_HF = 461 * MiB, WS_HB = 477 * MiB;
constexpr size_t WS_MEMB = 400 * MiB;
constexpr size_t WS_YATT = 186 * MiB, WS_YML = 202 * MiB;
constexpr size_t WS_M32 = 234 * MiB;
constexpr size_t WS_MB16 = 298 * MiB;
constexpr size_t WS_END = 493 * MiB;

constexpr int LDS_BYTES = 147456;
constexpr int TB_OFF = 131072;

DI unsigned pkbf(float lo, float hi) {
    typedef float f2 __attribute__((ext_vector_type(2))); typedef __bf16 b2 __attribute__((ext_vector_type(2)));
    f2 v = {lo, hi}; b2 b = __builtin_convertvector(v, b2); return __builtin_bit_cast(unsigned, b);
}
DI float bflo(unsigned u) { return __uint_as_float(u << 16); }
DI float bfhi(unsigned u) { return __uint_as_float(u & 0xffff0000u); }
DI float wave_sum(float v) {
#pragma unroll
    for (int o = 1; o < 64; o <<= 1) v += __shfl_xor(v, o);
    return v;
}
DI int crow(int i, int h) { return (i & 3) + 8 * (i >> 2) + 4 * h; }
DI f32x16 mfma32(bf16x8 a, bf16x8 b, f32x16 c) { return __builtin_amdgcn_mfma_f32_32x32x16_bf16(a, b, c, 0, 0, 0); }
DI bf16x8 pack8(const f32x16& x, int s) {
    u32x4 p;
    p.x = pkbf(x[8 * s + 0], x[8 * s + 1]); p.y = pkbf(x[8 * s + 2], x[8 * s + 3]);
    p.z = pkbf(x[8 * s + 4], x[8 * s + 5]); p.w = pkbf(x[8 * s + 6], x[8 * s + 7]);
    return __builtin_bit_cast(bf16x8, p);
}
DI f32x16 zero16() { f32x16 z; for (int i = 0; i < 16; ++i) z[i] = 0.f; return z; }
typedef short v4i16_t __attribute__((ext_vector_type(4)));
DI s16x4 trread(LAS unsigned char* p) { return __builtin_bit_cast(s16x4, __builtin_amdgcn_ds_read_tr16_b64_v4i16((LAS v4i16_t*)p)); }
DI bf16x8 cat44(s16x4 lo, s16x4 hi) { return (bf16x8){lo[0], lo[1], lo[2], lo[3], hi[0], hi[1], hi[2], hi[3]}; }
#define LDS_FENCE() asm volatile("s_waitcnt lgkmcnt(0)" ::: "memory")
DI float rstd_part(const float* part, int row) { return 1.0f / sqrtf(part[row] * (1.0f / 1024.0f) + EPS); }
#define MEMFENCE() asm volatile("" ::: "memory")
DI float sigmoidf_(float v) { return 1.0f / (1.0f + __expf(-v)); }

struct KP {
    const float* x; const float* mem; const float* norm_ffn1; const float* w_ffn1_in; const float* w_ffn1_out;
    const float* norm_mix; const float* norm_mem; const float* w_in; const float* att_q_gain; const float* att_k_gain;
    const float* ml_conv_w; const float* ml_conv_b; const float* ml_gate_b; const float* ml_out_gain;
    const float* cx_q_gain; const float* cx_k_gain; const float* w_mem_kv; const float* mix_gate_b;
    const float* w_br_att; const float* w_br_ml; const float* w_br_cx; const float* w_out;
    const float* norm_ffn2; const float* w_ffn2_in; const float* w_ffn2_out; const float* norm_final;
    float* out; unsigned char* ws;
};
typedef const KP __attribute__((address_space(4)))* KPC;

namespace pg8 {
constexpr int BM = 256, BK = 64, HALF = 128, HTB = HALF * BK * 2, STAGE_BYTES = 8 * HTB, NXCD = 8, WGM = 8;
DI int lds_byte(int r, int c) { const int st = (r >> 4) * 2 + (c >> 5), rr = r & 15, cc = c & 31, ob = rr * 64 + cc * 2; return st * 1024 + (ob ^ (((ob >> 9) & 1) << 5)); }
DI void stage_rc(int b, int& R, int& C) { const int st = b / 1024, sb = b % 1024, swz = sb ^ (((sb >> 9) & 1) << 5); R = (st >> 1) * 16 + swz / 64; C = (st & 1) * 32 + (swz % 64) / 2; }
DI int perm32(int rho) { const int n = rho >> 4, i = rho & 15; return 8 * (i >> 2) + 4 * n + (i & 3); }
struct Unit { int pm, pn; };
struct Gemm { const bf16_t* A; const bf16_t* Bt; int M, N, K; };
struct StaticOrder {
    int nM, nN, nwg, G, c;
    DI void init(int M, int N, int G_, int c_) { nM = M / BM; nN = N / BM; nwg = nM * nN; G = G_; c = c_; }
    DI bool next(int i, Unit& u) const {
        const long L = (long)i * G + c; if (L >= nwg) return false;
        int wgid = (int)L; { const int q = nwg / NXCD, r = nwg % NXCD, xcd = wgid % NXCD, off = wgid / NXCD; wgid = (xcd < r ? xcd * (q + 1) : r * (q + 1) + (xcd - r) * q) + off; }
        const int nig = WGM * nN, gid = wgid / nig, fm = gid * WGM, gsz = (nM - fm) < WGM ? (nM - fm) : WGM;
        u.pm = fm + ((wgid % nig) % gsz); u.pn = (wgid % nig) / gsz; return true;
    }
};
template <class Epi>
DI void gemm_phase(LAS unsigned char* lds, const Gemm g, const StaticOrder& S, const Epi& E, const bool perm, const int tid) {
    const int wid = __builtin_amdgcn_readfirstlane(tid >> 6), lane = tid & 63, wr = wid >> 2, wc = wid & 3, fr = lane & 15, fq = lane >> 4;
    const int K = g.K, nt = K / BK;
    unsigned voffA[2], voffB[2];
#pragma unroll
    for (int i = 0; i < 2; ++i) { int R, C; stage_rc(tid * 16 + i * 8192, R, C); const int Rb = perm ? ((R & ~31) + perm32(R & 31)) : R;
        voffA[i] = (unsigned)(R * K + C) * 2u; voffB[i] = (unsigned)(Rb * K + C) * 2u; }
    const size_t kstep = (size_t)(BK * 2);
    const size_t hstep = (size_t)HALF * K * 2;
    const size_t tstep = 2 * hstep;
    const unsigned ldsw = (unsigned)wid * 1024u;
    const int aoff = lds_byte(wr * 64 + fr, fq * 8), boff = lds_byte(wc * 32 + fr, fq * 8);
#define PG8_SA(b, h) (((b) * 2 + (h)) * HTB)
#define PG8_SB(b, h) ((4 + (b) * 2 + (h)) * HTB)
#define PG8_STAGE(bufoff, gbase, voff) do { _Pragma("unroll") for (int _i = 0; _i < 2; ++_i) \
        __builtin_amdgcn_global_load_lds((const unsigned*)((const char*)(gbase) + (voff)[_i]), (LAS unsigned*)(lds + (bufoff) + ldsw + _i * 8192), 16, 0, 0); } while (0)
#define PG8_LDA(dst, b, h) do { _Pragma("unroll") for (int m = 0; m < 4; ++m) _Pragma("unroll") for (int k = 0; k < 2; ++k) dst[m][k] = *(const LAS bf16x8*)(lds + PG8_SA(b, h) + aoff + m * 2048 + k * 1024); } while (0)
#define PG8_LDB(dst, b, h) do { _Pragma("unroll") for (int n = 0; n < 2; ++n) _Pragma("unroll") for (int k = 0; k < 2; ++k) dst[n][k] = *(const LAS bf16x8*)(lds + PG8_SB(b, h) + boff + n * 2048 + k * 1024); } while (0)
#define PG8_MMA(ai, bj, At, Bt) do { __builtin_amdgcn_s_setprio(1); _Pragma("unroll") for (int m = 0; m < 4; ++m) _Pragma("unroll") for (int n = 0; n < 2; ++n) _Pragma("unroll") for (int k = 0; k < 2; ++k) \
        acc[ai][bj][m][n] = __builtin_amdgcn_mfma_f32_16x16x32_bf16(Bt[n][k], At[m][k], acc[ai][bj][m][n], 0, 0, 0); __builtin_amdgcn_s_setprio(0); } while (0)
#define PG8_WAIT_V(n) asm volatile("s_waitcnt vmcnt(" #n ")" ::: "memory")
#define PG8_WAIT_L(n) asm volatile("s_waitcnt lgkmcnt(" #n ")" ::: "memory")
#define PG8_BAR __builtin_amdgcn_s_barrier()
#define PG8_SCHED __builtin_amdgcn_sched_barrier(0)
    Unit cur, nxt; int ui = 0;
    if (!S.next(0, cur)) return;
    f32x4 acc[2][2][4][2];
#pragma unroll
    for (int a = 0; a < 2; ++a)
#pragma unroll
        for (int b = 0; b < 2; ++b)
#pragma unroll
            for (int m = 0; m < 4; ++m)
#pragma unroll
                for (int n = 0; n < 2; ++n) acc[a][b][m][n] = (f32x4){0.f, 0.f, 0.f, 0.f};
    bf16x8 At[4][2], B0[2][2], B1[2][2];
    const char* cA = (const char*)g.A + (size_t)cur.pm * tstep; const char* cB = (const char*)g.Bt + (size_t)cur.pn * tstep;
    {
        PG8_STAGE(PG8_SB(0, 0), cB, voffB); PG8_STAGE(PG8_SB(0, 1), cB + hstep, voffB); PG8_STAGE(PG8_SA(0, 0), cA, voffA); PG8_STAGE(PG8_SA(0, 1), cA + hstep, voffA);
        if (wr == 1) PG8_BAR;
        PG8_WAIT_V(2); PG8_BAR;
        PG8_STAGE(PG8_SB(1, 0), cB + kstep, voffB); PG8_STAGE(PG8_SA(1, 0), cA + kstep, voffA); PG8_STAGE(PG8_SB(1, 1), cB + hstep + kstep, voffB);
        PG8_WAIT_V(6); PG8_BAR;
    }
    for (;;) {
        const bool has_next = S.next(ui + 1, nxt);
        const char* nA = has_next ? (const char*)g.A + (size_t)nxt.pm * tstep : cA; const char* nB = has_next ? (const char*)g.Bt + (size_t)nxt.pn * tstep : cB;
        for (int t = 0; t < nt; t += 2) {
            const bool last = (t == nt - 2);
            const char* a1 = cA + (size_t)(t + 1) * kstep;
            const char* a2 = last ? nA : cA + (size_t)(t + 2) * kstep; const char* b2 = last ? nB : cB + (size_t)(t + 2) * kstep;
            const char* a3 = a2 + kstep; const char* b3 = b2 + kstep;
            PG8_LDB(B0, 0, 0); PG8_LDB(B1, 0, 1); PG8_SCHED; PG8_LDA(At, 0, 0); PG8_STAGE(PG8_SA(1, 1), a1 + hstep, voffA);
            PG8_WAIT_V(8); PG8_WAIT_L(0); PG8_BAR; PG8_MMA(0, 0, At, B0); PG8_MMA(0, 1, At, B1); PG8_BAR; PG8_SCHED;
            PG8_LDA(At, 0, 1); PG8_STAGE(PG8_SB(0, 0), b2, voffB); PG8_STAGE(PG8_SB(0, 1), b2 + hstep, voffB); PG8_STAGE(PG8_SA(0, 0), a2, voffA);
            PG8_WAIT_V(8); PG8_WAIT_L(0); PG8_BAR; PG8_MMA(1, 0, At, B0); PG8_MMA(1, 1, At, B1); PG8_BAR; PG8_SCHED;
            PG8_LDB(B0, 1, 0); PG8_LDB(B1, 1, 1); PG8_SCHED; PG8_LDA(At, 1, 0); PG8_STAGE(PG8_SA(0, 1), a2 + hstep, voffA);
            PG8_WAIT_V(8); PG8_WAIT_L(0); PG8_BAR; PG8_MMA(0, 0, At, B0); PG8_MMA(0, 1, At, B1); PG8_BAR; PG8_SCHED;
            PG8_LDA(At, 1, 1); PG8_STAGE(PG8_SB(1, 0), b3, voffB); PG8_STAGE(PG8_SB(1, 1), b3 + hstep, voffB); PG8_STAGE(PG8_SA(1, 0), a3, voffA);
            PG8_WAIT_V(8); PG8_WAIT_L(0); PG8_BAR; PG8_MMA(1, 0, At, B0); PG8_MMA(1, 1, At, B1); PG8_BAR; PG8_SCHED;
        }
        if (wr == 0) PG8_BAR;
        E(acc, cur, wr, wc, fr, fq);
        if (!has_next) break;
#pragma unroll
        for (int a = 0; a < 2; ++a)
#pragma unroll
            for (int b = 0; b < 2; ++b)
#pragma unroll
                for (int m = 0; m < 4; ++m)
#pragma unroll
                    for (int n = 0; n < 2; ++n) acc[a][b][m][n] = (f32x4){0.f, 0.f, 0.f, 0.f};
        cur = nxt; cA = nA; cB = nB; ++ui;
        if (wr == 1) PG8_BAR;
    }
    PG8_WAIT_V(0);
    PG8_BAR;
#undef PG8_SA
#undef PG8_SB
#undef PG8_STAGE
#undef PG8_LDA
#undef PG8_LDB
#undef PG8_MMA
#undef PG8_WAIT_V
#undef PG8_WAIT_L
#undef PG8_BAR
#undef PG8_SCHED
}
}

enum EpiKind { EK_SWIGLU = 0, EK_RESID = 1, EK_WIN = 2, EK_MEMKV = 3, EK_BR0 = 4, EK_BR1 = 5, EK_BR2 = 6 };
typedef const f32x4 (&AccRef)[2][2][4][2];

struct EpiAny {
    int kind, aux, goff;
    unsigned char* ws; KPC kp;

    DI void swiglu(AccRef acc, const pg8::Unit& u, int wr, int wc, int fr, int fq) const {
        const int row0 = u.pm * 256 + wr * 64 + fr, col = u.pn * 128 + wc * 32 + 8 * fq;
        const float* part = (const float*)(ws + WS_PART + (aux ? 2 * SS_STRIDE : 0)); bf16_t* xb = (bf16_t*)(ws + WS_ACT);
#pragma unroll
        for (int ai = 0; ai < 2; ++ai)
#pragma unroll
            for (int m = 0; m < 4; ++m) {
                const int row = row0 + ai * 128 + m * 16; const float rs = rstd_part(part, row);
                float o[8];
#pragma unroll
                for (int n = 0; n < 2; ++n)
#pragma unroll
                    for (int j = 0; j < 4; ++j) { const float gt = acc[ai][0][m][n][j] * rs, up = acc[ai][1][m][n][j] * rs; o[4 * n + j] = gt * sigmoidf_(gt) * up; }
                u32x4 w; w.x = pkbf(o[0], o[1]); w.y = pkbf(o[2], o[3]); w.z = pkbf(o[4], o[5]); w.w = pkbf(o[6], o[7]);
                *(u32x4*)(xb + (size_t)row * DFF + col) = w;
                MEMFENCE();
            }
    }
    DI void residual(AccRef acc, const pg8::Unit& u, int wr, int wc, int fr, int fq) const {
        const int row0 = goff + u.pm * 256 + wr * 64 + fr, c0 = u.pn * 256 + wc * 32 + 4 * fq;
        const float* resid = aux == 0 ? kp->x : kp->out; float* outf = kp->out; bf16_t* xb = (bf16_t*)(ws + WS_XB);
        float* partw = (float*)(ws + WS_PART + (size_t)(aux + 1) * SS_STRIDE); const float scale = aux == 1 ? 1.0f : 0.5f;
#pragma unroll
        for (int ai = 0; ai < 2; ++ai)
#pragma unroll
            for (int m = 0; m < 4; ++m) {
                const int row = row0 + ai * 128 + m * 16; float ssq = 0.f;
#pragma unroll
                for (int bj = 0; bj < 2; ++bj)
#pragma unroll
                    for (int n = 0; n < 2; ++n) {
                        const size_t off = (size_t)row * DM + c0 + bj * 128 + n * 16;
                        const f32x4 r = *(const f32x4*)(resid + off); const f32x4 v = r + acc[ai][bj][m][n] * scale;
                        *(f32x4*)(outf + off) = v; u32x2 w; w.x = pkbf(v.x, v.y); w.y = pkbf(v.z, v.w); *(u32x2*)(xb + off) = w;
                        ssq += (v.x * v.x + v.y * v.y) + (v.z * v.z + v.w * v.w);
                    }
                ssq += __shfl_xor(ssq, 16); ssq += __shfl_xor(ssq, 32);
                if (fq == 0) unsafeAtomicAdd(partw + row, ssq);
                MEMFENCE();
            }
    }
    DI void memkv(AccRef acc, const pg8::Unit& u, int wr, int wc, int fr, int fq) const {
        const int row0 = u.pm * 256 + wr * 64 + fr, c0 = u.pn * 256 + wc * 32 + 8 * fq;
        const float* part = (const float*)(ws + WS_SSM); bf16_t* xb = (bf16_t*)(ws + WS_CKV);
#pragma unroll
        for (int ai = 0; ai < 2; ++ai)
#pragma unroll
            for (int m = 0; m < 4; ++m) {
                const int row = row0 + ai * 128 + m * 16; const float rs = 1.0f / sqrtf(part[row] * (1.0f / 1024.0f) + EPS);
#pragma unroll
                for (int bj = 0; bj < 2; ++bj) {
                    const f32x4 a = acc[ai][bj][m][0] * rs, b = acc[ai][bj][m][1] * rs;
                    u32x4 w; w.x = pkbf(a.x, a.y); w.y = pkbf(a.z, a.w); w.z = pkbf(b.x, b.y); w.w = pkbf(b.z, b.w);
                    *(u32x4*)(xb + (size_t)row * 1024 + c0 + bj * 128) = w;
                }
            }
    }
    template <int B> DI void branch(AccRef acc, const pg8::Unit& u, int wr, int wc, int fr, int fq) const {
        const int row0 = u.pm * 256 + wr * 64 + fr, c0 = u.pn * 256 + wc * 32 + 4 * fq;
        const bf16_t* gts = (const bf16_t*)(ws + WS_GTS); float* m32 = (float*)(ws + WS_M32); bf16_t* mb16 = (bf16_t*)(ws + WS_MB16);
#pragma unroll
        for (int bj = 0; bj < 2; ++bj)
#pragma unroll
            for (int n = 0; n < 2; ++n) {
                const int col = c0 + bj * 128 + n * 16;
                const f32x4 gb = *(const f32x4*)(kp->mix_gate_b + B * 1024 + col);
#pragma unroll
                for (int ai = 0; ai < 2; ++ai)
#pragma unroll
                    for (int m = 0; m < 4; ++m) {
                        const int row = row0 + ai * 128 + m * 16;
                        const u32x2 gw = *(const u32x2*)(gts + (size_t)row * 3072 + B * 1024 + col);
                        f32x4 gv; gv.x = sigmoidf_(bflo(gw.x) + gb.x); gv.y = sigmoidf_(bfhi(gw.x) + gb.y); gv.z = sigmoidf_(bflo(gw.y) + gb.z); gv.w = sigmoidf_(bfhi(gw.y) + gb.w);
                        f32x4 v = gv * acc[ai][bj][m][n];
                        const size_t off = (size_t)row * DM + col;
                        if (B > 0) v = v + *(const f32x4*)(m32 + off);
                        if (B < 2) *(f32x4*)(m32 + off) = v;
                        else { u32x2 w; w.x = pkbf(v.x, v.y); w.y = pkbf(v.z, v.w); *(u32x2*)(mb16 + off) = w; }
                        if (m & 1) MEMFENCE();
                    }
            }
    }
    DI void win(AccRef acc, const pg8::Unit& u, int wr, int wc, int fr, int fq) const {
        const int row0 = u.pm * 256 + wr * 64 + fr; const int pn = u.pn;
        const float* part = (const float*)(ws + WS_PART + SS_STRIDE) + goff;
        if (pn < 12) {
            const int isk = pn >= 6 ? 1 : 0; const int hh = 4 * (pn - 6 * isk) + wc; const int gi = hh >> 3, sh = 2 * gi;
            const float* gain = isk ? kp->att_k_gain : kp->att_q_gain; const float qs = isk ? 1.0f : 0.125f;
            bf16_t* dst = (bf16_t*)(ws + (isk ? WS_AK : WS_AQ));
            const float* rc = (const float*)(ws + WS_ROPE); const float* rsn = rc + 2048 * 32;
#pragma unroll
            for (int ai = 0; ai < 2; ++ai)
#pragma unroll
                for (int m = 0; m < 4; ++m) {
                    const int row = row0 + ai * 128 + m * 16; const float rs = rstd_part(part, row);
                    const int bl = row >> 11, s = row & 2047;
                    float ss = 0.f;
#pragma unroll
                    for (int bj = 0; bj < 2; ++bj)
#pragma unroll
                        for (int n = 0; n < 2; ++n) { const f32x4 v = acc[ai][bj][m][n]; ss += (v.x * v.x + v.y * v.y) + (v.z * v.z + v.w * v.w); }
                    ss *= rs * rs;
                    ss += __shfl_xor(ss, 16); ss += __shfl_xor(ss, 32);
                    const float rh = rs * qs / sqrtf(ss * (1.0f / 64.0f) + EPS);
                    const int perm = ((s & ((1 << sh) - 1)) << (11 - sh)) + (s >> sh);
                    bf16_t* d = dst + ((size_t)(bl * 24 + hh) * 2048 + perm) * 64 + 8 * fq;
#pragma unroll
                    for (int n = 0; n < 2; ++n) {
                        const f32x4 ga = *(const f32x4*)(gain + 8 * fq + 4 * n), gb = *(const f32x4*)(gain + 32 + 8 * fq + 4 * n);
                        const f32x4 c = *(const f32x4*)(rc + s * 32 + 8 * fq + 4 * n), sn = *(const f32x4*)(rsn + s * 32 + 8 * fq + 4 * n);
                        const f32x4 v1 = acc[ai][0][m][n] * ga * rh, v2 = acc[ai][1][m][n] * gb * rh;
                        const f32x4 o1 = v1 * c - v2 * sn, o2 = v2 * c + v1 * sn;
                        u32x2 w1; w1.x = pkbf(o1.x, o1.y); w1.y = pkbf(o1.z, o1.w);
                        u32x2 w2; w2.x = pkbf(o2.x, o2.y); w2.y = pkbf(o2.z, o2.w);
                        *(u32x2*)(d + 4 * n) = w1; *(u32x2*)(d + 32 + 4 * n) = w2;
                        MEMFENCE();
                    }
                }
        } else if (pn < 18) {
            bf16_t* dst = (bf16_t*)(ws + WS_AV);
#pragma unroll
            for (int bj = 0; bj < 2; ++bj) {
                const int hh = 4 * (pn - 12) + 2 * bj + (wc >> 1), d0 = 32 * (wc & 1) + 8 * fq; const int gi = hh >> 3, sh = 2 * gi;
#pragma unroll
                for (int ai = 0; ai < 2; ++ai)
#pragma unroll
                    for (int m = 0; m < 4; ++m) {
                        const int row = row0 + ai * 128 + m * 16; const float rs = rstd_part(part, row);
                        const int bl = row >> 11, s = row & 2047;
                        const int perm = ((s & ((1 << sh) - 1)) << (11 - sh)) + (s >> sh);
                        const f32x4 a = acc[ai][bj][m][0] * rs, b = acc[ai][bj][m][1] * rs;
                        u32x4 w; w.x = pkbf(a.x, a.y); w.y = pkbf(a.z, a.w); w.z = pkbf(b.x, b.y); w.w = pkbf(b.z, b.w);
                        *(u32x4*)(dst + ((size_t)(bl * 24 + hh) * 2048 + perm) * 64 + d0) = w;
                        if (m & 1) MEMFENCE();
                    }
            }
        } else if (pn < 40) {
            bf16_t* dst; int ld, colt;
            if (pn < 28) { const int seg = (pn - 18) >> 1; dst = (bf16_t*)(ws + WS_MQ) + (size_t)seg * TG * 512; ld = 512; colt = 256 * ((pn - 18) & 1); }
            else { dst = (bf16_t*)(ws + WS_GTS); ld = 3072; colt = 256 * (pn - 28); }
            const int c0 = colt + wc * 32 + 8 * fq;
#pragma unroll
            for (int ai = 0; ai < 2; ++ai)
#pragma unroll
                for (int m = 0; m < 4; ++m) {
                    const int row = row0 + ai * 128 + m * 16; const float rs = rstd_part(part, row);
#pragma unroll
                    for (int bj = 0; bj < 2; ++bj) {
                        const f32x4 a = acc[ai][bj][m][0] * rs, b = acc[ai][bj][m][1] * rs;
                        u32x4 w; w.x = pkbf(a.x, a.y); w.y = pkbf(a.z, a.w); w.z = pkbf(b.x, b.y); w.w = pkbf(b.z, b.w);
                        *(u32x4*)(dst + (size_t)row * ld + c0 + bj * 128) = w;
                    }
                    if (m & 1) MEMFENCE();
                }
        } else {
            if (wc == 0 && fq < 2) {
                float* dst = (float*)(ws + WS_MIF);
#pragma unroll
                for (int ai = 0; ai < 2; ++ai)
#pragma unroll
                    for (int m = 0; m < 4; ++m) {
                        const int row = row0 + ai * 128 + m * 16; const float rs = rstd_part(part, row);
                        *(f32x4*)(dst + (size_t)row * 16 + 8 * fq) = acc[ai][0][m][0] * rs;
                        *(f32x4*)(dst + (size_t)row * 16 + 8 * fq + 4) = acc[ai][0][m][1] * rs;
                    }
            }
        }
    }
    DI void operator()(AccRef acc, const pg8::Unit& u, int wr, int wc, int fr, int fq) const {
        asm volatile("" : "+v"(fr), "+v"(fq));
        switch (kind) {
#ifndef NO_E0
            case EK_SWIGLU: swiglu(acc, u, wr, wc, fr, fq); break;
#endif
#ifndef NO_E1
            case EK_RESID: residual(acc, u, wr, wc, fr, fq); break;
#endif
#ifndef NO_E2
            case EK_WIN: win(acc, u, wr, wc, fr, fq); break;
#endif
#ifndef NO_E3
            case EK_MEMKV: memkv(acc, u, wr, wc, fr, fq); break;
#endif
#ifndef NO_E4
            case EK_BR0: branch<0>(acc, u, wr, wc, fr, fq); break;
            case EK_BR1: branch<1>(acc, u, wr, wc, fr, fq); break;
            default: branch<2>(acc, u, wr, wc, fr, fq); break;
#else
            default: break;
#endif
        }
    }
};

DI void tr_item(const float* __restrict__ W, int ldw, int src0, int nvalid, const float* __restrict__ gain,
                bf16_t* Bt, int K, int n0, int k0, LAS float* scr, int lane) {
    const int nn = lane & 31;
#pragma unroll 8
    for (int i = 0; i < 32; ++i) {
        const int kk = 2 * i + (lane >> 5); float v = 0.f;
        if (nn < nvalid) { v = W[(size_t)(k0 + kk) * ldw + src0 + nn]; if (gain) v *= gain[k0 + kk]; }
        scr[kk * 33 + nn] = v;
    }
    LDS_FENCE();
    const int c = lane & 7;
#pragma unroll
    for (int j = 0; j < 4; ++j) {
        const int n = (lane >> 3) + 8 * j; const LAS float* s = scr + (8 * c) * 33 + n;
        u32x4 o; o.x = pkbf(s[0 * 33], s[1 * 33]); o.y = pkbf(s[2 * 33], s[3 * 33]); o.z = pkbf(s[4 * 33], s[5 * 33]); o.w = pkbf(s[6 * 33], s[7 * 33]);
        *(u32x4*)(Bt + (size_t)(n0 + n) * K + k0 + 8 * c) = o;
    }
    LDS_FENCE();
}
DI void ffn_map(int n0, int& src0) { const int pn = n0 >> 8, bj = (n0 >> 7) & 1, i0 = n0 & 127; src0 = bj * DFF + 128 * pn + i0; }
DI void win_map(int n0, int& src0, int& nvalid) {
    const int pn = n0 >> 8, within = n0 & 255, bj = within >> 7, wc = (within >> 5) & 3; nvalid = 32;
    if (pn < 12) { const int seg = pn >= 6 ? 1 : 0; const int hh = 4 * (pn - 6 * seg) + wc; src0 = seg * 1536 + 64 * hh + 32 * bj; }
    else if (pn < 18) src0 = 3072 + (n0 - 12 * 256);
    else if (pn < 26) src0 = 4608 + (n0 - 18 * 256);
    else if (pn < 28) src0 = 6672 + (n0 - 26 * 256);
    else if (pn < 40) src0 = 7184 + (n0 - 28 * 256);
    else { src0 = 6656; nvalid = (n0 == 10240) ? 16 : 0; }
}
DI void prepass(KPC P, LAS unsigned char* lds, int gw, int NGW, int wave, int lane) {
    LAS float* scr = (LAS float*)(lds + wave * 16384);
    unsigned char* ws = P->ws;
    constexpr int I1 = 16 * 176, I2 = 44 * 32, I3 = 16 * 328, I4 = 16 * 32, I5 = 8 * 32, I6 = 16 * 32;
    constexpr int NIT = I1 + I2 + I3 + I4 + 3 * I5 + I6 + I1 + I2;
    for (int it = gw; it < NIT; it += NGW) {
        int r = it;
        if (r < I1) { const int kb = r / 176, nb = r % 176; int s0; ffn_map(32 * nb, s0); tr_item(P->w_ffn1_in, 2 * DFF, s0, 32, P->norm_ffn1, (bf16_t*)(ws + WS_W1), 1024, 32 * nb, 64 * kb, scr, lane); continue; } r -= I1;
        if (r < I2) { const int kb = r / 32, nb = r % 32; tr_item(P->w_ffn1_out, 1024, 32 * nb, 32, nullptr, (bf16_t*)(ws + WS_W2), DFF, 32 * nb, 64 * kb, scr, lane); continue; } r -= I2;
        if (r < I3) { const int kb = r / 328, nb = r % 328; int s0, nv; win_map(32 * nb, s0, nv); tr_item(P->w_in, NIN, s0, nv, P->norm_mix, (bf16_t*)(ws + WS_WIN), 1024, 32 * nb, 64 * kb, scr, lane); continue; } r -= I3;
        if (r < I4) { const int kb = r / 32, nb = r % 32; tr_item(P->w_mem_kv, 1024, 32 * nb, 32, P->norm_mem, (bf16_t*)(ws + WS_WMEM), 1024, 32 * nb, 64 * kb, scr, lane); continue; } r -= I4;
        if (r < 3 * I5) { const int b = r / I5, q = r % I5, kb = q / 32, nb = q % 32; const float* w = b == 0 ? P->w_br_att : (b == 1 ? P->w_br_ml : P->w_br_cx);
            tr_item(w, 1024, 32 * nb, 32, nullptr, (bf16_t*)(ws + WS_WBR) + (size_t)b * 1024 * 512, 512, 32 * nb, 64 * kb, scr, lane); continue; } r -= 3 * I5;
        if (r < I6) { const int kb = r / 32, nb = r % 32; tr_item(P->w_out, 1024, 32 * nb, 32, nullptr, (bf16_t*)(ws + WS_WOUT), 1024, 32 * nb, 64 * kb, scr, lane); continue; } r -= I6;
        if (r < I1) { const int kb = r / 176, nb = r % 176; int s0; ffn_map(32 * nb, s0); tr_item(P->w_ffn2_in, 2 * DFF, s0, 32, P->norm_ffn2, (bf16_t*)(ws + WS_W3), 1024, 32 * nb, 64 * kb, scr, lane); continue; } r -= I1;
        { const int kb = r / 32, nb = r % 32; tr_item(P->w_ffn2_out, 1024, 32 * nb, 32, nullptr, (bf16_t*)(ws + WS_W4), DFF, 32 * nb, 64 * kb, scr, lane); }
    }
    bf16_t* xb = (bf16_t*)(ws + WS_XB); float* part = (float*)(ws + WS_PART);
    bf16_t* memb = (bf16_t*)(ws + WS_MEMB); float* ssm = (float*)(ws + WS_SSM);
    for (int m = gw; m < T_ + MEMROWS; m += NGW) {
        const bool isx = m < T_; const int row = isx ? m : m - T_;
        const f32x4* xr = (const f32x4*)((isx ? P->x : P->mem) + (size_t)row * DM) + lane;
        unsigned long long* o8 = (unsigned long long*)((isx ? xb : memb) + (size_t)row * DM) + lane;
        float s = 0.f;
#pragma unroll
        for (int j = 0; j < 4; ++j) { const f32x4 v = xr[64 * j]; s += (v.x * v.x + v.y * v.y) + (v.z * v.z + v.w * v.w);
            o8[64 * j] = (unsigned long long)pkbf(v.x, v.y) | ((unsigned long long)pkbf(v.z, v.w) << 32); }
        s = wave_sum(s);
        if (isx) { if (lane < 4) part[(size_t)lane * (SS_STRIDE / 4) + row] = lane == 0 ? s : 0.f; }
        else if (lane == 0) ssm[row] = s;
    }
    float* rc = (float*)(ws + WS_ROPE); float* rsn = rc + 2048 * 32;
    for (int i = gw * 64 + lane; i < 2048 * 32; i += NGW * 64) {
        const int s = i >> 5, d = i & 31; const float inv = powf(10000.0f, -(float)(2 * d) / 64.0f); const float ang = (float)s * inv;
        rc[i] = cosf(ang); rsn[i] = sinf(ang);
    }
}

DI void cknorm(KPC P, int gw, int NGW, int lane) {
    bf16_t* ckv = (bf16_t*)(P->ws + WS_CKV);
    for (int it = gw; it < MEMROWS * 4; it += NGW) {
        const int row = it >> 2, hd = it & 3; unsigned* p = (unsigned*)(ckv + (size_t)row * 1024 + hd * 128) + lane;
        const unsigned w = *p; const float a = bflo(w), b = bfhi(w);
        const float ss = wave_sum(a * a + b * b); const float rs = 1.0f / sqrtf(ss * (1.0f / 128.0f) + EPS);
        *p = pkbf(a * rs * P->cx_k_gain[2 * lane], b * rs * P->cx_k_gain[2 * lane + 1]);
    }
}

template <int D, int NKB, bool BAND>
DI void attn_pass(const bf16_t* Kb, const bf16_t* Vb, long pitch, unsigned vmask, const bf16x8 (&qf)[D / 16],
                  float& m, float& l, f32x16 (&o)[D / 32], LAS unsigned char* vs, int lane) {
    const int r = lane & 31, h = lane >> 5;
    f32x16 st[NKB];
#pragma unroll
    for (int kb = 0; kb < NKB; ++kb) {
        if (vmask & (1u << kb)) {
            const bf16_t* kr = Kb + (long)(32 * kb + r) * pitch + 8 * h;
            f32x16 a = zero16();
#pragma unroll
            for (int ks = 0; ks < D / 16; ++ks) a = mfma32(*(const bf16x8*)(kr + 16 * ks), qf[ks], a);
            st[kb] = a;
            MEMFENCE();
        } else {
#pragma unroll
            for (int i = 0; i < 16; ++i) st[kb][i] = NEGF;
        }
    }
    if (BAND) {
#pragma unroll
        for (int i = 0; i < 16; ++i) { const int jj = crow(i, h); if (jj < r) st[0][i] = NEGF; if (jj > r) st[NKB - 1][i] = NEGF; }
    }
    float bm = NEGF;
#pragma unroll
    for (int kb = 0; kb < NKB; ++kb)
#pragma unroll
        for (int i = 0; i < 16; ++i) bm = fmaxf(bm, st[kb][i]);
    bm = fmaxf(bm, __shfl_xor(bm, 32));
    const float mn = fmaxf(m, bm); const float alpha = __expf(m - mn);
    float ls = 0.f;
#pragma unroll
    for (int kb = 0; kb < NKB; ++kb)
#pragma unroll
        for (int i = 0; i < 16; ++i) { const float p = __expf(st[kb][i] - mn); st[kb][i] = p; ls += p; }
    ls += __shfl_xor(ls, 32);
    l = l * alpha + ls; m = mn;
#pragma unroll
    for (int d0 = 0; d0 < D / 32; ++d0)
#pragma unroll
        for (int i = 0; i < 16; ++i) o[d0][i] *= alpha;
    const int q4 = (lane & 15) >> 2, p4 = lane & 3, blk = (lane >> 4) & 1;
    LAS unsigned char* vrd = vs + q4 * (2 * D) + 32 * blk + 8 * p4;
#pragma unroll
    for (int kb = 0; kb < NKB; ++kb) {
        if (vmask & (1u << kb)) {
            constexpr int CPR = D / 8;
#pragma unroll
            for (int t = 0; t < (32 * CPR) / 64; ++t) {
                const int ci = lane + 64 * t, row = ci / CPR, ch = ci % CPR;
                const u32x4 v = *(const u32x4*)(Vb + (long)(32 * kb + row) * pitch + 8 * ch);
                *(LAS u32x4*)(vs + row * (2 * D) + ch * 16) = v;
                if ((t & 3) == 3) MEMFENCE();
            }
            LDS_FENCE();
#pragma unroll
            for (int ks2 = 0; ks2 < 2; ++ks2) {
                const bf16x8 pb = pack8(st[kb], ks2);
#pragma unroll
                for (int d0 = 0; d0 < D / 32; ++d0) {
                    const s16x4 lo = trread(vrd + (16 * ks2 + 4 * h) * (2 * D) + 64 * d0);
                    const s16x4 hi = trread(vrd + (16 * ks2 + 8 + 4 * h) * (2 * D) + 64 * d0);
                    o[d0] = mfma32(cat44(lo, hi), pb, o[d0]);
                }
            }
            LDS_FENCE();
        }
    }
}

DI void att_unit(unsigned char* ws, int u, LAS unsigned char* vs, int lane) {
    const int r = lane & 31, h = lane >> 5;
    const int qblk = u & 63, hb = u >> 6, head = hb % 24, bl = hb / 24;
    const int gi = head >> 3, slot = head & 7, sh = 2 * gi, n = 2048 >> sh;
    const int prow = 32 * qblk, c = prow >> (11 - sh), i0 = prow & (n - 1);
    const size_t hbase = (size_t)(bl * 24 + head) * 2048 * 64;
    bf16_t* Q = (bf16_t*)(ws + WS_AQ) + hbase; const bf16_t* K = (const bf16_t*)(ws + WS_AK) + hbase; const bf16_t* V = (const bf16_t*)(ws + WS_AV) + hbase;
    bf16x8 qf[4];
#pragma unroll
    for (int ks = 0; ks < 4; ++ks) qf[ks] = *(const bf16x8*)(Q + (size_t)(prow + r) * 64 + 16 * ks + 8 * h);
    unsigned vmask = 0;
#pragma unroll
    for (int kb = 0; kb < 5; ++kb) { const int j0 = i0 - 64 + 32 * kb; if (j0 >= 0 && j0 < n) vmask |= 1u << kb; }
    vmask = __builtin_amdgcn_readfirstlane(vmask);
    float m = NEGF, l = 0.f; f32x16 o[2]; o[0] = zero16(); o[1] = zero16();
    attn_pass<64, 5, true>(K + (long)(prow - 64) * 64, V + (long)(prow - 64) * 64, 64, vmask, qf, m, l, o, vs, lane);
    const float inv = 1.0f / l;
    bf16_t* orow = Q + (size_t)(prow + r) * 64;
#pragma unroll
    for (int d0 = 0; d0 < 2; ++d0)
#pragma unroll
        for (int g4 = 0; g4 < 4; ++g4) {
            u32x2 w; w.x = pkbf(o[d0][4 * g4] * inv, o[d0][4 * g4 + 1] * inv); w.y = pkbf(o[d0][4 * g4 + 2] * inv, o[d0][4 * g4 + 3] * inv);
            *(u32x2*)(orow + 32 * d0 + 8 * g4 + 4 * h) = w;
        }
    if (h == 0) {
        const int s = c + ((i0 + r) << sh);
        float* lse = (float*)(ws + WS_LSE);
        lse[((size_t)gi * TG + (size_t)bl * 2048 + s) * 8 + slot] = m + __logf(l);
    }
}

DI void cross_unit(KPC P, int grp, int u, LAS unsigned char* vs, int lane) {
    const int r = lane & 31, h = lane >> 5;
    const int qblk = u & 63, head = (u >> 6) & 3, bl = u >> 8;
    bf16_t* qrow = (bf16_t*)(P->ws + WS_CQ) + ((size_t)bl * 2048 + 32 * qblk + r) * 512 + head * 128;
    bf16x8 qf[8]; float ss = 0.f;
#pragma unroll
    for (int ks = 0; ks < 8; ++ks) { qf[ks] = *(const bf16x8*)(qrow + 16 * ks + 8 * h);
        const u32x4 w = __builtin_bit_cast(u32x4, qf[ks]);
        ss += (bflo(w.x) * bflo(w.x) + bfhi(w.x) * bfhi(w.x)) + (bflo(w.y) * bflo(w.y) + bfhi(w.y) * bfhi(w.y)) + (bflo(w.z) * bflo(w.z) + bfhi(w.z) * bfhi(w.z)) + (bflo(w.w) * bflo(w.w) + bfhi(w.w) * bfhi(w.w)); }
    ss += __shfl_xor(ss, 32);
    const float rq = (1.0f / sqrtf(ss * (1.0f / 128.0f) + EPS)) * 0.08838834764831845f;
#pragma unroll
    for (int ks = 0; ks < 8; ++ks) {
        const u32x4 w = __builtin_bit_cast(u32x4, qf[ks]); const float* g = P->cx_q_gain + 16 * ks + 8 * h;
        const f32x4 ga = *(const f32x4*)g, gb = *(const f32x4*)(g + 4);
        u32x4 o; o.x = pkbf(bflo(w.x) * rq * ga.x, bfhi(w.x) * rq * ga.y); o.y = pkbf(bflo(w.y) * rq * ga.z, bfhi(w.y) * rq * ga.w);
        o.z = pkbf(bflo(w.z) * rq * gb.x, bfhi(w.z) * rq * gb.y); o.w = pkbf(bflo(w.w) * rq * gb.z, bfhi(w.w) * rq * gb.w);
        qf[ks] = __builtin_bit_cast(bf16x8, o);
    }
    const bf16_t* K = (const bf16_t*)(P->ws + WS_CKV) + (size_t)(grp * BL + bl) * 256 * 1024 + head * 128;
    const bf16_t* V = K + 512;
    float m = NEGF, l = 0.f; f32x16 o[4];
#pragma unroll
    for (int d0 = 0; d0 < 4; ++d0) o[d0] = zero16();
#pragma unroll 1
    for (int ps = 0; ps < 4; ++ps) attn_pass<128, 2, false>(K + (size_t)ps * 64 * 1024, V + (size_t)ps * 64 * 1024, 1024, 0x3u, qf, m, l, o, vs, lane);
    const float inv = 1.0f / l;
#pragma unroll
    for (int d0 = 0; d0 < 4; ++d0)
#pragma unroll
        for (int g4 = 0; g4 < 4; ++g4) {
            u32x2 w; w.x = pkbf(o[d0][4 * g4] * inv, o[d0][4 * g4 + 1] * inv); w.y = pkbf(o[d0][4 * g4 + 2] * inv, o[d0][4 * g4 + 3] * inv);
            *(u32x2*)(qrow + 32 * d0 + 8 * g4 + 4 * h) = w;
        }
}

DI float scan_add(float v, int lane) {
#pragma unroll
    for (int d = 1; d < 64; d <<= 1) { const float t = __shfl_up(v, d); if (lane >= d) v += t; }
    return v;
}
DI float scan_max(float v, int lane) {
#pragma unroll
    for (int d = 1; d < 64; d <<= 1) { const float t = __shfl_up(v, d); if (lane >= d) v = fmaxf(v, t); }
    return v;
}
DI float log_sigmoid(float x) { return x >= 0.f ? -log1pf(__expf(-x)) : x - log1pf(__expf(x)); }

DI void mlstm_chain(KPC P, LAS unsigned char* lds, int bl, int head, int dir, const int tid) {
    const int lane = tid & 63, wave = __builtin_amdgcn_readfirstlane(tid >> 6), r = lane & 31, h = lane >> 5;
    unsigned char* ws = P->ws; asm volatile("" : "+s"(ws));
    const bf16_t* MQ = (const bf16_t*)(ws + WS_MQ); const bf16_t* MK = (const bf16_t*)(ws + WS_MK); const bf16_t* MV = (const bf16_t*)(ws + WS_MV);
    const float* MIF = (const float*)(ws + WS_MIF);
    bf16_t* Hout = (bf16_t*)(ws + (dir ? WS_HB : WS_HF));
    LAS unsigned char* QI = lds; LAS unsigned char* KI = lds + 32768; LAS unsigned char* VI = lds + 65536; LAS unsigned char* CI = lds + 98304;
    LAS float* tg = (LAS float*)(lds + TB_OFF); LAS float* tM = tg + 128; LAS float* tbc = tg + 256; LAS float* twk = tg + 384; LAS float* tnv = tg + 512;
    LAS float* scal = tg + 640; LAS float* cw = tg + 656; LAS float* cb = cw + 5 * 256;
    for (int i = tid; i < 5 * 256; i += 512) { const int j = i >> 8, c = i & 255; cw[i] = P->ml_conv_w[j * 1024 + (c >> 7) * 512 + head * 128 + (c & 127)]; }
    if (tid < 256) cb[tid] = P->ml_conv_b[(tid >> 7) * 512 + head * 128 + (tid & 127)];
    for (int i = tid; i < 32768 / 16; i += 512) *(LAS u32x4*)(CI + i * 16) = (u32x4){0u, 0u, 0u, 0u};
    if (tid < 128) tnv[tid] = 0.f;
    f32x16 cacc[2]; float nst[2] = {0.f, 0.f};
    cacc[0] = zero16(); cacc[1] = zero16();
    float mcur = 0.f;
    const float bli = P->ml_gate_b[(dir ? 8 : 0) + head], blf = P->ml_gate_b[(dir ? 12 : 4) + head];
    __syncthreads();
    const int q4 = (lane & 15) >> 2, p4 = lane & 3, blk = (lane >> 4) & 1;
    const int trofs = q4 * 256 + 32 * blk + 8 * p4;
#pragma unroll 1
    for (int ci = 0; ci < 16; ++ci) {
        {
            const int t = tid >> 2, c0 = (tid & 3) * 32; const int tau = 128 * ci + t; const int p = dir ? 2047 - tau : tau;
            const size_t rowb = (size_t)bl * 2048;
#pragma unroll
            for (int sel = 0; sel < 2; ++sel) {
                const bf16_t* src = (sel ? MK : MQ) + head * 128 + c0; LAS unsigned char* dst = (sel ? KI : QI) + t * 256 + c0 * 2;
                const float osc = sel ? 1.0f : 0.08838834764831845f;
#pragma unroll
                for (int sub = 0; sub < 4; ++sub) {
                    float a[8];
#pragma unroll
                    for (int e = 0; e < 8; ++e) a[e] = cb[sel * 128 + c0 + 8 * sub + e];
#pragma unroll
                    for (int j = 0; j < 5; ++j) {
                        const int pp = p + j - 2;
                        if (pp >= 0 && pp < 2048) {
                            const u32x4 w = *(const u32x4*)(src + (rowb + pp) * 512 + 8 * sub);
                            const LAS float* wj = cw + j * 256 + sel * 128 + c0 + 8 * sub;
                            a[0] += wj[0] * bflo(w.x); a[1] += wj[1] * bfhi(w.x); a[2] += wj[2] * bflo(w.y); a[3] += wj[3] * bfhi(w.y);
                            a[4] += wj[4] * bflo(w.z); a[5] += wj[5] * bfhi(w.z); a[6] += wj[6] * bflo(w.w); a[7] += wj[7] * bfhi(w.w);
                        }
                    }
#pragma unroll
                    for (int e = 0; e < 8; ++e) a[e] = a[e] * sigmoidf_(a[e]) * osc;
                    u32x4 o; o.x = pkbf(a[0], a[1]); o.y = pkbf(a[2], a[3]); o.z = pkbf(a[4], a[5]); o.w = pkbf(a[6], a[7]);
                    *(LAS u32x4*)(dst + sub * 16) = o;
                    MEMFENCE();
                }
            }
            const bf16_t* vsrc = MV + (rowb + p) * 512 + head * 128 + c0;
#pragma unroll
            for (int sub = 0; sub < 4; ++sub) *(LAS u32x4*)(VI + t * 256 + c0 * 2 + sub * 16) = *(const u32x4*)(vsrc + 8 * sub);
        }
        if (wave == 0) {
            const int tau1 = 128 * ci + lane, tau2 = tau1 + 64; const int p1 = dir ? 2047 - tau1 : tau1, p2 = dir ? 2047 - tau2 : tau2;
            const float* r1 = MIF + ((size_t)bl * 2048 + p1) * 16 + head; const float* r2 = MIF + ((size_t)bl * 2048 + p2) * 16 + head;
            const float li1 = r1[dir ? 8 : 0] + bli, li2 = r2[dir ? 8 : 0] + bli;
            const float lf1 = log_sigmoid(r1[dir ? 12 : 4] + blf), lf2 = log_sigmoid(r2[dir ? 12 : 4] + blf);
            const float c1 = scan_add(lf1, lane); const float tot1 = __shfl(c1, 63); const float c2 = scan_add(lf2, lane) + tot1;
            const float g1 = li1 - c1, g2 = li2 - c2;
            const float x1 = scan_max(g1, lane); const float mx1 = __shfl(x1, 63); const float x2 = fmaxf(scan_max(g2, lane), mx1);
            const float gtot = __shfl(c2, 63), gmax = __shfl(x2, 63);
            const float mnew = gtot + fmaxf(mcur, gmax);
            tg[lane] = g1; tg[64 + lane] = g2; tM[lane] = fmaxf(x1, mcur); tM[64 + lane] = fmaxf(x2, mcur); tbc[lane] = c1; tbc[64 + lane] = c2;
            twk[lane] = __expf(g1 + gtot - mnew); twk[64 + lane] = __expf(g2 + gtot - mnew);
            if (lane == 0) { scal[0] = mcur; scal[1] = __expf(gtot + mcur - mnew); }
            mcur = mnew;
        }
        __syncthreads();
        {
            const int tb = wave >> 1, vh = wave & 1; const int t = 32 * tb + r;
            const float Mt = tM[t], bct = tbc[t], mold = scal[0];
            const float winter = __expf(mold - Mt), flo = __expf(-(Mt + bct));
            bf16x8 qf[8];
#pragma unroll
            for (int ks = 0; ks < 8; ++ks) qf[ks] = *(const LAS bf16x8*)(QI + t * 256 + (16 * ks + 8 * h) * 2);
            f32x16 na[2]; na[0] = zero16(); na[1] = zero16();
            float den = 0.f;
            for (int sb = 0; sb <= tb; ++sb) {
                f32x16 st = zero16();
#pragma unroll
                for (int ks = 0; ks < 8; ++ks) st = mfma32(*(const LAS bf16x8*)(KI + (32 * sb + r) * 256 + (16 * ks + 8 * h) * 2), qf[ks], st);
                MEMFENCE();
#pragma unroll
                for (int i = 0; i < 16; ++i) {
                    const int sl = crow(i, h); const float wgt = __expf(tg[32 * sb + sl] - Mt);
                    const bool valid = (sb < tb) || (sl <= r);
                    const float v = valid ? st[i] * wgt : 0.f; st[i] = v; den += v;
                }
#pragma unroll
                for (int ks2 = 0; ks2 < 2; ++ks2) {
                    const bf16x8 pb = pack8(st, ks2);
#pragma unroll
                    for (int jv = 0; jv < 2; ++jv) {
                        LAS unsigned char* vp = VI + trofs + (32 * sb + 16 * ks2 + 4 * h) * 256 + 64 * (2 * vh + jv);
                        const s16x4 lo = trread(vp), hi = trread(vp + 8 * 256);
                        na[jv] = mfma32(cat44(lo, hi), pb, na[jv]);
                    }
                }
            }
            den += __shfl_xor(den, 32);
            float dq = 0.f;
#pragma unroll
            for (int ks = 0; ks < 8; ++ks) {
                const u32x4 w = __builtin_bit_cast(u32x4, qf[ks]); const LAS float* nv = tnv + 16 * ks + 8 * h;
                const float q0 = bflo(w.x), q1 = bfhi(w.x), q2 = bflo(w.y), q3 = bfhi(w.y), q4_ = bflo(w.z), q5 = bfhi(w.z), q6 = bflo(w.w), q7 = bfhi(w.w);
                dq += (nv[0] * q0 + nv[1] * q1) + (nv[2] * q2 + nv[3] * q3) + (nv[4] * q4_ + nv[5] * q5) + (nv[6] * q6 + nv[7] * q7);
                u32x4 o; o.x = pkbf(q0 * winter, q1 * winter); o.y = pkbf(q2 * winter, q3 * winter); o.z = pkbf(q4_ * winter, q5 * winter); o.w = pkbf(q6 * winter, q7 * winter);
                const bf16x8 qs = __builtin_bit_cast(bf16x8, o);
#pragma unroll
                for (int jv = 0; jv < 2; ++jv)
                    na[jv] = mfma32(*(const LAS bf16x8*)(CI + (32 * (2 * vh + jv) + r) * 256 + (16 * ks + 8 * h) * 2), qs, na[jv]);
            }
            dq += __shfl_xor(dq, 32);
            den += winter * dq;
            const float inv = 1.0f / fmaxf(fabsf(den), flo);
            const int tau = 128 * ci + t; const int p = dir ? 2047 - tau : tau;
            bf16_t* dst = Hout + ((size_t)bl * 2048 + p) * 512 + head * 128;
#pragma unroll
            for (int jv = 0; jv < 2; ++jv)
#pragma unroll
                for (int g4 = 0; g4 < 4; ++g4) {
                    u32x2 w; w.x = pkbf(na[jv][4 * g4] * inv, na[jv][4 * g4 + 1] * inv); w.y = pkbf(na[jv][4 * g4 + 2] * inv, na[jv][4 * g4 + 3] * inv);
                    *(u32x2*)(dst + 32 * (2 * vh + jv) + 8 * g4 + 4 * h) = w;
                }
        }
        __syncthreads();
        {
            const int s = tid >> 2, c0 = (tid & 3) * 32; const float wks = twk[s];
#pragma unroll
            for (int sub = 0; sub < 4; ++sub) {
                LAS u32x4* pp = (LAS u32x4*)(KI + s * 256 + c0 * 2 + sub * 16); const u32x4 w = *pp;
                u32x4 o; o.x = pkbf(bflo(w.x) * wks, bfhi(w.x) * wks); o.y = pkbf(bflo(w.y) * wks, bfhi(w.y) * wks); o.z = pkbf(bflo(w.z) * wks, bfhi(w.z) * wks); o.w = pkbf(bflo(w.w) * wks, bfhi(w.w) * wks);
                *pp = o;
            }
        }
        __syncthreads();
        {
            const int vb = wave >> 1, kh = wave & 1; const float decay = scal[1];
#pragma unroll
            for (int jk = 0; jk < 2; ++jk)
#pragma unroll
                for (int i = 0; i < 16; ++i) cacc[jk][i] *= decay;
            f32x16 ntmp[2]; ntmp[0] = zero16(); ntmp[1] = zero16();
            const bf16x8 ones = (bf16x8){0x3F80, 0x3F80, 0x3F80, 0x3F80, 0x3F80, 0x3F80, 0x3F80, 0x3F80};
#pragma unroll
            for (int ks = 0; ks < 8; ++ks) {
                LAS unsigned char* vp = VI + trofs + (16 * ks + 8 * h) * 256 + 64 * vb;
                const bf16x8 af = cat44(trread(vp), trread(vp + 4 * 256));
#pragma unroll
                for (int jk = 0; jk < 2; ++jk) {
                    LAS unsigned char* kp = KI + trofs + (16 * ks + 8 * h) * 256 + 64 * (2 * kh + jk);
                    const bf16x8 bfr = cat44(trread(kp), trread(kp + 4 * 256));
                    cacc[jk] = mfma32(af, bfr, cacc[jk]);
                    if (vb == 0) ntmp[jk] = mfma32(ones, bfr, ntmp[jk]);
                }
            }
#pragma unroll
            for (int jk = 0; jk < 2; ++jk) {
                const int kcol = 32 * (2 * kh + jk) + r;
#pragma unroll
                for (int i = 0; i < 16; i += 1) {
                    const unsigned short v = (unsigned short)(pkbf(cacc[jk][i], 0.f) & 0xffffu);
                    *(LAS unsigned short*)(CI + (32 * vb + crow(i, h)) * 256 + kcol * 2) = v;
                }
                nst[jk] = nst[jk] * decay + ntmp[jk][0];
                if (vb == 0 && h == 0) tnv[kcol] = nst[jk];
            }
        }
        __syncthreads();
    }
}

DI void merge_pass(KPC P, int gw, int NGW, int lane) {
    unsigned char* ws = P->ws;
    const bf16_t* AO = (const bf16_t*)(ws + WS_AQ); const float* LSE = (const float*)(ws + WS_LSE);
    const bf16_t* HF = (const bf16_t*)(ws + WS_HF); const bf16_t* HB = (const bf16_t*)(ws + WS_HB); const bf16_t* MO = (const bf16_t*)(ws + WS_MO);
    bf16_t* YA = (bf16_t*)(ws + WS_YATT); bf16_t* YM = (bf16_t*)(ws + WS_YML);
    for (int tok = gw; tok < TG; tok += NGW) {
        const int bl = tok >> 11, s = tok & 2047;
        {
            const int slot = lane >> 3, d0 = 8 * (lane & 7);
            float ls[3], mx = NEGF;
#pragma unroll
            for (int g = 0; g < 3; ++g) { ls[g] = LSE[((size_t)g * TG + tok) * 8 + slot]; mx = fmaxf(mx, ls[g]); }
            float e[3], sum = 0.f;
#pragma unroll
            for (int g = 0; g < 3; ++g) { e[g] = __expf(ls[g] - mx); sum += e[g]; }
            const float isum = 1.0f / sum;
            float acc[8];
#pragma unroll
            for (int k = 0; k < 8; ++k) acc[k] = 0.f;
#pragma unroll
            for (int g = 0; g < 3; ++g) {
                const int sh = 2 * g; const int perm = ((s & ((1 << sh) - 1)) << (11 - sh)) + (s >> sh);
                const u32x4 w = *(const u32x4*)(AO + ((size_t)(bl * 24 + g * 8 + slot) * 2048 + perm) * 64 + d0);
                const float a = e[g] * isum;
                acc[0] += a * bflo(w.x); acc[1] += a * bfhi(w.x); acc[2] += a * bflo(w.y); acc[3] += a * bfhi(w.y);
                acc[4] += a * bflo(w.z); acc[5] += a * bfhi(w.z); acc[6] += a * bflo(w.w); acc[7] += a * bfhi(w.w);
            }
            u32x4 o; o.x = pkbf(acc[0], acc[1]); o.y = pkbf(acc[2], acc[3]); o.z = pkbf(acc[4], acc[5]); o.w = pkbf(acc[6], acc[7]);
            *(u32x4*)(YA + (size_t)tok * 512 + slot * 64 + d0) = o;
        }
        {
            const size_t off = (size_t)tok * 512 + 8 * lane;
            const u32x4 a = *(const u32x4*)(HF + off), b = *(const u32x4*)(HB + off), mo = *(const u32x4*)(MO + off);
            float v[8];
            v[0] = bflo(a.x) + bflo(b.x); v[1] = bfhi(a.x) + bfhi(b.x); v[2] = bflo(a.y) + bflo(b.y); v[3] = bfhi(a.y) + bfhi(b.y);
            v[4] = bflo(a.z) + bflo(b.z); v[5] = bfhi(a.z) + bfhi(b.z); v[6] = bflo(a.w) + bflo(b.w); v[7] = bfhi(a.w) + bfhi(b.w);
            float ss = 0.f;
#pragma unroll
            for (int k = 0; k < 8; ++k) ss += v[k] * v[k];
            ss += __shfl_xor(ss, 1); ss += __shfl_xor(ss, 2); ss += __shfl_xor(ss, 4); ss += __shfl_xor(ss, 8);
            const float rs = 1.0f / sqrtf(ss * (1.0f / 128.0f) + EPS);
            const f32x4 ga = *(const f32x4*)(P->ml_out_gain + 8 * lane), gb = *(const f32x4*)(P->ml_out_gain + 8 * lane + 4);
            float mg[8]; mg[0] = bflo(mo.x); mg[1] = bfhi(mo.x); mg[2] = bflo(mo.y); mg[3] = bfhi(mo.y); mg[4] = bflo(mo.z); mg[5] = bfhi(mo.z); mg[6] = bflo(mo.w); mg[7] = bfhi(mo.w);
            const float gg[8] = {ga.x, ga.y, ga.z, ga.w, gb.x, gb.y, gb.z, gb.w};
            float y[8];
#pragma unroll
            for (int k = 0; k < 8; ++k) y[k] = v[k] * rs * gg[k] * sigmoidf_(mg[k]);
            u32x4 o; o.x = pkbf(y[0], y[1]); o.y = pkbf(y[2], y[3]); o.z = pkbf(y[4], y[5]); o.w = pkbf(y[6], y[7]);
            *(u32x4*)(YM + off) = o;
        }
    }
}

DI void final_norm(KPC P, int gw, int NGW, int lane) {
    const float* part = (const float*)(P->ws + WS_PART + 3 * SS_STRIDE);
    for (int row = gw; row < T_; row += NGW) {
        const float rs = rstd_part(part, row);
        f32x4* xr = (f32x4*)(P->out + (size_t)row * DM) + lane; const f32x4* gr = (const f32x4*)P->norm_final + lane;
#pragma unroll
        for (int j = 0; j < 4; ++j) { const f32x4 v = xr[64 * j]; xr[64 * j] = v * rs * gr[64 * j]; }
    }
}

__global__ void __launch_bounds__(512, 2) mega_fwd(KP Pv, int step_lo, int step_hi, int coop) {
    extern __shared__ __attribute__((aligned(16))) unsigned char lds_raw[];
    LAS unsigned char* lds = (LAS unsigned char*)lds_raw;
    const int G = gridDim.x, NGW = G * 8;
    cg::grid_group grid = cg::this_grid();
#pragma unroll 1
    for (int step = step_lo; step < step_hi; ++step) {
        int tid = threadIdx.x; asm volatile("" : "+v"(tid));
        const int lane = tid & 63, wave = __builtin_amdgcn_readfirstlane(tid >> 6);
        int bid = blockIdx.x; asm volatile("" : "+s"(bid));
        const int gw = bid * 8 + wave;
        KPC P = (KPC)__builtin_amdgcn_kernarg_segment_ptr(); asm volatile("" : "+s"(P));
        unsigned char* ws = P->ws; asm volatile("" : "+s"(ws));
        unsigned* ctl = (unsigned*)(ws + WS_CTL);
        bool is_gemm = false, do_sync = true, perm = true;
        pg8::Gemm g{nullptr, nullptr, 0, 0, 0};
        EpiAny E; E.kind = 0; E.aux = 0; E.goff = 0; E.ws = ws; E.kp = P;
        bf16_t* xb = (bf16_t*)(ws + WS_XB);
        int grp = 0, sub = -1;
        if (step >= 5 && step < 19) { grp = (step - 5) / 7; sub = (step - 5) % 7; }
        const int goff = grp * TG;
        if (step == 0) {
#ifndef NO_PRE
            prepass(P, lds, gw, NGW, wave, lane);
#endif
        } else if (step == 1) {
            is_gemm = true; do_sync = false; g = pg8::Gemm{xb, (const bf16_t*)(ws + WS_W1), T_, 2 * DFF, 1024};
            E.kind = EK_SWIGLU;
        } else if (step == 2) {
            is_gemm = true; g = pg8::Gemm{(const bf16_t*)(ws + WS_MEMB), (const bf16_t*)(ws + WS_WMEM), MEMROWS, 1024, 1024};
            E.kind = EK_MEMKV;
        } else if (step == 3) {
            cknorm(P, gw, NGW, lane); do_sync = false;
        } else if (step == 4) {
            is_gemm = true; perm = false; g = pg8::Gemm{(const bf16_t*)(ws + WS_ACT), (const bf16_t*)(ws + WS_W2), T_, 1024, DFF};
            E.kind = EK_RESID; E.aux = 0;
        } else if (sub == 0) {
            is_gemm = true; g = pg8::Gemm{xb + (size_t)goff * DM, (const bf16_t*)(ws + WS_WIN), TG, NWIN, 1024};
            E.kind = EK_WIN; E.goff = goff;
        } else if (sub == 1) {
#ifndef NO_CHAIN
            for (int c = bid; c < 64; c += G) mlstm_chain(P, lds, c >> 3, (c >> 1) & 3, c & 1, tid);
#endif
            LAS unsigned char* vs = lds + wave * 8192;
            constexpr int NCROSS = BL * 4 * 64, NATT = BL * 24 * 64;
            for (;;) {
                unsigned u = 0;
                if (lane == 0) u = atomicAdd(ctl + 64 * (1 + grp), 1u);
                u = __builtin_amdgcn_readfirstlane(u);
                if (u >= (unsigned)(NCROSS + NATT)) break;
#ifndef NO_CROSS
                if (u < (unsigned)NCROSS) cross_unit(P, grp, (int)u, vs, lane);
#endif
#ifndef NO_ATT
                if (u >= (unsigned)NCROSS) att_unit(ws, (int)u - NCROSS, vs, lane);
#endif
            }
        } else if (sub == 2) {
#ifndef NO_MERGE
            merge_pass(P, gw, NGW, lane);
#endif
        } else if (sub >= 3 && sub <= 5) {
            const int b = sub - 3; is_gemm = true; perm = false; do_sync = (b == 2);
            const bf16_t* A = (const bf16_t*)(ws + (b == 0 ? WS_YATT : (b == 1 ? WS_YML : WS_CQ)));
            g = pg8::Gemm{A, (const bf16_t*)(ws + WS_WBR) + (size_t)b * 1024 * 512, TG, 1024, 512};
            E.kind = EK_BR0 + b;
        } else if (sub == 6) {
            is_gemm = true; perm = false; g = pg8::Gemm{(const bf16_t*)(ws + WS_MB16), (const bf16_t*)(ws + WS_WOUT), TG, 1024, 1024};
            E.kind = EK_RESID; E.aux = 1; E.goff = goff;
        } else if (step == 19) {
            is_gemm = true; g = pg8::Gemm{xb, (const bf16_t*)(ws + WS_W3), T_, 2 * DFF, 1024};
            E.kind = EK_SWIGLU; E.aux = 1;
        } else if (step == 20) {
            is_gemm = true; perm = false; g = pg8::Gemm{(const bf16_t*)(ws + WS_ACT), (const bf16_t*)(ws + WS_W4), T_, 1024, DFF};
            E.kind = EK_RESID; E.aux = 2;
        } else if (step == 21) {
            final_norm(P, gw, NGW, lane); do_sync = false;
        }
        if (is_gemm) {
            pg8::StaticOrder S; S.init(g.M, g.N, G, bid);
#ifndef NO_GEMM
            pg8::gemm_phase<EpiAny>(lds, g, S, E, perm, tid);
#endif
        }
        __syncthreads();
        if (coop && do_sync && step + 1 < step_hi) grid.sync();
    }
}

extern "C" void kernel_launch(void* const* d_in, const int* in_sizes, int n_in, void* d_out, int out_size, void* d_ws, size_t ws_size, hipStream_t stream) {
    static int grid = 0;
    if (grid == 0) {
        if (n_in != 26 || ws_size < WS_END) { fprintf(stderr, "kernel_launch: unexpected n_in %d or ws_size %zu (need %zu)\n", n_in, ws_size, (size_t)WS_END); grid = -1; return; }
        int dev = 0, cus = 0, per_cu = 0;
        hipGetDevice(&dev); hipDeviceGetAttribute(&cus, hipDeviceAttributeMultiprocessorCount, dev);
        if (hipFuncSetAttribute((const void*)mega_fwd, hipFuncAttributeMaxDynamicSharedMemorySize, LDS_BYTES) != hipSuccess) { fprintf(stderr, "kernel_launch: hipFuncSetAttribute failed\n"); }
        hipOccupancyMaxActiveBlocksPerMultiprocessor(&per_cu, (const void*)mega_fwd, 512, LDS_BYTES);
        (void)hipGetLastError();
        if (per_cu < 1) per_cu = 1;
        grid = cus;
        fprintf(stderr, "kernel_launch: cus %d per_cu %d grid %d ws %zu\n", cus, per_cu, grid, ws_size);
    }
    if (grid < 0) return;
    hipMemsetAsync((char*)d_ws + WS_CTL, 0, 4096, stream);
    KP p{};
    const float** pp = (const float**)&p;
    for (int i = 0; i < 26; ++i) pp[i] = (const float*)d_in[i];
    p.out = (float*)d_out; p.ws = (unsigned char*)d_ws;
    int lo = 0, hi = 22, coop = 1;
    void* args[] = {&p, &lo, &hi, &coop};
    hipError_t e = hipLaunchCooperativeKernel((const void*)mega_fwd, dim3(grid), dim3(512), args, LDS_BYTES, stream);
    if (e != hipSuccess) fprintf(stderr, "cooperative launch failed: %s (grid %d)\n", hipGetErrorString(e), grid);
}
```

```cpp
#include <hip/hip_runtime.h>
#include <hip/hip_cooperative_groups.h>
#include <cstdio>
#include <cstdint>
namespace cg = cooperative_groups;

#define LAS __attribute__((address_space(3)))
#define DI __device__ __forceinline__
typedef unsigned short bf16_t;
typedef short bf16x8 __attribute__((ext_vector_type(8)));
typedef short s16x4 __attribute__((ext_vector_type(4)));
typedef float f32x4 __attribute__((ext_vector_type(4)));
typedef float f32x16 __attribute__((ext_vector_type(16)));
typedef unsigned u32x4 __attribute__((ext_vector_type(4)));
typedef unsigned u32x2 __attribute__((ext_vector_type(2)));

constexpr int T_ = 32768, TG = 16384, NGRP = 2, BL = 8, S_ = 2048, DM = 1024, DFF = 2816, MEMROWS = 4096;
constexpr int NWIN = 10496, NIN = 10256;
constexpr float EPS = 1e-6f;
constexpr float NEGF = -1e30f;

constexpr size_t MiB = 1u << 20;
constexpr size_t WS_CTL = 0;
constexpr size_t WS_W1 = 1 * MiB, WS_W2 = 12 * MiB, WS_WIN = 18 * MiB, WS_WMEM = 39 * MiB, WS_WBR = 41 * MiB, WS_WOUT = 44 * MiB, WS_W3 = 46 * MiB, WS_W4 = 57 * MiB;
constexpr size_t WS_ROPE = 63 * MiB;
constexpr size_t WS_SSM = 63 * MiB + 512 * 1024;
constexpr size_t WS_PART = 64 * MiB;
constexpr size_t SS_STRIDE = 131072;
constexpr size_t WS_CKV = 66 * MiB;
constexpr size_t WS_XB = 74 * MiB;
constexpr size_t WS_ACT = 138 * MiB;
constexpr size_t WS_AQ = 138 * MiB, WS_AK = 186 * MiB, WS_AV = 234 * MiB;
constexpr size_t WS_MQ = 282 * MiB;
constexpr size_t WS_MK = 298 * MiB, WS_MV = 314 * MiB, WS_MO = 330 * MiB, WS_CQ = 346 * MiB;
constexpr size_t WS_GTS = 362 * MiB;
constexpr size_t WS_MIF = 458 * MiB;
constexpr size_t WS_LSE = 459 * MiB;
constexpr size_t WS_HF = 461 * MiB, WS_HB = 477 * MiB;
constexpr size_t WS_MEMB = 400 * MiB;
constexpr size_t WS_YATT = 186 * MiB, WS_YML = 202 * MiB;
constexpr size_t WS_M32 = 234 * MiB;
constexpr size_t WS_MB16 = 298 * MiB;
constexpr size_t WS_END = 493 * MiB;

constexpr int LDS_BYTES = 147456;
constexpr int TB_OFF = 131072;

DI unsigned pkbf(float lo, float hi) {
    typedef float f2 __attribute__((ext_vector_type(2))); typedef __bf16 b2 __attribute__((ext_vector_type(2)));
    f2 v = {lo, hi}; b2 b = __builtin_convertvector(v, b2); return __builtin_bit_cast(unsigned, b);
}
DI float bflo(unsigned u) { return __uint_as_float(u << 16); }
DI float bfhi(unsigned u) { return __uint_as_float(u & 0xffff0000u); }
DI float wave_sum(float v) {
#pragma unroll
    for (int o = 1; o < 64; o <<= 1) v += __shfl_xor(v, o);
    return v;
}
DI int crow(int i, int h) { return (i & 3) + 8 * (i >> 2) + 4 * h; }
DI f32x16 mfma32(bf16x8 a, bf16x8 b, f32x16 c) { return __builtin_amdgcn_mfma_f32_32x32x16_bf16(a, b, c, 0, 0, 0); }
DI bf16x8 pack8(const f32x16& x, int s) {
    u32x4 p;
    p.x = pkbf(x[8 * s + 0], x[8 * s + 1]); p.y = pkbf(x[8 * s + 2], x[8 * s + 3]);
    p.z = pkbf(x[8 * s + 4], x[8 * s + 5]); p.w = pkbf(x[8 * s + 6], x[8 * s + 7]);
    return __builtin_bit_cast(bf16x8, p);
}
DI f32x16 zero16() { f32x16 z; for (int i = 0; i < 16; ++i) z[i] = 0.f; return z; }
typedef short v4i16_t __attribute__((ext_vector_type(4)));
DI s16x4 trread(LAS unsigned char* p) { return __builtin_bit_cast(s16x4, __builtin_amdgcn_ds_read_tr16_b64_v4i16((LAS v4i16_t*)p)); }
DI bf16x8 cat44(s16x4 lo, s16x4 hi) { return (bf16x8){lo[0], lo[1], lo[2], lo[3], hi[0], hi[1], hi[2], hi[3]}; }
#define LDS_FENCE() asm volatile("s_waitcnt lgkmcnt(0)" ::: "memory")
DI float rstd_part(const float* part, int row) { return 1.0f / sqrtf(part[row] * (1.0f / 1024.0f) + EPS); }
#define MEMFENCE() asm volatile("" ::: "memory")
DI float sigmoidf_(float v) { return 1.0f / (1.0f + __expf(-v)); }

struct KP {
    const float* x; const float* mem; const float* norm_ffn1; const float* w_ffn1_in; const float* w_ffn1_out;
    const float* norm_mix; const float* norm_mem; const float* w_in; const float* att_q_gain; const float* att_k_gain;
    const float* ml_conv_w; const float* ml_conv_b; const float* ml_gate_b; const float* ml_out_gain;
    const float* cx_q_gain; const float* cx_k_gain; const float* w_mem_kv; const float* mix_gate_b;
    const float* w_br_att; const float* w_br_ml; const float* w_br_cx; const float* w_out;
    const float* norm_ffn2; const float* w_ffn2_in; const float* w_ffn2_out; const float* norm_final;
    float* out; unsigned char* ws;
};
typedef const KP __attribute__((address_space(4)))* KPC;

namespace pg8 {
constexpr int BM = 256, BK = 64, HALF = 128, HTB = HALF * BK * 2, STAGE_BYTES = 8 * HTB, NXCD = 8, WGM = 8;
DI int lds_byte(int r, int c) { const int st = (r >> 4) * 2 + (c >> 5), rr = r & 15, cc = c & 31, ob = rr * 64 + cc * 2; return st * 1024 + (ob ^ (((ob >> 9) & 1) << 5)); }
DI void stage_rc(int b, int& R, int& C) { const int st = b / 1024, sb = b % 1024, swz = sb ^ (((sb >> 9) & 1) << 5); R = (st >> 1) * 16 + swz / 64; C = (st & 1) * 32 + (swz % 64) / 2; }
DI int perm32(int rho) { const int n = rho >> 4, i = rho & 15; return 8 * (i >> 2) + 4 * n + (i & 3); }
struct Unit { int pm, pn; };
struct Gemm { const bf16_t* A; const bf16_t* Bt; int M, N, K; };
struct StaticOrder {
    int nM, nN, nwg, G, c;
    DI void init(int M, int N, int G_, int c_) { nM = M / BM; nN = N / BM; nwg = nM * nN; G = G_; c = c_; }
    DI bool next(int i, Unit& u) const {
        const long L = (long)i * G + c; if (L >= nwg) return false;
        int wgid = (int)L; { const int q = nwg / NXCD, r = nwg % NXCD, xcd = wgid % NXCD, off = wgid / NXCD; wgid = (xcd < r ? xcd * (q + 1) : r * (q + 1) + (xcd - r) * q) + off; }
        const int nig = WGM * nN, gid = wgid / nig, fm = gid * WGM, gsz = (nM - fm) < WGM ? (nM - fm) : WGM;
        u.pm = fm + ((wgid % nig) % gsz); u.pn = (wgid % nig) / gsz; return true;
    }
};
template <class Epi>
DI void gemm_phase(LAS unsigned char* lds, const Gemm g, const StaticOrder& S, const Epi& E, const bool perm, const int tid) {
    const int wid = __builtin_amdgcn_readfirstlane(tid >> 6), lane = tid & 63, wr = wid >> 2, wc = wid & 3, fr = lane & 15, fq = lane >> 4;
    const int K = g.K, nt = K / BK;
    unsigned voffA[2], voffB[2];
#pragma unroll
    for (int i = 0; i < 2; ++i) { int R, C; stage_rc(tid * 16 + i * 8192, R, C); const int Rb = perm ? ((R & ~31) + perm32(R & 31)) : R;
        voffA[i] = (unsigned)(R * K + C) * 2u; voffB[i] = (unsigned)(Rb * K + C) * 2u; }
    const size_t kstep = (size_t)(BK * 2);
    const size_t hstep = (size_t)HALF * K * 2;
    const size_t tstep = 2 * hstep;
    const unsigned ldsw = (unsigned)wid * 1024u;
    const int aoff = lds_byte(wr * 64 + fr, fq * 8), boff = lds_byte(wc * 32 + fr, fq * 8);
#define PG8_SA(b, h) (((b) * 2 + (h)) * HTB)
#define PG8_SB(b, h) ((4 + (b) * 2 + (h)) * HTB)
#define PG8_STAGE(bufoff, gbase, voff) do { _Pragma("unroll") for (int _i = 0; _i < 2; ++_i) \
        __builtin_amdgcn_global_load_lds((const unsigned*)((const char*)(gbase) + (voff)[_i]), (LAS unsigned*)(lds + (bufoff) + ldsw + _i * 8192), 16, 0, 0); } while (0)
#define PG8_LDA(dst, b, h) do { _Pragma("unroll") for (int m = 0; m < 4; ++m) _Pragma("unroll") for (int k = 0; k < 2; ++k) dst[m][k] = *(const LAS bf16x8*)(lds + PG8_SA(b, h) + aoff + m * 2048 + k * 1024); } while (0)
#define PG8_LDB(dst, b, h) do { _Pragma("unroll") for (int n = 0; n < 2; ++n) _Pragma("unroll") for (int k = 0; k < 2; ++k) dst[n][k] = *(const LAS bf16x8*)(lds + PG8_SB(b, h) + boff + n * 2048 + k * 1024); } while (0)
#define PG8_MMA(ai, bj, At, Bt) do { __builtin_amdgcn_s_setprio(1); _Pragma("unroll") for (int m = 0; m < 4; ++m) _Pragma("unroll") for (int n = 0; n < 2; ++n) _Pragma("unroll") for (int k = 0; k < 2; ++k) \
        acc[ai][bj][m][n] = __builtin_amdgcn_mfma_f32_16x16x32_bf16(Bt[n][k], At[m][k], acc[ai][bj][m][n], 0, 0, 0); __builtin_amdgcn_s_setprio(0); } while (0)
#define PG8_WAIT_V(n) asm volatile("s_waitcnt vmcnt(" #n ")" ::: "memory")
#define PG8_WAIT_L(n) asm volatile("s_waitcnt lgkmcnt(" #n ")" ::: "memory")
#define PG8_BAR __builtin_amdgcn_s_barrier()
#define PG8_SCHED __builtin_amdgcn_sched_barrier(0)
    Unit cur, nxt; int ui = 0;
    if (!S.next(0, cur)) return;
    f32x4 acc[2][2][4][2];
#pragma unroll
    for (int a = 0; a < 2; ++a)
#pragma unroll
        for (int b = 0; b < 2; ++b)
#pragma unroll
            for (int m = 0; m < 4; ++m)
#pragma unroll
                for (int n = 0; n < 2; ++n) acc[a][b][m][n] = (f32x4){0.f, 0.f, 0.f, 0.f};
    bf16x8 At[4][2], B0[2][2], B1[2][2];
    const char* cA = (const char*)g.A + (size_t)cur.pm * tstep; const char* cB = (const char*)g.Bt + (size_t)cur.pn * tstep;
    {
        PG8_STAGE(PG8_SB(0, 0), cB, voffB); PG8_STAGE(PG8_SB(0, 1), cB + hstep, voffB); PG8_STAGE(PG8_SA(0, 0), cA, voffA); PG8_STAGE(PG8_SA(0, 1), cA + hstep, voffA);
        if (wr == 1) PG8_BAR;
        PG8_WAIT_V(2); PG8_BAR;
        PG8_STAGE(PG8_SB(1, 0), cB + kstep, voffB); PG8_STAGE(PG8_SA(1, 0), cA + kstep, voffA); PG8_STAGE(PG8_SB(1, 1), cB + hstep + kstep, voffB);
        PG8_WAIT_V(6); PG8_BAR;
    }
    for (;;) {
        const bool has_next = S.next(ui + 1, nxt);
        const char* nA = has_next ? (const char*)g.A + (size_t)nxt.pm * tstep : cA; const char* nB = has_next ? (const char*)g.Bt + (size_t)nxt.pn * tstep : cB;
        for (int t = 0; t < nt; t += 2) {
            const bool last = (t == nt - 2);
            const char* a1 = cA + (size_t)(t + 1) * kstep;
            const char* a2 = last ? nA : cA + (size_t)(t + 2) * kstep; const char* b2 = last ? nB : cB + (size_t)(t + 2) * kstep;
            const char* a3 = a2 + kstep; const char* b3 = b2 + kstep;
            PG8_LDB(B0, 0, 0); PG8_LDB(B1, 0, 1); PG8_SCHED; PG8_LDA(At, 0, 0); PG8_STAGE(PG8_SA(1, 1), a1 + hstep, voffA);
            PG8_WAIT_V(8); PG8_WAIT_L(0); PG8_BAR; PG8_MMA(0, 0, At, B0); PG8_MMA(0, 1, At, B1); PG8_BAR; PG8_SCHED;
            PG8_LDA(At, 0, 1); PG8_STAGE(PG8_SB(0, 0), b2, voffB); PG8_STAGE(PG8_SB(0, 1), b2 + hstep, voffB); PG8_STAGE(PG8_SA(0, 0), a2, voffA);
            PG8_WAIT_V(8); PG8_WAIT_L(0); PG8_BAR; PG8_MMA(1, 0, At, B0); PG8_MMA(1, 1, At, B1); PG8_BAR; PG8_SCHED;
            PG8_LDB(B0, 1, 0); PG8_LDB(B1, 1, 1); PG8_SCHED; PG8_LDA(At, 1, 0); PG8_STAGE(PG8_SA(0, 1), a2 + hstep, voffA);
            PG8_WAIT_V(8); PG8_WAIT_L(0); PG8_BAR; PG8_MMA(0, 0, At, B0); PG8_MMA(0, 1, At, B1); PG8_BAR; PG8_SCHED;
            PG8_LDA(At, 1, 1); PG8_STAGE(PG8_SB(1, 0), b3, voffB); PG8_STAGE(PG8_SB(1, 1), b3 + hstep, voffB); PG8_STAGE(PG8_SA(1, 0), a3, voffA);
            PG8_WAIT_V(8); PG8_WAIT_L(0); PG8_BAR; PG8_MMA(1, 0, At, B0); PG8_MMA(1, 1, At, B1); PG8_BAR; PG8_SCHED;
        }
        if (wr == 0) PG8_BAR;
        E(acc, cur, wr, wc, fr, fq);
        if (!has_next) break;
#pragma unroll
        for (int a = 0; a < 2; ++a)
#pragma unroll
            for (int b = 0; b < 2; ++b)
#pragma unroll
                for (int m = 0; m < 4; ++m)
#pragma unroll
                    for (int n = 0; n < 2; ++n) acc[a][b][m][n] = (f32x4){0.f, 0.f, 0.f, 0.f};
        cur = nxt; cA = nA; cB = nB; ++ui;
        if (wr == 1) PG8_BAR;
    }
    PG8_WAIT_V(0);
    PG8_BAR;
#undef PG8_SA
#undef PG8_SB
#undef PG8_STAGE
#undef PG8_LDA
#undef PG8_LDB
#undef PG8_MMA
#undef PG8_WAIT_V
#undef PG8_WAIT_L
#undef PG8_BAR
#undef PG8_SCHED
}
}

enum EpiKind { EK_SWIGLU = 0, EK_RESID = 1, EK_WIN = 2, EK_MEMKV = 3, EK_BR0 = 4, EK_BR1 = 5, EK_BR2 = 6 };
typedef const f32x4 (&AccRef)[2][2][4][2];

struct EpiAny {
    int kind, aux, goff;
    unsigned char* ws; KPC kp;

    DI void swiglu(AccRef acc, const pg8::Unit& u, int wr, int wc, int fr, int fq) const {
        const int row0 = u.pm * 256 + wr * 64 + fr, col = u.pn * 128 + wc * 32 + 8 * fq;
        const float* part = (const float*)(ws + WS_PART + (aux ? 2 * SS_STRIDE : 0)); bf16_t* xb = (bf16_t*)(ws + WS_ACT);
#pragma unroll
        for (int ai = 0; ai < 2; ++ai)
#pragma unroll
            for (int m = 0; m < 4; ++m) {
                const int row = row0 + ai * 128 + m * 16; const float rs = rstd_part(part, row);
                float o[8];
#pragma unroll
                for (int n = 0; n < 2; ++n)
#pragma unroll
                    for (int j = 0; j < 4; ++j) { const float gt = acc[ai][0][m][n][j] * rs, up = acc[ai][1][m][n][j] * rs; o[4 * n + j] = gt * sigmoidf_(gt) * up; }
                u32x4 w; w.x = pkbf(o[0], o[1]); w.y = pkbf(o[2], o[3]); w.z = pkbf(o[4], o[5]); w.w = pkbf(o[6], o[7]);
                *(u32x4*)(xb + (size_t)row * DFF + col) = w;
                MEMFENCE();
            }
    }
    DI void residual(AccRef acc, const pg8::Unit& u, int wr, int wc, int fr, int fq) const {
        const int row0 = goff + u.pm * 256 + wr * 64 + fr, c0 = u.pn * 256 + wc * 32 + 4 * fq;
        const float* resid = aux == 0 ? kp->x : kp->out; float* outf = kp->out; bf16_t* xb = (bf16_t*)(ws + WS_XB);
        float* partw = (float*)(ws + WS_PART + (size_t)(aux + 1) * SS_STRIDE); const float scale = aux == 1 ? 1.0f : 0.5f;
#pragma unroll
        for (int ai = 0; ai < 2; ++ai)
#pragma unroll
            for (int m = 0; m < 4; ++m) {
                const int row = row0 + ai * 128 + m * 16; float ssq = 0.f;
#pragma unroll
                for (int bj = 0; bj < 2; ++bj)
#pragma unroll
                    for (int n = 0; n < 2; ++n) {
                        const size_t off = (size_t)row * DM + c0 + bj * 128 + n * 16;
                        const f32x4 r = *(const f32x4*)(resid + off); const f32x4 v = r + acc[ai][bj][m][n] * scale;
                        *(f32x4*)(outf + off) = v; u32x2 w; w.x = pkbf(v.x, v.y); w.y = pkbf(v.z, v.w); *(u32x2*)(xb + off) = w;
                        ssq += (v.x * v.x + v.y * v.y) + (v.z * v.z + v.w * v.w);
                    }
                ssq += __shfl_xor(ssq, 16); ssq += __shfl_xor(ssq, 32);
                if (fq == 0) unsafeAtomicAdd(partw + row, ssq);
                MEMFENCE();
            }
    }
    DI void memkv(AccRef acc, const pg8::Unit& u, int wr, int wc, int fr, int fq) const {
        const int row0 = u.pm * 256 + wr * 64 + fr, c0 = u.pn * 256 + wc * 32 + 8 * fq;
        const float* part = (const float*)(ws + WS_SSM); bf16_t* xb = (bf16_t*)(ws + WS_CKV);
#pragma unroll
        for (int ai = 0; ai < 2; ++ai)
#pragma unroll
            for (int m = 0; m < 4; ++m) {
                const int row = row0 + ai * 128 + m * 16; const float rs = 1.0f / sqrtf(part[row] * (1.0f / 1024.0f) + EPS);
#pragma unroll
                for (int bj = 0; bj < 2; ++bj) {
                    const f32x4 a = acc[ai][bj][m][0] * rs, b = acc[ai][bj][m][1] * rs;
                    u32x4 w; w.x = pkbf(a.x, a.y); w.y = pkbf(a.z, a.w); w.z = pkbf(b.x, b.y); w.w = pkbf(b.z, b.w);
                    *(u32x4*)(xb + (size_t)row * 1024 + c0 + bj * 128) = w;
                }
            }
    }
    template <int B> DI void branch(AccRef acc, const pg8::Unit& u, int wr, int wc, int fr, int fq) const {
        const int row0 = u.pm * 256 + wr * 64 + fr, c0 = u.pn * 256 + wc * 32 + 4 * fq;
        const bf16_t* gts = (const bf16_t*)(ws + WS_GTS); float* m32 = (float*)(ws + WS_M32); bf16_t* mb16 = (bf16_t*)(ws + WS_MB16);
#pragma unroll
        for (int bj = 0; bj < 2; ++bj)
#pragma unroll
            for (int n = 0; n < 2; ++n) {
                const int col = c0 + bj * 128 + n * 16;
                const f32x4 gb = *(const f32x4*)(kp->mix_gate_b + B * 1024 + col);
#pragma unroll
                for (int ai = 0; ai < 2; ++ai)
#pragma unroll
                    for (int m = 0; m < 4; ++m) {
                        const int row = row0 + ai * 128 + m * 16;
                        const u32x2 gw = *(const u32x2*)(gts + (size_t)row * 3072 + B * 1024 + col);
                        f32x4 gv; gv.x = sigmoidf_(bflo(gw.x) + gb.x); gv.y = sigmoidf_(bfhi(gw.x) + gb.y); gv.z = sigmoidf_(bflo(gw.y) + gb.z); gv.w = sigmoidf_(bfhi(gw.y) + gb.w);
                        f32x4 v = gv * acc[ai][bj][m][n];
                        const size_t off = (size_t)row * DM + col;
                        if (B > 0) v = v + *(const f32x4*)(m32 + off);
                        if (B < 2) *(f32x4*)(m32 + off) = v;
                        else { u32x2 w; w.x = pkbf(v.x, v.y); w.y = pkbf(v.z, v.w); *(u32x2*)(mb16 + off) = w; }
                        if (m & 1) MEMFENCE();
                    }
            }
    }
    DI void win(AccRef acc, const pg8::Unit& u, int wr, int wc, int fr, int fq) const {
        const int row0 = u.pm * 256 + wr * 64 + fr; const int pn = u.pn;
        const float* part = (const float*)(ws + WS_PART + SS_STRIDE) + goff;
        if (pn < 12) {
            const int isk = pn >= 6 ? 1 : 0; const int hh = 4 * (pn - 6 * isk) + wc; const int gi = hh >> 3, sh = 2 * gi;
            const float* gain = isk ? kp->att_k_gain : kp->att_q_gain; const float qs = isk ? 1.0f : 0.125f;
            bf16_t* dst = (bf16_t*)(ws + (isk ? WS_AK : WS_AQ));
            const float* rc = (const float*)(ws + WS_ROPE); const float* rsn = rc + 2048 * 32;
#pragma unroll
            for (int ai = 0; ai < 2; ++ai)
#pragma unroll
                for (int m = 0; m < 4; ++m) {
                    const int row = row0 + ai * 128 + m * 16; const float rs = rstd_part(part, row);
                    const int bl = row >> 11, s = row & 2047;
                    float ss = 0.f;
#pragma unroll
                    for (int bj = 0; bj < 2; ++bj)
#pragma unroll
                        for (int n = 0; n < 2; ++n) { const f32x4 v = acc[ai][bj][m][n]; ss += (v.x * v.x + v.y * v.y) + (v.z * v.z + v.w * v.w); }
                    ss *= rs * rs;
                    ss += __shfl_xor(ss, 16); ss += __shfl_xor(ss, 32);
                    const float rh = rs * qs / sqrtf(ss * (1.0f / 64.0f) + EPS);
                    const int perm = ((s & ((1 << sh) - 1)) << (11 - sh)) + (s >> sh);
                    bf16_t* d = dst + ((size_t)(bl * 24 + hh) * 2048 + perm) * 64 + 8 * fq;
#pragma unroll
                    for (int n = 0; n < 2; ++n) {
                        const f32x4 ga = *(const f32x4*)(gain + 8 * fq + 4 * n), gb = *(const f32x4*)(gain + 32 + 8 * fq + 4 * n);
                        const f32x4 c = *(const f32x4*)(rc + s * 32 + 8 * fq + 4 * n), sn = *(const f32x4*)(rsn + s * 32 + 8 * fq + 4 * n);
                        const f32x4 v1 = acc[ai][0][m][n] * ga * rh, v2 = acc[ai][1][m][n] * gb * rh;
                        const f32x4 o1 = v1 * c - v2 * sn, o2 = v2 * c + v1 * sn;
                        u32x2 w1; w1.x = pkbf(o1.x, o1.y); w1.y = pkbf(o1.z, o1.w);
                        u32x2 w2; w2.x = pkbf(o2.x, o2.y); w2.y = pkbf(o2.z, o2.w);
                        *(u32x2*)(d + 4 * n) = w1; *(u32x2*)(d + 32 + 4 * n) = w2;
                        MEMFENCE();
                    }
                }
        } else if (pn < 18) {
            bf16_t* dst = (bf16_t*)(ws + WS_AV);
#pragma unroll
            for (int bj = 0; bj < 2; ++bj) {
                const int hh = 4 * (pn - 12) + 2 * bj + (wc >> 1), d0 = 32 * (wc & 1) + 8 * fq; const int gi = hh >> 3, sh = 2 * gi;
#pragma unroll
                for (int ai = 0; ai < 2; ++ai)
#pragma unroll
                    for (int m = 0; m < 4; ++m) {
                        const int row = row0 + ai * 128 + m * 16; const float rs = rstd_part(part, row);
                        const int bl = row >> 11, s = row & 2047;
                        const int perm = ((s & ((1 << sh) - 1)) << (11 - sh)) + (s >> sh);
                        const f32x4 a = acc[ai][bj][m][0] * rs, b = acc[ai][bj][m][1] * rs;
                        u32x4 w; w.x = pkbf(a.x, a.y); w.y = pkbf(a.z, a.w); w.z = pkbf(b.x, b.y); w.w = pkbf(b.z, b.w);
                        *(u32x4*)(dst + ((size_t)(bl * 24 + hh) * 2048 + perm) * 64 + d0) = w;
                        if (m & 1) MEMFENCE();
                    }
            }
        } else if (pn < 40) {
            bf16_t* dst; int ld, colt;
            if (pn < 28) { const int seg = (pn - 18) >> 1; dst = (bf16_t*)(ws + WS_MQ) + (size_t)seg * TG * 512; ld = 512; colt = 256 * ((pn - 18) & 1); }
            else { dst = (bf16_t*)(ws + WS_GTS); ld = 3072; colt = 256 * (pn - 28); }
            const int c0 = colt + wc * 32 + 8 * fq;
#pragma unroll
            for (int ai = 0; ai < 2; ++ai)
#pragma unroll
                for (int m = 0; m < 4; ++m) {
                    const int row = row0 + ai * 128 + m * 16; const float rs = rstd_part(part, row);
#pragma unroll
                    for (int bj = 0; bj < 2; ++bj) {
                        const f32x4 a = acc[ai][bj][m][0] * rs, b = acc[ai][bj][m][1] * rs;
                        u32x4 w; w.x = pkbf(a.x, a.y); w.y = pkbf(a.z, a.w); w.z = pkbf(b.x, b.y); w.w = pkbf(b.z, b.w);
                        *(u32x4*)(dst + (size_t)row * ld + c0 + bj * 128) = w;
                    }
                    if (m & 1) MEMFENCE();
                }
        } else {
            if (wc == 0 && fq < 2) {
                float* dst = (float*)(ws + WS_MIF);
#pragma unroll
                for (int ai = 0; ai < 2; ++ai)
#pragma unroll
                    for (int m = 0; m < 4; ++m) {
                        const int row = row0 + ai * 128 + m * 16; const float rs = rstd_part(part, row);
                        *(f32x4*)(dst + (size_t)row * 16 + 8 * fq) = acc[ai][0][m][0] * rs;
                        *(f32x4*)(dst + (size_t)row * 16 + 8 * fq + 4) = acc[ai][0][m][1] * rs;
                    }
            }
        }
    }
    DI void operator()(AccRef acc, const pg8::Unit& u, int wr, int wc, int fr, int fq) const {
        asm volatile("" : "+v"(fr), "+v"(fq));
        switch (kind) {
#ifndef NO_E0
            case EK_SWIGLU: swiglu(acc, u, wr, wc, fr, fq); break;
#endif
#ifndef NO_E1
            case EK_RESID: residual(acc, u, wr, wc, fr, fq); break;
#endif
#ifndef NO_E2
            case EK_WIN: win(acc, u, wr, wc, fr, fq); break;
#endif
#ifndef NO_E3
            case EK_MEMKV: memkv(acc, u, wr, wc, fr, fq); break;
#endif
#ifndef NO_E4
            case EK_BR0: branch<0>(acc, u, wr, wc, fr, fq); break;
            case EK_BR1: branch<1>(acc, u, wr, wc, fr, fq); break;
            default: branch<2>(acc, u, wr, wc, fr, fq); break;
#else
            default: break;
#endif
        }
    }
};

DI void tr_item(const float* __restrict__ W, int ldw, int src0, int nvalid, const float* __restrict__ gain,
                bf16_t* Bt, int K, int n0, int k0, LAS float* scr, int lane) {
    const int nn = lane & 31;
#pragma unroll 8
    for (int i = 0; i < 32; ++i) {
        const int kk = 2 * i + (lane >> 5); float v = 0.f;
        if (nn < nvalid) { v = W[(size_t)(k0 + kk) * ldw + src0 + nn]; if (gain) v *= gain[k0 + kk]; }
        scr[kk * 33 + nn] = v;
    }
    LDS_FENCE();
    const int c = lane & 7;
#pragma unroll
    for (int j = 0; j < 4; ++j) {
        const int n = (lane >> 3) + 8 * j; const LAS float* s = scr + (8 * c) * 33 + n;
        u32x4 o; o.x = pkbf(s[0 * 33], s[1 * 33]); o.y = pkbf(s[2 * 33], s[3 * 33]); o.z = pkbf(s[4 * 33], s[5 * 33]); o.w = pkbf(s[6 * 33], s[7 * 33]);
        *(u32x4*)(Bt + (size_t)(n0 + n) * K + k0 + 8 * c) = o;
    }
    LDS_FENCE();
}
DI void ffn_map(int n0, int& src0) { const int pn = n0 >> 8, bj = (n0 >> 7) & 1, i0 = n0 & 127; src0 = bj * DFF + 128 * pn + i0; }
DI void win_map(int n0, int& src0, int& nvalid) {
    const int pn = n0 >> 8, within = n0 & 255, bj = within >> 7, wc = (within >> 5) & 3; nvalid = 32;
    if (pn < 12) { const int seg = pn >= 6 ? 1 : 0; const int hh = 4 * (pn - 6 * seg) + wc; src0 = seg * 1536 + 64 * hh + 32 * bj; }
    else if (pn < 18) src0 = 3072 + (n0 - 12 * 256);
    else if (pn < 26) src0 = 4608 + (n0 - 18 * 256);
    else if (pn < 28) src0 = 6672 + (n0 - 26 * 256);
    else if (pn < 40) src0 = 7184 + (n0 - 28 * 256);
    else { src0 = 6656; nvalid = (n0 == 10240) ? 16 : 0; }
}
DI void prepass(KPC P, LAS unsigned char* lds, int gw, int NGW, int wave, int lane) {
    LAS float* scr = (LAS float*)(lds + wave * 16384);
    unsigned char* ws = P->ws;
    constexpr int I1 = 16 * 176, I2 = 44 * 32, I3 = 16 * 328, I4 = 16 * 32, I5 = 8 * 32, I6 = 16 * 32;
    constexpr int NIT = I1 + I2 + I3 + I4 + 3 * I5 + I6 + I1 + I2;
    for (int it = gw; it < NIT; it += NGW) {
        int r = it;
        if (r < I1) { const int kb = r / 176, nb = r % 176; int s0; ffn_map(32 * nb, s0); tr_item(P->w_ffn1_in, 2 * DFF, s0, 32, P->norm_ffn1, (bf16_t*)(ws + WS_W1), 1024, 32 * nb, 64 * kb, scr, lane); continue; } r -= I1;
        if (r < I2) { const int kb = r / 32, nb = r % 32; tr_item(P->w_ffn1_out, 1024, 32 * nb, 32, nullptr, (bf16_t*)(ws + WS_W2), DFF, 32 * nb, 64 * kb, scr, lane); continue; } r -= I2;
        if (r < I3) { const int kb = r / 328, nb = r % 328; int s0, nv; win_map(32 * nb, s0, nv); tr_item(P->w_in, NIN, s0, nv, P->norm_mix, (bf16_t*)(ws + WS_WIN), 1024, 32 * nb, 64 * kb, scr, lane); continue; } r -= I3;
        if (r < I4) { const int kb = r / 32, nb = r % 32; tr_item(P->w_mem_kv, 1024, 32 * nb, 32, P->norm_mem, (bf16_t*)(ws + WS_WMEM), 1024, 32 * nb, 64 * kb, scr, lane); continue; } r -= I4;
        if (r < 3 * I5) { const int b = r / I5, q = r % I5, kb = q / 32, nb = q % 32; const float* w = b == 0 ? P->w_br_att : (b == 1 ? P->w_br_ml : P->w_br_cx);
            tr_item(w, 1024, 32 * nb, 32, nullptr, (bf16_t*)(ws + WS_WBR) + (size_t)b * 1024 * 512, 512, 32 * nb, 64 * kb, scr, lane); continue; } r -= 3 * I5;
        if (r < I6) { const int kb = r / 32, nb = r % 32; tr_item(P->w_out, 1024, 32 * nb, 32, nullptr, (bf16_t*)(ws + WS_WOUT), 1024, 32 * nb, 64 * kb, scr, lane); continue; } r -= I6;
        if (r < I1) { const int kb = r / 176, nb = r % 176; int s0; ffn_map(32 * nb, s0); tr_item(P->w_ffn2_in, 2 * DFF, s0, 32, P->norm_ffn2, (bf16_t*)(ws + WS_W3), 1024, 32 * nb, 64 * kb, scr, lane); continue; } r -= I1;
        { const int kb = r / 32, nb = r % 32; tr_item(P->w_ffn2_out, 1024, 32 * nb, 32, nullptr, (bf16_t*)(ws + WS_W4), DFF, 32 * nb, 64 * kb, scr, lane); }
    }
    bf16_t* xb = (bf16_t*)(ws + WS_XB); float* part = (float*)(ws + WS_PART);
    bf16_t* memb = (bf16_t*)(ws + WS_MEMB); float* ssm = (float*)(ws + WS_SSM);
    for (int m = gw; m < T_ + MEMROWS; m += NGW) {
        const bool isx = m < T_; const int row = isx ? m : m - T_;
        const f32x4* xr = (const f32x4*)((isx ? P->x : P->mem) + (size_t)row * DM) + lane;
        unsigned long long* o8 = (unsigned long long*)((isx ? xb : memb) + (size_t)row * DM) + lane;
        float s = 0.f;
#pragma unroll
        for (int j = 0; j < 4; ++j) { const f32x4 v = xr[64 * j]; s += (v.x * v.x + v.y * v.y) + (v.z * v.z + v.w * v.w);
            o8[64 * j] = (unsigned long long)pkbf(v.x, v.y) | ((unsigned long long)pkbf(v.z, v.w) << 32); }
        s = wave_sum(s);
        if (isx) { if (lane < 4) part[(size_t)lane * (SS_STRIDE / 4) + row] = lane == 0 ? s : 0.f; }
        else if (lane == 0) ssm[row] = s;
    }
    float* rc = (float*)(ws + WS_ROPE); float* rsn = rc + 2048 * 32;
    for (int i = gw * 64 + lane; i < 2048 * 32; i += NGW * 64) {
        const int s = i >> 5, d = i & 31; const float inv = powf(10000.0f, -(float)(2 * d) / 64.0f); const float ang = (float)s * inv;
        rc[i] = cosf(ang); rsn[i] = sinf(ang);
    }
}

DI void cknorm(KPC P, int gw, int NGW, int lane) {
    bf16_t* ckv = (bf16_t*)(P->ws + WS_CKV);
    for (int it = gw; it < MEMROWS * 4; it += NGW) {
        const int row = it >> 2, hd = it & 3; unsigned* p = (unsigned*)(ckv + (size_t)row * 1024 + hd * 128) + lane;
        const unsigned w = *p; const float a = bflo(w), b = bfhi(w);
        const float ss = wave_sum(a * a + b * b); const float rs = 1.0f / sqrtf(ss * (1.0f / 128.0f) + EPS);
        *p = pkbf(a * rs * P->cx_k_gain[2 * lane], b * rs * P->cx_k_gain[2 * lane + 1]);
    }
}

template <int D, int NKB, bool BAND>
DI void attn_pass(const bf16_t* Kb, const bf16_t* Vb, long pitch, unsigned vmask, const bf16x8 (&qf)[D / 16],
                  float& m, float& l, f32x16 (&o)[D / 32], LAS unsigned char* vs, int lane) {
    const int r = lane & 31, h = lane >> 5;
    f32x16 st[NKB];
#pragma unroll
    for (int kb = 0; kb < NKB; ++kb) {
        if (vmask & (1u << kb)) {
            const bf16_t* kr = Kb + (long)(32 * kb + r) * pitch + 8 * h;
            f32x16 a = zero16();
#pragma unroll
            for (int ks = 0; ks < D / 16; ++ks) a = mfma32(*(const bf16x8*)(kr + 16 * ks), qf[ks], a);
            st[kb] = a;
            MEMFENCE();
        } else {
#pragma unroll
            for (int i = 0; i < 16; ++i) st[kb][i] = NEGF;
        }
    }
    if (BAND) {
#pragma unroll
        for (int i = 0; i < 16; ++i) { const int jj = crow(i, h); if (jj < r) st[0][i] = NEGF; if (jj > r) st[NKB - 1][i] = NEGF; }
    }
    float bm = NEGF;
#pragma unroll
    for (int kb = 0; kb < NKB; ++kb)
#pragma unroll
        for (int i = 0; i < 16; ++i) bm = fmaxf(bm, st[kb][i]);
    bm = fmaxf(bm, __shfl_xor(bm, 32));
    const float mn = fmaxf(m, bm); const float alpha = __expf(m - mn);
    float ls = 0.f;
#pragma unroll
    for (int kb = 0; kb < NKB; ++kb)
#pragma unroll
        for (int i = 0; i < 16; ++i) { const float p = __expf(st[kb][i] - mn); st[kb][i] = p; ls += p; }
    ls += __shfl_xor(ls, 32);
    l = l * alpha + ls; m = mn;
#pragma unroll
    for (int d0 = 0; d0 < D / 32; ++d0)
#pragma unroll
        for (int i = 0; i < 16; ++i) o[d0][i] *= alpha;
    const int q4 = (lane & 15) >> 2, p4 = lane & 3, blk = (lane >> 4) & 1;
    LAS unsigned char* vrd = vs + q4 * (2 * D) + 32 * blk + 8 * p4;
#pragma unroll
    for (int kb = 0; kb < NKB; ++kb) {
        if (vmask & (1u << kb)) {
            constexpr int CPR = D / 8;
#pragma unroll
            for (int t = 0; t < (32 * CPR) / 64; ++t) {
                const int ci = lane + 64 * t, row = ci / CPR, ch = ci % CPR;
                const u32x4 v = *(const u32x4*)(Vb + (long)(32 * kb + row) * pitch + 8 * ch);
                *(LAS u32x4*)(vs + row * (2 * D) + ch * 16) = v;
                if ((t & 3) == 3) MEMFENCE();
            }
            LDS_FENCE();
#pragma unroll
            for (int ks2 = 0; ks2 < 2; ++ks2) {
                const bf16x8 pb = pack8(st[kb], ks2);
#pragma unroll
                for (int d0 = 0; d0 < D / 32; ++d0) {
                    const s16x4 lo = trread(vrd + (16 * ks2 + 4 * h) * (2 * D) + 64 * d0);
                    const s16x4 hi = trread(vrd + (16 * ks2 + 8 + 4 * h) * (2 * D) + 64 * d0);
                    o[d0] = mfma32(cat44(lo, hi), pb, o[d0]);
                }
            }
            LDS_FENCE();
        }
    }
}

DI void att_unit(unsigned char* ws, int u, LAS unsigned char* vs, int lane, bool dry) {
    const int r = lane & 31, h = lane >> 5;
    const int qblk = u & 63, hb = u >> 6, head = hb % 24, bl = hb / 24;
    const int gi = head >> 3, slot = head & 7, sh = 2 * gi, n = 2048 >> sh;
    const int prow = 32 * qblk, c = prow >> (11 - sh), i0 = prow & (n - 1);
    const size_t hbase = (size_t)(bl * 24 + head) * 2048 * 64;
    bf16_t* Q = (bf16_t*)(ws + WS_AQ) + hbase; const bf16_t* K = (const bf16_t*)(ws + WS_AK) + hbase; const bf16_t* V = (const bf16_t*)(ws + WS_AV) + hbase;
    bf16x8 qf[4];
#pragma unroll
    for (int ks = 0; ks < 4; ++ks) qf[ks] = *(const bf16x8*)(Q + (size_t)(prow + r) * 64 + 16 * ks + 8 * h);
    unsigned vmask = 0;
#pragma unroll
    for (int kb = 0; kb < 5; ++kb) { const int j0 = i0 - 64 + 32 * kb; if (j0 >= 0 && j0 < n) vmask |= 1u << kb; }
    vmask = __builtin_amdgcn_readfirstlane(vmask);
    float m = NEGF, l = 0.f; f32x16 o[2]; o[0] = zero16(); o[1] = zero16();
    attn_pass<64, 5, true>(K + (long)(prow - 64) * 64, V + (long)(prow - 64) * 64, 64, vmask, qf, m, l, o, vs, lane);
    if (dry) return;
    const float inv = 1.0f / l;
    bf16_t* orow = Q + (size_t)(prow + r) * 64;
#pragma unroll
    for (int d0 = 0; d0 < 2; ++d0)
#pragma unroll
        for (int g4 = 0; g4 < 4; ++g4) {
            u32x2 w; w.x = pkbf(o[d0][4 * g4] * inv, o[d0][4 * g4 + 1] * inv); w.y = pkbf(o[d0][4 * g4 + 2] * inv, o[d0][4 * g4 + 3] * inv);
            *(u32x2*)(orow + 32 * d0 + 8 * g4 + 4 * h) = w;
        }
    if (h == 0) {
        const int s = c + ((i0 + r) << sh);
        float* lse = (float*)(ws + WS_LSE);
        lse[((size_t)gi * TG + (size_t)bl * 2048 + s) * 8 + slot] = m + __logf(l);
    }
}

DI void cross_unit(KPC P, int grp, int u, LAS unsigned char* vs, int lane, bool dry) {
    const int r = lane & 31, h = lane >> 5;
    const int qblk = u & 63, head = (u >> 6) & 3, bl = u >> 8;
    bf16_t* qrow = (bf16_t*)(P->ws + WS_CQ) + ((size_t)bl * 2048 + 32 * qblk + r) * 512 + head * 128;
    bf16x8 qf[8]; float ss = 0.f;
#pragma unroll
    for (int ks = 0; ks < 8; ++ks) { qf[ks] = *(const bf16x8*)(qrow + 16 * ks + 8 * h);
        const u32x4 w = __builtin_bit_cast(u32x4, qf[ks]);
        ss += (bflo(w.x) * bflo(w.x) + bfhi(w.x) * bfhi(w.x)) + (bflo(w.y) * bflo(w.y) + bfhi(w.y) * bfhi(w.y)) + (bflo(w.z) * bflo(w.z) + bfhi(w.z) * bfhi(w.z)) + (bflo(w.w) * bflo(w.w) + bfhi(w.w) * bfhi(w.w)); }
    ss += __shfl_xor(ss, 32);
    const float rq = (1.0f / sqrtf(ss * (1.0f / 128.0f) + EPS)) * 0.08838834764831845f;
#pragma unroll
    for (int ks = 0; ks < 8; ++ks) {
        const u32x4 w = __builtin_bit_cast(u32x4, qf[ks]); const float* g = P->cx_q_gain + 16 * ks + 8 * h;
        const f32x4 ga = *(const f32x4*)g, gb = *(const f32x4*)(g + 4);
        u32x4 o; o.x = pkbf(bflo(w.x) * rq * ga.x, bfhi(w.x) * rq * ga.y); o.y = pkbf(bflo(w.y) * rq * ga.z, bfhi(w.y) * rq * ga.w);
        o.z = pkbf(bflo(w.z) * rq * gb.x, bfhi(w.z) * rq * gb.y); o.w = pkbf(bflo(w.w) * rq * gb.z, bfhi(w.w) * rq * gb.w);
        qf[ks] = __builtin_bit_cast(bf16x8, o);
    }
    const bf16_t* K = (const bf16_t*)(P->ws + WS_CKV) + (size_t)(grp * BL + bl) * 256 * 1024 + head * 128;
    const bf16_t* V = K + 512;
    float m = NEGF, l = 0.f; f32x16 o[4];
#pragma unroll
    for (int d0 = 0; d0 < 4; ++d0) o[d0] = zero16();
#pragma unroll 1
    for (int ps = 0; ps < 4; ++ps) attn_pass<128, 2, false>(K + (size_t)ps * 64 * 1024, V + (size_t)ps * 64 * 1024, 1024, 0x3u, qf, m, l, o, vs, lane);
    if (dry) return;
    const float inv = 1.0f / l;
#pragma unroll
    for (int d0 = 0; d0 < 4; ++d0)
#pragma unroll
        for (int g4 = 0; g4 < 4; ++g4) {
            u32x2 w; w.x = pkbf(o[d0][4 * g4] * inv, o[d0][4 * g4 + 1] * inv); w.y = pkbf(o[d0][4 * g4 + 2] * inv, o[d0][4 * g4 + 3] * inv);
            *(u32x2*)(qrow + 32 * d0 + 8 * g4 + 4 * h) = w;
        }
}

DI float scan_add(float v, int lane) {
#pragma unroll
    for (int d = 1; d < 64; d <<= 1) { const float t = __shfl_up(v, d); if (lane >= d) v += t; }
    return v;
}
DI float scan_max(float v, int lane) {
#pragma unroll
    for (int d = 1; d < 64; d <<= 1) { const float t = __shfl_up(v, d); if (lane >= d) v = fmaxf(v, t); }
    return v;
}
DI float log_sigmoid(float x) { return x >= 0.f ? -log1pf(__expf(-x)) : x - log1pf(__expf(x)); }

DI void mlstm_chain(KPC P, LAS unsigned char* lds, int bl, int head, int dir, const int tid0) {
    int tid = tid0; const int wave = __builtin_amdgcn_readfirstlane(tid0 >> 6);
    unsigned char* ws = P->ws; asm volatile("" : "+s"(ws));
    const bf16_t* MQ = (const bf16_t*)(ws + WS_MQ); const bf16_t* MK = (const bf16_t*)(ws + WS_MK); const bf16_t* MV = (const bf16_t*)(ws + WS_MV);
    const float* MIF = (const float*)(ws + WS_MIF);
    bf16_t* Hout = (bf16_t*)(ws + (dir ? WS_HB : WS_HF));
    LAS unsigned char* QI = lds; LAS unsigned char* KI = lds + 32768; LAS unsigned char* VI = lds + 65536; LAS unsigned char* CI = lds + 98304;
    LAS float* tg = (LAS float*)(lds + TB_OFF); LAS float* tM = tg + 128; LAS float* tbc = tg + 256; LAS float* twk = tg + 384; LAS float* tnv = tg + 512;
    LAS float* scal = tg + 640; LAS float* cw = tg + 656; LAS float* cb = cw + 5 * 256;
    for (int i = tid; i < 5 * 256; i += 512) { const int j = i >> 8, c = i & 255; cw[i] = P->ml_conv_w[j * 1024 + (c >> 7) * 512 + head * 128 + (c & 127)]; }
    if (tid < 256) cb[tid] = P->ml_conv_b[(tid >> 7) * 512 + head * 128 + (tid & 127)];
    for (int i = tid; i < 32768 / 16; i += 512) *(LAS u32x4*)(CI + i * 16) = (u32x4){0u, 0u, 0u, 0u};
    if (tid < 128) tnv[tid] = 0.f;
    f32x16 cacc[2]; float nst[2] = {0.f, 0.f};
    cacc[0] = zero16(); cacc[1] = zero16();
    float mcur = 0.f;
    const float bli = P->ml_gate_b[(dir ? 8 : 0) + head], blf = P->ml_gate_b[(dir ? 12 : 4) + head];
    __syncthreads();
#define CHAIN_LANES() asm volatile("" : "+v"(tid)); const int lane = tid & 63, r = lane & 31, h = lane >> 5; const int trofs = ((lane & 15) >> 2) * 256 + 32 * ((lane >> 4) & 1) + 8 * (lane & 3); (void)r; (void)h; (void)trofs
#pragma unroll 1
    for (int ci = 0; ci < 16; ++ci) {
        {
            CHAIN_LANES();
            const size_t rowb = (size_t)bl * 2048;
            {
                const int sel = tid >> 8, cg8 = tid & 15, seg = (tid >> 4) & 15;
                const int tl0 = 128 * ci + 8 * seg;
                const int pmin = dir ? 2047 - (tl0 + 7) : tl0;
                const bf16_t* src = (sel ? MK : MQ) + head * 128 + 8 * cg8;
                u32x4 raw[12];
#pragma unroll
                for (int i = 0; i < 12; ++i) { const int pp = pmin - 2 + i; raw[i] = (u32x4){0u, 0u, 0u, 0u}; if (pp >= 0 && pp < 2048) raw[i] = *(const u32x4*)(src + (rowb + pp) * 512); }
                float wv[5][8], bv[8];
#pragma unroll
                for (int j = 0; j < 5; ++j)
#pragma unroll
                    for (int e = 0; e < 8; ++e) wv[j][e] = cw[j * 256 + sel * 128 + 8 * cg8 + e];
#pragma unroll
                for (int e = 0; e < 8; ++e) bv[e] = cb[sel * 128 + 8 * cg8 + e];
                const float osc = sel ? 1.0f : 0.08838834764831845f;
                LAS unsigned char* dstb = (sel ? KI : QI) + cg8 * 16;
#pragma unroll
                for (int i = 0; i < 8; ++i) {
                    float a[8];
#pragma unroll
                    for (int e = 0; e < 8; ++e) a[e] = bv[e];
#pragma unroll
                    for (int j = 0; j < 5; ++j) {
                        const u32x4 w = raw[i + j];
                        a[0] += wv[j][0] * bflo(w.x); a[1] += wv[j][1] * bfhi(w.x); a[2] += wv[j][2] * bflo(w.y); a[3] += wv[j][3] * bfhi(w.y);
                        a[4] += wv[j][4] * bflo(w.z); a[5] += wv[j][5] * bfhi(w.z); a[6] += wv[j][6] * bflo(w.w); a[7] += wv[j][7] * bfhi(w.w);
                    }
#pragma unroll
                    for (int e = 0; e < 8; ++e) a[e] = a[e] * sigmoidf_(a[e]) * osc;
                    u32x4 o; o.x = pkbf(a[0], a[1]); o.y = pkbf(a[2], a[3]); o.z = pkbf(a[4], a[5]); o.w = pkbf(a[6], a[7]);
                    const int tl = dir ? (8 * seg + 7 - i) : (8 * seg + i);
                    *(LAS u32x4*)(dstb + tl * 256) = o;
                }
            }
            {
                const int t = tid >> 2, c0 = (tid & 3) * 32; const int tau = 128 * ci + t; const int p = dir ? 2047 - tau : tau;
                const bf16_t* vsrc = MV + (rowb + p) * 512 + head * 128 + c0;
#pragma unroll
                for (int sub = 0; sub < 4; ++sub) *(LAS u32x4*)(VI + t * 256 + c0 * 2 + sub * 16) = *(const u32x4*)(vsrc + 8 * sub);
            }
        }
        if (wave == 0) {
            CHAIN_LANES();
            const int tau1 = 128 * ci + lane, tau2 = tau1 + 64; const int p1 = dir ? 2047 - tau1 : tau1, p2 = dir ? 2047 - tau2 : tau2;
            const float* r1 = MIF + ((size_t)bl * 2048 + p1) * 16 + head; const float* r2 = MIF + ((size_t)bl * 2048 + p2) * 16 + head;
            const float li1 = r1[dir ? 8 : 0] + bli, li2 = r2[dir ? 8 : 0] + bli;
            const float lf1 = log_sigmoid(r1[dir ? 12 : 4] + blf), lf2 = log_sigmoid(r2[dir ? 12 : 4] + blf);
            const float c1 = scan_add(lf1, lane); const float tot1 = __shfl(c1, 63); const float c2 = scan_add(lf2, lane) + tot1;
            const float g1 = li1 - c1, g2 = li2 - c2;
            const float x1 = scan_max(g1, lane); const float mx1 = __shfl(x1, 63); const float x2 = fmaxf(scan_max(g2, lane), mx1);
            const float gtot = __shfl(c2, 63), gmax = __shfl(x2, 63);
            const float mnew = gtot + fmaxf(mcur, gmax);
            tg[lane] = g1; tg[64 + lane] = g2; tM[lane] = fmaxf(x1, mcur); tM[64 + lane] = fmaxf(x2, mcur); tbc[lane] = c1; tbc[64 + lane] = c2;
            twk[lane] = __expf(g1 + gtot - mnew); twk[64 + lane] = __expf(g2 + gtot - mnew);
            if (lane == 0) { scal[0] = mcur; scal[1] = __expf(gtot + mcur - mnew); }
            mcur = mnew;
        }
        __syncthreads();
        {
            CHAIN_LANES();
            const int tb = wave >> 1, vh = wave & 1; const int t = 32 * tb + r;
            const float Mt = tM[t], bct = tbc[t], mold = scal[0];
            const float winter = __expf(mold - Mt), flo = __expf(-(Mt + bct));
            bf16x8 qf[8];
#pragma unroll
            for (int ks = 0; ks < 8; ++ks) qf[ks] = *(const LAS bf16x8*)(QI + t * 256 + (16 * ks + 8 * h) * 2);
            f32x16 na[2]; na[0] = zero16(); na[1] = zero16();
            float den = 0.f;
            for (int sb = 0; sb <= tb; ++sb) {
                f32x16 st = zero16();
#pragma unroll
                for (int ks = 0; ks < 8; ++ks) st = mfma32(*(const LAS bf16x8*)(KI + (32 * sb + r) * 256 + (16 * ks + 8 * h) * 2), qf[ks], st);
                MEMFENCE();
#pragma unroll
                for (int i = 0; i < 16; ++i) {
                    const int sl = crow(i, h); const float wgt = __expf(tg[32 * sb + sl] - Mt);
                    const bool valid = (sb < tb) || (sl <= r);
                    const float v = valid ? st[i] * wgt : 0.f; st[i] = v; den += v;
                }
#pragma unroll
                for (int ks2 = 0; ks2 < 2; ++ks2) {
                    const bf16x8 pb = pack8(st, ks2);
#pragma unroll
                    for (int jv = 0; jv < 2; ++jv) {
                        LAS unsigned char* vp = VI + trofs + (32 * sb + 16 * ks2 + 4 * h) * 256 + 64 * (2 * vh + jv);
                        const s16x4 lo = trread(vp), hi = trread(vp + 8 * 256);
                        na[jv] = mfma32(cat44(lo, hi), pb, na[jv]);
                    }
                }
            }
            den += __shfl_xor(den, 32);
            float dq = 0.f;
#pragma unroll
            for (int ks = 0; ks < 8; ++ks) {
                const u32x4 w = __builtin_bit_cast(u32x4, qf[ks]); const LAS float* nv = tnv + 16 * ks + 8 * h;
                const float q0 = bflo(w.x), q1 = bfhi(w.x), q2 = bflo(w.y), q3 = bfhi(w.y), q4_ = bflo(w.z), q5 = bfhi(w.z), q6 = bflo(w.w), q7 = bfhi(w.w);
                dq += (nv[0] * q0 + nv[1] * q1) + (nv[2] * q2 + nv[3] * q3) + (nv[4] * q4_ + nv[5] * q5) + (nv[6] * q6 + nv[7] * q7);
                u32x4 o; o.x = pkbf(q0 * winter, q1 * winter); o.y = pkbf(q2 * winter, q3 * winter); o.z = pkbf(q4_ * winter, q5 * winter); o.w = pkbf(q6 * winter, q7 * winter);
                const bf16x8 qs = __builtin_bit_cast(bf16x8, o);
#pragma unroll
                for (int jv = 0; jv < 2; ++jv)
                    na[jv] = mfma32(*(const LAS bf16x8*)(CI + (32 * (2 * vh + jv) + r) * 256 + (16 * ks + 8 * h) * 2), qs, na[jv]);
            }
            dq += __shfl_xor(dq, 32);
            den += winter * dq;
            const float inv = 1.0f / fmaxf(fabsf(den), flo);
            const int tau = 128 * ci + t; const int p = dir ? 2047 - tau : tau;
            bf16_t* dst = Hout + ((size_t)bl * 2048 + p) * 512 + head * 128;
#pragma unroll
            for (int jv = 0; jv < 2; ++jv)
#pragma unroll
                for (int g4 = 0; g4 < 4; ++g4) {
                    u32x2 w; w.x = pkbf(na[jv][4 * g4] * inv, na[jv][4 * g4 + 1] * inv); w.y = pkbf(na[jv][4 * g4 + 2] * inv, na[jv][4 * g4 + 3] * inv);
                    *(u32x2*)(dst + 32 * (2 * vh + jv) + 8 * g4 + 4 * h) = w;
                }
        }
        __syncthreads();
        {
            CHAIN_LANES();
            const int s = tid >> 2, c0 = (tid & 3) * 32; const float wks = twk[s];
#pragma unroll
            for (int sub = 0; sub < 4; ++sub) {
                LAS u32x4* pp = (LAS u32x4*)(KI + s * 256 + c0 * 2 + sub * 16); const u32x4 w = *pp;
                u32x4 o; o.x = pkbf(bflo(w.x) * wks, bfhi(w.x) * wks); o.y = pkbf(bflo(w.y) * wks, bfhi(w.y) * wks); o.z = pkbf(bflo(w.z) * wks, bfhi(w.z) * wks); o.w = pkbf(bflo(w.w) * wks, bfhi(w.w) * wks);
                *pp = o;
            }
        }
        __syncthreads();
        {
            CHAIN_LANES();
            const int vb = wave >> 1, kh = wave & 1; const float decay = scal[1];
#pragma unroll
            for (int jk = 0; jk < 2; ++jk)
#pragma unroll
                for (int i = 0; i < 16; ++i) cacc[jk][i] *= decay;
            f32x16 ntmp[2]; ntmp[0] = zero16(); ntmp[1] = zero16();
            const bf16x8 ones = (bf16x8){0x3F80, 0x3F80, 0x3F80, 0x3F80, 0x3F80, 0x3F80, 0x3F80, 0x3F80};
#pragma unroll
            for (int ks = 0; ks < 8; ++ks) {
                LAS unsigned char* vp = VI + trofs + (16 * ks + 8 * h) * 256 + 64 * vb;
                const bf16x8 af = cat44(trread(vp), trread(vp + 4 * 256));
#pragma unroll
                for (int jk = 0; jk < 2; ++jk) {
                    LAS unsigned char* kp = KI + trofs + (16 * ks + 8 * h) * 256 + 64 * (2 * kh + jk);
                    const bf16x8 bfr = cat44(trread(kp), trread(kp + 4 * 256));
                    cacc[jk] = mfma32(af, bfr, cacc[jk]);
                    if (vb == 0) ntmp[jk] = mfma32(ones, bfr, ntmp[jk]);
                }
            }
#pragma unroll
            for (int jk = 0; jk < 2; ++jk) {
                const int kcol = 32 * (2 * kh + jk) + r;
#pragma unroll
                for (int i = 0; i < 16; i += 1) {
                    const unsigned short v = (unsigned short)(pkbf(cacc[jk][i], 0.f) & 0xffffu);
                    *(LAS unsigned short*)(CI + (32 * vb + crow(i, h)) * 256 + kcol * 2) = v;
                }
                nst[jk] = nst[jk] * decay + ntmp[jk][0];
                if (vb == 0 && h == 0) tnv[kcol] = nst[jk];
            }
        }
        __syncthreads();
    }
}

DI void merge_pass(KPC P, int gw, int NGW, int lane) {
    unsigned char* ws = P->ws;
    const bf16_t* AO = (const bf16_t*)(ws + WS_AQ); const float* LSE = (const float*)(ws + WS_LSE);
    const bf16_t* HF = (const bf16_t*)(ws + WS_HF); const bf16_t* HB = (const bf16_t*)(ws + WS_HB); const bf16_t* MO = (const bf16_t*)(ws + WS_MO);
    bf16_t* YA = (bf16_t*)(ws + WS_YATT); bf16_t* YM = (bf16_t*)(ws + WS_YML);
    for (int tok = gw; tok < TG; tok += NGW) {
        const int bl = tok >> 11, s = tok & 2047;
        {
            const int slot = lane >> 3, d0 = 8 * (lane & 7);
            float ls[3], mx = NEGF;
#pragma unroll
            for (int g = 0; g < 3; ++g) { ls[g] = LSE[((size_t)g * TG + tok) * 8 + slot]; mx = fmaxf(mx, ls[g]); }
            float e[3], sum = 0.f;
#pragma unroll
            for (int g = 0; g < 3; ++g) { e[g] = __expf(ls[g] - mx); sum += e[g]; }
            const float isum = 1.0f / sum;
            float acc[8];
#pragma unroll
            for (int k = 0; k < 8; ++k) acc[k] = 0.f;
#pragma unroll
            for (int g = 0; g < 3; ++g) {
                const int sh = 2 * g; const int perm = ((s & ((1 << sh) - 1)) << (11 - sh)) + (s >> sh);
                const u32x4 w = *(const u32x4*)(AO + ((size_t)(bl * 24 + g * 8 + slot) * 2048 + perm) * 64 + d0);
                const float a = e[g] * isum;
                acc[0] += a * bflo(w.x); acc[1] += a * bfhi(w.x); acc[2] += a * bflo(w.y); acc[3] += a * bfhi(w.y);
                acc[4] += a * bflo(w.z); acc[5] += a * bfhi(w.z); acc[6] += a * bflo(w.w); acc[7] += a * bfhi(w.w);
            }
            u32x4 o; o.x = pkbf(acc[0], acc[1]); o.y = pkbf(acc[2], acc[3]); o.z = pkbf(acc[4], acc[5]); o.w = pkbf(acc[6], acc[7]);
            *(u32x4*)(YA + (size_t)tok * 512 + slot * 64 + d0) = o;
        }
        {
            const size_t off = (size_t)tok * 512 + 8 * lane;
            const u32x4 a = *(const u32x4*)(HF + off), b = *(const u32x4*)(HB + off), mo = *(const u32x4*)(MO + off);
            float v[8];
            v[0] = bflo(a.x) + bflo(b.x); v[1] = bfhi(a.x) + bfhi(b.x); v[2] = bflo(a.y) + bflo(b.y); v[3] = bfhi(a.y) + bfhi(b.y);
            v[4] = bflo(a.z) + bflo(b.z); v[5] = bfhi(a.z) + bfhi(b.z); v[6] = bflo(a.w) + bflo(b.w); v[7] = bfhi(a.w) + bfhi(b.w);
            float ss = 0.f;
#pragma unroll
            for (int k = 0; k < 8; ++k) ss += v[k] * v[k];
            ss += __shfl_xor(ss, 1); ss += __shfl_xor(ss, 2); ss += __shfl_xor(ss, 4); ss += __shfl_xor(ss, 8);
            const float rs = 1.0f / sqrtf(ss * (1.0f / 128.0f) + EPS);
            const f32x4 ga = *(const f32x4*)(P->ml_out_gain + 8 * lane), gb = *(const f32x4*)(P->ml_out_gain + 8 * lane + 4);
            float mg[8]; mg[0] = bflo(mo.x); mg[1] = bfhi(mo.x); mg[2] = bflo(mo.y); mg[3] = bfhi(mo.y); mg[4] = bflo(mo.z); mg[5] = bfhi(mo.z); mg[6] = bflo(mo.w); mg[7] = bfhi(mo.w);
            const float gg[8] = {ga.x, ga.y, ga.z, ga.w, gb.x, gb.y, gb.z, gb.w};
            float y[8];
#pragma unroll
            for (int k = 0; k < 8; ++k) y[k] = v[k] * rs * gg[k] * sigmoidf_(mg[k]);
            u32x4 o; o.x = pkbf(y[0], y[1]); o.y = pkbf(y[2], y[3]); o.z = pkbf(y[4], y[5]); o.w = pkbf(y[6], y[7]);
            *(u32x4*)(YM + off) = o;
        }
    }
}

DI void final_norm(KPC P, int gw, int NGW, int lane) {
    const float* part = (const float*)(P->ws + WS_PART + 3 * SS_STRIDE);
    for (int row = gw; row < T_; row += NGW) {
        const float rs = rstd_part(part, row);
        f32x4* xr = (f32x4*)(P->out + (size_t)row * DM) + lane; const f32x4* gr = (const f32x4*)P->norm_final + lane;
#pragma unroll
        for (int j = 0; j < 4; ++j) { const f32x4 v = xr[64 * j]; xr[64 * j] = v * rs * gr[64 * j]; }
    }
}

#define XB_TMO      128
#define XB_XCNT(j)  (256  + 64 * (j))
#define XB_XSUB(j)  (1280 + 64 * (j))
#define XB_XGEN(j)  (2304 + 64 * (j))
#define XB_TOP      3328
#define XB_TOPGEN   3392
#define XCD_BAR_WORDS 3456
#define XB_SPIN_CAP (1u << 22)
DI unsigned xb_ld(unsigned* p)              { return __hip_atomic_load(p, __ATOMIC_RELAXED, __HIP_MEMORY_SCOPE_AGENT); }
DI unsigned xb_add(unsigned* p, unsigned v) { return __hip_atomic_fetch_add(p, v, __ATOMIC_RELAXED, __HIP_MEMORY_SCOPE_AGENT); }
DI unsigned xb_xcc_id() { return (unsigned)__builtin_amdgcn_s_getreg((3 << 11) | 20) & 0xFu; }
#define XB_SPIN(cond, bar) do { unsigned _sp = 0; while (cond) { __builtin_amdgcn_s_sleep(1); \
    if ((++_sp & 255u) == 0u) { if (xb_ld(&(bar)[XB_TMO])) break; if (_sp > XB_SPIN_CAP) { atomicAdd(&(bar)[XB_TMO], 1u); break; } } } } while (0)
struct XcdBarrier { unsigned* bar; unsigned x; volatile LAS unsigned* st; };
DI XcdBarrier xcd_barrier_post(unsigned* bar, volatile LAS unsigned* st) {
    XcdBarrier b; b.bar = bar; b.x = xb_xcc_id(); b.st = st;
    if (threadIdx.x == 0) (void)xb_add(&bar[XB_XCNT(b.x)], 1u);
    return b;
}
DI void xcd_barrier_complete(unsigned* bar, unsigned x, unsigned& nloc, unsigned& nx) {
    const unsigned G = gridDim.x * gridDim.y * gridDim.z;
    unsigned sum, cnt, mine, sp = 0u;
    for (;;) {
        sum = 0u; cnt = 0u; mine = 0u;
#pragma unroll
        for (unsigned j = 0; j < 16; ++j) { const unsigned c = xb_ld(&bar[XB_XCNT(j)]); sum += c; cnt += (c > 0u) ? 1u : 0u; mine = (j == x) ? c : mine; }
        if (sum == G) break;
        __builtin_amdgcn_s_sleep(1);
        if ((++sp & 255u) == 0u) { if (xb_ld(&bar[XB_TMO])) break; if (sp > XB_SPIN_CAP) { atomicAdd(&bar[XB_TMO], 1u); break; } }
    }
    nloc = mine > 0u ? mine : 1u; nx = cnt > 0u ? cnt : 1u;
}
DI void xcd_barrier(const XcdBarrier& b) {
    asm volatile("s_waitcnt vmcnt(0)" ::: "memory");
    __syncthreads();
    if (threadIdx.x == 0) {
        unsigned* bar = b.bar;
        __builtin_amdgcn_s_waitcnt(0);
        unsigned nloc = b.st[0], nx = b.st[1];
        if (nloc == 0u) { xcd_barrier_complete(bar, b.x, nloc, nx); b.st[0] = nloc; b.st[1] = nx; }
        const unsigned old = xb_add(&bar[XB_XSUB(b.x)], 1u);
        const unsigned gen = old / nloc;
        if (old + 1u == (gen + 1u) * nloc) {
            __builtin_amdgcn_fence(__ATOMIC_RELEASE, "agent");
            asm volatile("s_waitcnt vmcnt(0)" ::: "memory");
            const unsigned og = xb_add(&bar[XB_TOP], 1u);
            const unsigned tg = og / nx;
            if (og + 1u == (tg + 1u) * nx) xb_add(&bar[XB_TOPGEN], 1u);
            else XB_SPIN(xb_ld(&bar[XB_TOPGEN]) == tg, bar);
            __builtin_amdgcn_fence(__ATOMIC_ACQUIRE, "agent");
            xb_add(&bar[XB_XGEN(b.x)], 1u);
            asm volatile("s_waitcnt vmcnt(0)" ::: "memory");
        } else {
            XB_SPIN(xb_ld(&bar[XB_XGEN(b.x)]) == gen, bar);
            __builtin_amdgcn_fence(__ATOMIC_ACQUIRE, "agent");
            asm volatile("s_waitcnt vmcnt(0)" ::: "memory");
        }
    }
    __syncthreads();
}

__global__ void __launch_bounds__(512, 2) mega_fwd(KP Pv, int step_lo, int step_hi, int coop) {
    extern __shared__ __attribute__((aligned(16))) unsigned char lds_raw[];
    LAS unsigned char* lds = (LAS unsigned char*)lds_raw;
    const int G = gridDim.x, NGW = G * 8;
    cg::grid_group grid = cg::this_grid();
    volatile LAS unsigned* misc = (volatile LAS unsigned*)(lds + LDS_BYTES - 256);
    if (threadIdx.x < 8) misc[threadIdx.x] = 0u;
    __syncthreads();
    XcdBarrier xbar = xcd_barrier_post((unsigned*)(Pv.ws + WS_CTL) + 4096, misc);
#pragma unroll 1
    for (int step = step_lo; step < step_hi; ++step) {
        int tid = threadIdx.x; asm volatile("" : "+v"(tid));
        const int lane = tid & 63, wave = __builtin_amdgcn_readfirstlane(tid >> 6);
        int bid = blockIdx.x; asm volatile("" : "+s"(bid));
        const int gw = bid * 8 + wave;
        KPC P = (KPC)__builtin_amdgcn_kernarg_segment_ptr(); asm volatile("" : "+s"(P));
        unsigned char* ws = P->ws; asm volatile("" : "+s"(ws));
        unsigned* ctl = (unsigned*)(ws + WS_CTL);
        bool is_gemm = false, do_sync = true, perm = true;
        pg8::Gemm g{nullptr, nullptr, 0, 0, 0};
        EpiAny E; E.kind = 0; E.aux = 0; E.goff = 0; E.ws = ws; E.kp = P;
        bf16_t* xb = (bf16_t*)(ws + WS_XB);
        int grp = 0, sub = -1;
        if (step >= 5 && step < 19) { grp = (step - 5) / 7; sub = (step - 5) % 7; }
        const int goff = grp * TG;
        if (step == 0) {
#ifndef REP_PRE
#define REP_PRE 1
#endif
            prepass(P, lds, gw, NGW, wave, lane);
            if (REP_PRE > 1) { __syncthreads(); prepass(P, lds, gw, NGW, wave, lane); }
        } else if (step == 1) {
            is_gemm = true; do_sync = false; g = pg8::Gemm{xb, (const bf16_t*)(ws + WS_W1), T_, 2 * DFF, 1024};
            E.kind = EK_SWIGLU;
        } else if (step == 2) {
            is_gemm = true; g = pg8::Gemm{(const bf16_t*)(ws + WS_MEMB), (const bf16_t*)(ws + WS_WMEM), MEMROWS, 1024, 1024};
            E.kind = EK_MEMKV;
        } else if (step == 3) {
            cknorm(P, gw, NGW, lane); do_sync = false;
        } else if (step == 4) {
            is_gemm = true; perm = false; g = pg8::Gemm{(const bf16_t*)(ws + WS_ACT), (const bf16_t*)(ws + WS_W2), T_, 1024, DFF};
            E.kind = EK_RESID; E.aux = 0;
        } else if (sub == 0) {
            is_gemm = true; g = pg8::Gemm{xb + (size_t)goff * DM, (const bf16_t*)(ws + WS_WIN), TG, NWIN, 1024};
            E.kind = EK_WIN; E.goff = goff;
        } else if (sub == 1) {
#ifndef REP_CHAIN
#define REP_CHAIN 1
#endif
#pragma unroll 1
            for (int c = bid; c < 64 * REP_CHAIN; c += 64) { const int cc = c & 63; if (bid < 64) mlstm_chain(P, lds, cc >> 3, (cc >> 1) & 3, cc & 1, tid); }
            LAS unsigned char* vs = lds + wave * 8192;
            constexpr int NCROSS = BL * 4 * 64, NATT = BL * 24 * 64;
#ifndef REP_UNITS
#define REP_UNITS 1
#endif
#pragma unroll 1
            for (int rp = 0; rp < REP_UNITS; ++rp) {
                const bool dry = rp + 1 < REP_UNITS;
                for (;;) {
                    unsigned u = 0;
                    if (lane == 0) u = atomicAdd(ctl + 64 * (1 + grp + 2 * rp), 1u);
                    u = __builtin_amdgcn_readfirstlane(u);
                    if (u >= (unsigned)(NCROSS + NATT)) break;
                    if (u < (unsigned)NCROSS) cross_unit(P, grp, (int)u, vs, lane, dry);
                    else att_unit(ws, (int)u - NCROSS, vs, lane, dry);
                }
            }
        } else if (sub == 2) {
#ifndef NO_MERGE
            merge_pass(P, gw, NGW, lane);
#endif
        } else if (sub >= 3 && sub <= 5) {
            const int b = sub - 3; is_gemm = true; perm = false; do_sync = (b == 2);
            const bf16_t* A = (const bf16_t*)(ws + (b == 0 ? WS_YATT : (b == 1 ? WS_YML : WS_CQ)));
            g = pg8::Gemm{A, (const bf16_t*)(ws + WS_WBR) + (size_t)b * 1024 * 512, TG, 1024, 512};
            E.kind = EK_BR0 + b;
        } else if (sub == 6) {
            is_gemm = true; perm = false; g = pg8::Gemm{(const bf16_t*)(ws + WS_MB16), (const bf16_t*)(ws + WS_WOUT), TG, 1024, 1024};
            E.kind = EK_RESID; E.aux = 1; E.goff = goff;
        } else if (step == 19) {
            is_gemm = true; g = pg8::Gemm{xb, (const bf16_t*)(ws + WS_W3), T_, 2 * DFF, 1024};
            E.kind = EK_SWIGLU; E.aux = 1;
        } else if (step == 20) {
            is_gemm = true; perm = false; g = pg8::Gemm{(const bf16_t*)(ws + WS_ACT), (const bf16_t*)(ws + WS_W4), T_, 1024, DFF};
            E.kind = EK_RESID; E.aux = 2;
        } else if (step == 21) {
            final_norm(P, gw, NGW, lane); do_sync = false;
        }
        if (is_gemm) {
            pg8::StaticOrder S; S.init(g.M, g.N, G, bid);
#ifndef REP_MASK
#define REP_MASK 0
#endif
            const int nrep = 1 + (int)((REP_MASK >> step) & 1);
#pragma unroll 1
            for (int rp = 0; rp < nrep; ++rp) pg8::gemm_phase<EpiAny>(lds, g, S, E, perm, tid);
        }
        __syncthreads();
#ifndef REP_SYNC
#define REP_SYNC 1
#endif
        if (coop && do_sync && step + 1 < step_hi) { if (coop == 2) grid.sync(); else { for (int rp = 0; rp < REP_SYNC; ++rp) xcd_barrier(xbar); } }
    }
}

extern "C" void kernel_launch(void* const* d_in, const int* in_sizes, int n_in, void* d_out, int out_size, void* d_ws, size_t ws_size, hipStream_t stream) {
    static int grid = 0;
    if (grid == 0) {
        if (n_in != 26 || ws_size < WS_END) { fprintf(stderr, "kernel_launch: unexpected n_in %d or ws_size %zu (need %zu)\n", n_in, ws_size, (size_t)WS_END); grid = -1; return; }
        int dev = 0, cus = 0, per_cu = 0;
        hipGetDevice(&dev); hipDeviceGetAttribute(&cus, hipDeviceAttributeMultiprocessorCount, dev);
        if (hipFuncSetAttribute((const void*)mega_fwd, hipFuncAttributeMaxDynamicSharedMemorySize, LDS_BYTES) != hipSuccess) { fprintf(stderr, "kernel_launch: hipFuncSetAttribute failed\n"); }
        hipOccupancyMaxActiveBlocksPerMultiprocessor(&per_cu, (const void*)mega_fwd, 512, LDS_BYTES);
        (void)hipGetLastError();
        if (per_cu < 1) per_cu = 1;
        grid = cus;
        fprintf(stderr, "kernel_launch: cus %d per_cu %d grid %d ws %zu\n", cus, per_cu, grid, ws_size);
    }
    if (grid < 0) return;
    hipMemsetAsync((char*)d_ws + WS_CTL, 0, 65536, stream);
    KP p{};
    const float** pp = (const float**)&p;
    for (int i = 0; i < 26; ++i) pp[i] = (const float*)d_in[i];
    p.out = (float*)d_out; p.ws = (unsigned char*)d_ws;
    int lo = 0, hi = 22, coop = 1;
    void* args[] = {&p, &lo, &hi, &coop};
    hipError_t e = hipLaunchCooperativeKernel((const void*)mega_fwd, dim3(grid), dim3(512), args, LDS_BYTES, stream);
    if (e != hipSuccess) fprintf(stderr, "cooperative launch failed: %s (grid %d)\n", hipGetErrorString(e), grid);
}
```

```cpp
#include <hip/hip_runtime.h>
#include <hip/hip_cooperative_groups.h>
#include <cstdio>
#include <cstdint>
namespace cg = cooperative_groups;

#define LAS __attribute__((address_space(3)))
#define DI __device__ __forceinline__
typedef unsigned short bf16_t;
typedef short bf16x8 __attribute__((ext_vector_type(8)));
typedef short s16x4 __attribute__((ext_vector_type(4)));
typedef float f32x4 __attribute__((ext_vector_type(4)));
typedef float f32x16 __attribute__((ext_vector_type(16)));
typedef unsigned u32x4 __attribute__((ext_vector_type(4)));
typedef unsigned u32x2 __attribute__((ext_vector_type(2)));

constexpr int T_ = 32768, TG = 16384, NGRP = 2, BL = 8, S_ = 2048, DM = 1024, DFF = 2816, MEMROWS = 4096;
constexpr int NWIN = 10496, NIN = 10256;
constexpr float EPS = 1e-6f;
constexpr float NEGF = -1e30f;

constexpr size_t MiB = 1u << 20;
constexpr size_t WS_CTL = 0;
constexpr size_t WS_W1 = 1 * MiB, WS_W2 = 12 * MiB, WS_WIN = 18 * MiB, WS_WMEM = 39 * MiB, WS_WBR = 41 * MiB, WS_WOUT = 44 * MiB, WS_W3 = 46 * MiB, WS_W4 = 57 * MiB;
constexpr size_t WS_ROPE = 63 * MiB;
constexpr size_t WS_SSM = 63 * MiB + 512 * 1024;
constexpr size_t WS_PART = 64 * MiB;
constexpr size_t SS_STRIDE = 131072;
constexpr size_t WS_CKV = 66 * MiB;
constexpr size_t WS_XB = 74 * MiB;
constexpr size_t WS_ACT = 138 * MiB;
constexpr size_t WS_AQ = 138 * MiB, WS_AK = 186 * MiB, WS_AV = 234 * MiB;
constexpr size_t WS_MQ = 282 * MiB;
constexpr size_t WS_MK = 298 * MiB, WS_MV = 314 * MiB, WS_MO = 330 * MiB, WS_CQ = 346 * MiB;
constexpr size_t WS_GTS = 362 * MiB;
constexpr size_t WS_MIF = 458 * MiB;
constexpr size_t WS_LSE = 459 * MiB;
constexpr size_t WS_HF = 461 * MiB, WS_HB = 477 * MiB;
constexpr size_t WS_MEMB = 400 * MiB;
constexpr size_t WS_YATT = 186 * MiB, WS_YML = 202 * MiB;
constexpr size_t WS_M32 = 234 * MiB;
constexpr size_t WS_MB16 = 298 * MiB;
constexpr size_t WS_END = 494 * MiB;

constexpr int LDS_BYTES = 163840;
constexpr int MLP = 272;
constexpr int TB_OFF = 4 * 128 * MLP;

DI unsigned pkbf(float lo, float hi) {
    typedef float f2 __attribute__((ext_vector_type(2))); typedef __bf16 b2 __attribute__((ext_vector_type(2)));
    f2 v = {lo, hi}; b2 b = __builtin_convertvector(v, b2); return __builtin_bit_cast(unsigned, b);
}
DI float bflo(unsigned u) { return __uint_as_float(u << 16); }
DI float bfhi(unsigned u) { return __uint_as_float(u & 0xffff0000u); }
DI float wave_sum(float v) {
#pragma unroll
    for (int o = 1; o < 64; o <<= 1) v += __shfl_xor(v, o);
    return v;
}
DI int crow(int i, int h) { return (i & 3) + 8 * (i >> 2) + 4 * h; }
DI f32x16 mfma32(bf16x8 a, bf16x8 b, f32x16 c) { return __builtin_amdgcn_mfma_f32_32x32x16_bf16(a, b, c, 0, 0, 0); }
DI bf16x8 pack8(const f32x16& x, int s) {
    u32x4 p;
    p.x = pkbf(x[8 * s + 0], x[8 * s + 1]); p.y = pkbf(x[8 * s + 2], x[8 * s + 3]);
    p.z = pkbf(x[8 * s + 4], x[8 * s + 5]); p.w = pkbf(x[8 * s + 6], x[8 * s + 7]);
    return __builtin_bit_cast(bf16x8, p);
}
DI f32x16 zero16() { f32x16 z; for (int i = 0; i < 16; ++i) z[i] = 0.f; return z; }
typedef short v4i16_t __attribute__((ext_vector_type(4)));
DI s16x4 trread(LAS unsigned char* p) { return __builtin_bit_cast(s16x4, __builtin_amdgcn_ds_read_tr16_b64_v4i16((LAS v4i16_t*)p)); }
DI bf16x8 cat44(s16x4 lo, s16x4 hi) { return (bf16x8){lo[0], lo[1], lo[2], lo[3], hi[0], hi[1], hi[2], hi[3]}; }
#define LDS_FENCE() asm volatile("s_waitcnt lgkmcnt(0)" ::: "memory")
DI float rstd_part(const float* part, int row) { return 1.0f / sqrtf(part[row] * (1.0f / 1024.0f) + EPS); }
#define MEMFENCE() asm volatile("" ::: "memory")
DI float sigmoidf_(float v) { return 1.0f / (1.0f + __expf(-v)); }

struct KP {
    const float* x; const float* mem; const float* norm_ffn1; const float* w_ffn1_in; const float* w_ffn1_out;
    const float* norm_mix; const float* norm_mem; const float* w_in; const float* att_q_gain; const float* att_k_gain;
    const float* ml_conv_w; const float* ml_conv_b; const float* ml_gate_b; const float* ml_out_gain;
    const float* cx_q_gain; const float* cx_k_gain; const float* w_mem_kv; const float* mix_gate_b;
    const float* w_br_att; const float* w_br_ml; const float* w_br_cx; const float* w_out;
    const float* norm_ffn2; const float* w_ffn2_in; const float* w_ffn2_out; const float* norm_final;
    float* out; unsigned char* ws;
};
typedef const KP __attribute__((address_space(4)))* KPC;

namespace pg8 {
constexpr int BM = 256, BK = 64, HALF = 128, HTB = HALF * BK * 2, STAGE_BYTES = 8 * HTB, NXCD = 8, WGM = 8;
DI int lds_byte(int r, int c) { const int st = (r >> 4) * 2 + (c >> 5), rr = r & 15, cc = c & 31, ob = rr * 64 + cc * 2; return st * 1024 + (ob ^ (((ob >> 9) & 1) << 5)); }
DI void stage_rc(int b, int& R, int& C) { const int st = b / 1024, sb = b % 1024, swz = sb ^ (((sb >> 9) & 1) << 5); R = (st >> 1) * 16 + swz / 64; C = (st & 1) * 32 + (swz % 64) / 2; }
DI int perm32(int rho) { const int n = rho >> 4, i = rho & 15; return 8 * (i >> 2) + 4 * n + (i & 3); }
struct Unit { int pm, pn; };
struct Gemm { const bf16_t* A; const bf16_t* Bt; int M, N, K; };
struct StaticOrder {
    int nM, nN, nwg, G, c;
    DI void init(int M, int N, int G_, int c_) { nM = M / BM; nN = N / BM; nwg = nM * nN; G = G_; c = c_; }
    DI bool next(int i, Unit& u) const {
        const long L = (long)i * G + c; if (L >= nwg) return false;
        int wgid = (int)L; { const int q = nwg / NXCD, r = nwg % NXCD, xcd = wgid % NXCD, off = wgid / NXCD; wgid = (xcd < r ? xcd * (q + 1) : r * (q + 1) + (xcd - r) * q) + off; }
        const int nig = WGM * nN, gid = wgid / nig, fm = gid * WGM, gsz = (nM - fm) < WGM ? (nM - fm) : WGM;
        u.pm = fm + ((wgid % nig) % gsz); u.pn = (wgid % nig) / gsz; return true;
    }
};
template <class Epi>
DI void gemm_phase(LAS unsigned char* lds, const Gemm g, const StaticOrder& S, const Epi& E, const bool perm, const int tid) {
    const int wid = __builtin_amdgcn_readfirstlane(tid >> 6), lane = tid & 63, wr = wid >> 2, wc = wid & 3, fr = lane & 15, fq = lane >> 4;
    const int K = g.K, nt = K / BK;
    unsigned voffA[2], voffB[2];
#pragma unroll
    for (int i = 0; i < 2; ++i) { int R, C; stage_rc(tid * 16 + i * 8192, R, C); const int Rb = perm ? ((R & ~31) + perm32(R & 31)) : R;
        voffA[i] = (unsigned)(R * K + C) * 2u; voffB[i] = (unsigned)(Rb * K + C) * 2u; }
    const size_t kstep = (size_t)(BK * 2);
    const size_t hstep = (size_t)HALF * K * 2;
    const size_t tstep = 2 * hstep;
    const unsigned ldsw = (unsigned)wid * 1024u;
    const int aoff = lds_byte(wr * 64 + fr, fq * 8), boff = lds_byte(wc * 32 + fr, fq * 8);
#define PG8_SA(b, h) (((b) * 2 + (h)) * HTB)
#define PG8_SB(b, h) ((4 + (b) * 2 + (h)) * HTB)
#define PG8_STAGE(bufoff, gbase, voff) do { _Pragma("unroll") for (int _i = 0; _i < 2; ++_i) \
        __builtin_amdgcn_global_load_lds((const unsigned*)((const char*)(gbase) + (voff)[_i]), (LAS unsigned*)(lds + (bufoff) + ldsw + _i * 8192), 16, 0, 0); } while (0)
#define PG8_LDA(dst, b, h) do { _Pragma("unroll") for (int m = 0; m < 4; ++m) _Pragma("unroll") for (int k = 0; k < 2; ++k) dst[m][k] = *(const LAS bf16x8*)(lds + PG8_SA(b, h) + aoff + m * 2048 + k * 1024); } while (0)
#define PG8_LDB(dst, b, h) do { _Pragma("unroll") for (int n = 0; n < 2; ++n) _Pragma("unroll") for (int k = 0; k < 2; ++k) dst[n][k] = *(const LAS bf16x8*)(lds + PG8_SB(b, h) + boff + n * 2048 + k * 1024); } while (0)
#define PG8_MMA(ai, bj, At, Bt) do { __builtin_amdgcn_s_setprio(1); _Pragma("unroll") for (int m = 0; m < 4; ++m) _Pragma("unroll") for (int n = 0; n < 2; ++n) _Pragma("unroll") for (int k = 0; k < 2; ++k) \
        acc[ai][bj][m][n] = __builtin_amdgcn_mfma_f32_16x16x32_bf16(Bt[n][k], At[m][k], acc[ai][bj][m][n], 0, 0, 0); __builtin_amdgcn_s_setprio(0); } while (0)
#define PG8_WAIT_V(n) asm volatile("s_waitcnt vmcnt(" #n ")" ::: "memory")
#define PG8_WAIT_L(n) asm volatile("s_waitcnt lgkmcnt(" #n ")" ::: "memory")
#define PG8_BAR __builtin_amdgcn_s_barrier()
#define PG8_SCHED __builtin_amdgcn_sched_barrier(0)
    Unit cur, nxt; int ui = 0;
    if (!S.next(0, cur)) return;
    f32x4 acc[2][2][4][2];
#pragma unroll
    for (int a = 0; a < 2; ++a)
#pragma unroll
        for (int b = 0; b < 2; ++b)
#pragma unroll
            for (int m = 0; m < 4; ++m)
#pragma unroll
                for (int n = 0; n < 2; ++n) acc[a][b][m][n] = (f32x4){0.f, 0.f, 0.f, 0.f};
    bf16x8 At[4][2], B0[2][2], B1[2][2];
    const char* cA = (const char*)g.A + (size_t)cur.pm * tstep; const char* cB = (const char*)g.Bt + (size_t)cur.pn * tstep;
    {
        PG8_STAGE(PG8_SB(0, 0), cB, voffB); PG8_STAGE(PG8_SB(0, 1), cB + hstep, voffB); PG8_STAGE(PG8_SA(0, 0), cA, voffA); PG8_STAGE(PG8_SA(0, 1), cA + hstep, voffA);
        if (wr == 1) PG8_BAR;
        PG8_WAIT_V(2); PG8_BAR;
        PG8_STAGE(PG8_SB(1, 0), cB + kstep, voffB); PG8_STAGE(PG8_SA(1, 0), cA + kstep, voffA); PG8_STAGE(PG8_SB(1, 1), cB + hstep + kstep, voffB);
        PG8_WAIT_V(6); PG8_BAR;
    }
    for (;;) {
        const bool has_next = S.next(ui + 1, nxt);
        const char* nA = has_next ? (const char*)g.A + (size_t)nxt.pm * tstep : cA; const char* nB = has_next ? (const char*)g.Bt + (size_t)nxt.pn * tstep : cB;
        for (int t = 0; t < nt; t += 2) {
            const bool last = (t == nt - 2);
            const char* a1 = cA + (size_t)(t + 1) * kstep;
            const char* a2 = last ? nA : cA + (size_t)(t + 2) * kstep; const char* b2 = last ? nB : cB + (size_t)(t + 2) * kstep;
            const char* a3 = a2 + kstep; const char* b3 = b2 + kstep;
            PG8_LDB(B0, 0, 0); PG8_LDB(B1, 0, 1); PG8_SCHED; PG8_LDA(At, 0, 0); PG8_STAGE(PG8_SA(1, 1), a1 + hstep, voffA);
            PG8_WAIT_V(8); PG8_WAIT_L(0); PG8_BAR; PG8_MMA(0, 0, At, B0); PG8_MMA(0, 1, At, B1); PG8_BAR; PG8_SCHED;
            PG8_LDA(At, 0, 1); PG8_STAGE(PG8_SB(0, 0), b2, voffB); PG8_STAGE(PG8_SB(0, 1), b2 + hstep, voffB); PG8_STAGE(PG8_SA(0, 0), a2, voffA);
            PG8_WAIT_V(8); PG8_WAIT_L(0); PG8_BAR; PG8_MMA(1, 0, At, B0); PG8_MMA(1, 1, At, B1); PG8_BAR; PG8_SCHED;
            PG8_LDB(B0, 1, 0); PG8_LDB(B1, 1, 1); PG8_SCHED; PG8_LDA(At, 1, 0); PG8_STAGE(PG8_SA(0, 1), a2 + hstep, voffA);
            PG8_WAIT_V(8); PG8_WAIT_L(0); PG8_BAR; PG8_MMA(0, 0, At, B0); PG8_MMA(0, 1, At, B1); PG8_BAR; PG8_SCHED;
            PG8_LDA(At, 1, 1); PG8_STAGE(PG8_SB(1, 0), b3, voffB); PG8_STAGE(PG8_SB(1, 1), b3 + hstep, voffB); PG8_STAGE(PG8_SA(1, 0), a3, voffA);
            PG8_WAIT_V(8); PG8_WAIT_L(0); PG8_BAR; PG8_MMA(1, 0, At, B0); PG8_MMA(1, 1, At, B1); PG8_BAR; PG8_SCHED;
        }
        if (wr == 0) PG8_BAR;
        E(acc, cur, wr, wc, fr, fq);
        if (!has_next) break;
#pragma unroll
        for (int a = 0; a < 2; ++a)
#pragma unroll
            for (int b = 0; b < 2; ++b)
#pragma unroll
                for (int m = 0; m < 4; ++m)
#pragma unroll
                    for (int n = 0; n < 2; ++n) acc[a][b][m][n] = (f32x4){0.f, 0.f, 0.f, 0.f};
        cur = nxt; cA = nA; cB = nB; ++ui;
        if (wr == 1) PG8_BAR;
    }
    PG8_WAIT_V(0);
    PG8_BAR;
#undef PG8_SA
#undef PG8_SB
#undef PG8_STAGE
#undef PG8_LDA
#undef PG8_LDB
#undef PG8_MMA
#undef PG8_WAIT_V
#undef PG8_WAIT_L
#undef PG8_BAR
#undef PG8_SCHED
}
}

enum EpiKind { EK_SWIGLU = 0, EK_RESID = 1, EK_WIN = 2, EK_MEMKV = 3, EK_BR0 = 4, EK_BR1 = 5, EK_BR2 = 6 };
typedef const f32x4 (&AccRef)[2][2][4][2];

struct EpiAny {
    int kind, aux, goff;
    unsigned char* ws; KPC kp;

    DI void swiglu(AccRef acc, const pg8::Unit& u, int wr, int wc, int fr, int fq) const {
        const int row0 = u.pm * 256 + wr * 64 + fr, col = u.pn * 128 + wc * 32 + 8 * fq;
        const float* part = (const float*)(ws + WS_PART + (aux ? 2 * SS_STRIDE : 0)); bf16_t* xb = (bf16_t*)(ws + WS_ACT);
#pragma unroll
        for (int ai = 0; ai < 2; ++ai)
#pragma unroll
            for (int m = 0; m < 4; ++m) {
                const int row = row0 + ai * 128 + m * 16; const float rs = rstd_part(part, row);
                float o[8];
#pragma unroll
                for (int n = 0; n < 2; ++n)
#pragma unroll
                    for (int j = 0; j < 4; ++j) { const float gt = acc[ai][0][m][n][j] * rs, up = acc[ai][1][m][n][j] * rs; o[4 * n + j] = gt * sigmoidf_(gt) * up; }
                u32x4 w; w.x = pkbf(o[0], o[1]); w.y = pkbf(o[2], o[3]); w.z = pkbf(o[4], o[5]); w.w = pkbf(o[6], o[7]);
                *(u32x4*)(xb + (size_t)row * DFF + col) = w;
                MEMFENCE();
            }
    }
    DI void residual(AccRef acc, const pg8::Unit& u, int wr, int wc, int fr, int fq) const {
        const int row0 = goff + u.pm * 256 + wr * 64 + fr, c0 = u.pn * 256 + wc * 32 + 4 * fq;
        const float* resid = aux == 0 ? kp->x : kp->out; float* outf = kp->out; bf16_t* xb = (bf16_t*)(ws + WS_XB);
        float* partw = (float*)(ws + WS_PART + (size_t)(aux + 1) * SS_STRIDE); const float scale = aux == 1 ? 1.0f : 0.5f;
#pragma unroll
        for (int ai = 0; ai < 2; ++ai)
#pragma unroll
            for (int m = 0; m < 4; ++m) {
                const int row = row0 + ai * 128 + m * 16; float ssq = 0.f;
#pragma unroll
                for (int bj = 0; bj < 2; ++bj)
#pragma unroll
                    for (int n = 0; n < 2; ++n) {
                        const size_t off = (size_t)row * DM + c0 + bj * 128 + n * 16;
                        const f32x4 r = *(const f32x4*)(resid + off); const f32x4 v = r + acc[ai][bj][m][n] * scale;
                        *(f32x4*)(outf + off) = v; u32x2 w; w.x = pkbf(v.x, v.y); w.y = pkbf(v.z, v.w); *(u32x2*)(xb + off) = w;
                        ssq += (v.x * v.x + v.y * v.y) + (v.z * v.z + v.w * v.w);
                    }
                ssq += __shfl_xor(ssq, 16); ssq += __shfl_xor(ssq, 32);
                if (fq == 0) unsafeAtomicAdd(partw + row, ssq);
                MEMFENCE();
            }
    }
    DI void memkv(AccRef acc, const pg8::Unit& u, int wr, int wc, int fr, int fq) const {
        const int row0 = u.pm * 256 + wr * 64 + fr, c0 = u.pn * 256 + wc * 32 + 8 * fq;
        const float* part = (const float*)(ws + WS_SSM); bf16_t* xb = (bf16_t*)(ws + WS_CKV);
#pragma unroll
        for (int ai = 0; ai < 2; ++ai)
#pragma unroll
            for (int m = 0; m < 4; ++m) {
                const int row = row0 + ai * 128 + m * 16; const float rs = 1.0f / sqrtf(part[row] * (1.0f / 1024.0f) + EPS);
#pragma unroll
                for (int bj = 0; bj < 2; ++bj) {
                    const f32x4 a = acc[ai][bj][m][0] * rs, b = acc[ai][bj][m][1] * rs;
                    u32x4 w; w.x = pkbf(a.x, a.y); w.y = pkbf(a.z, a.w); w.z = pkbf(b.x, b.y); w.w = pkbf(b.z, b.w);
                    *(u32x4*)(xb + (size_t)row * 1024 + c0 + bj * 128) = w;
                }
            }
    }
    template <int B> DI void branch(AccRef acc, const pg8::Unit& u, int wr, int wc, int fr, int fq) const {
        const int row0 = u.pm * 256 + wr * 64 + fr, c0 = u.pn * 256 + wc * 32 + 4 * fq;
        const bf16_t* gts = (const bf16_t*)(ws + WS_GTS); float* m32 = (float*)(ws + WS_M32); bf16_t* mb16 = (bf16_t*)(ws + WS_MB16);
#pragma unroll
        for (int bj = 0; bj < 2; ++bj)
#pragma unroll
            for (int n = 0; n < 2; ++n) {
                const int col = c0 + bj * 128 + n * 16;
                const f32x4 gb = *(const f32x4*)(kp->mix_gate_b + B * 1024 + col);
#pragma unroll
                for (int ai = 0; ai < 2; ++ai)
#pragma unroll
                    for (int m = 0; m < 4; ++m) {
                        const int row = row0 + ai * 128 + m * 16;
                        const u32x2 gw = *(const u32x2*)(gts + (size_t)row * 3072 + B * 1024 + col);
                        f32x4 gv; gv.x = sigmoidf_(bflo(gw.x) + gb.x); gv.y = sigmoidf_(bfhi(gw.x) + gb.y); gv.z = sigmoidf_(bflo(gw.y) + gb.z); gv.w = sigmoidf_(bfhi(gw.y) + gb.w);
                        f32x4 v = gv * acc[ai][bj][m][n];
                        const size_t off = (size_t)row * DM + col;
                        if (B > 0) v = v + *(const f32x4*)(m32 + off);
                        if (B < 2) *(f32x4*)(m32 + off) = v;
                        else { u32x2 w; w.x = pkbf(v.x, v.y); w.y = pkbf(v.z, v.w); *(u32x2*)(mb16 + off) = w; }
                        if (m & 1) MEMFENCE();
                    }
            }
    }
    DI void win(AccRef acc, const pg8::Unit& u, int wr, int wc, int fr, int fq) const {
        const int row0 = u.pm * 256 + wr * 64 + fr; const int pn = u.pn;
        const float* part = (const float*)(ws + WS_PART + SS_STRIDE) + goff;
        if (pn < 12) {
            const int isk = pn >= 6 ? 1 : 0; const int hh = 4 * (pn - 6 * isk) + wc; const int gi = hh >> 3, sh = 2 * gi;
            const float* gain = isk ? kp->att_k_gain : kp->att_q_gain; const float qs = isk ? 1.0f : 0.125f;
            bf16_t* dst = (bf16_t*)(ws + (isk ? WS_AK : WS_AQ));
            const float* rc = (const float*)(ws + WS_ROPE); const float* rsn = rc + 2048 * 32;
#pragma unroll
            for (int ai = 0; ai < 2; ++ai)
#pragma unroll
                for (int m = 0; m < 4; ++m) {
                    const int row = row0 + ai * 128 + m * 16; const float rs = rstd_part(part, row);
                    const int bl = row >> 11, s = row & 2047;
                    float ss = 0.f;
#pragma unroll
                    for (int bj = 0; bj < 2; ++bj)
#pragma unroll
                        for (int n = 0; n < 2; ++n) { const f32x4 v = acc[ai][bj][m][n]; ss += (v.x * v.x + v.y * v.y) + (v.z * v.z + v.w * v.w); }
                    ss *= rs * rs;
                    ss += __shfl_xor(ss, 16); ss += __shfl_xor(ss, 32);
                    const float rh = rs * qs / sqrtf(ss * (1.0f / 64.0f) + EPS);
                    const int perm = ((s & ((1 << sh) - 1)) << (11 - sh)) + (s >> sh);
                    bf16_t* d = dst + ((size_t)(bl * 24 + hh) * 2048 + perm) * 64 + 8 * fq;
#pragma unroll
                    for (int n = 0; n < 2; ++n) {
                        const f32x4 ga = *(const f32x4*)(gain + 8 * fq + 4 * n), gb = *(const f32x4*)(gain + 32 + 8 * fq + 4 * n);
                        const f32x4 c = *(const f32x4*)(rc + s * 32 + 8 * fq + 4 * n), sn = *(const f32x4*)(rsn + s * 32 + 8 * fq + 4 * n);
                        const f32x4 v1 = acc[ai][0][m][n] * ga * rh, v2 = acc[ai][1][m][n] * gb * rh;
                        const f32x4 o1 = v1 * c - v2 * sn, o2 = v2 * c + v1 * sn;
                        u32x2 w1; w1.x = pkbf(o1.x, o1.y); w1.y = pkbf(o1.z, o1.w);
                        u32x2 w2; w2.x = pkbf(o2.x, o2.y); w2.y = pkbf(o2.z, o2.w);
                        *(u32x2*)(d + 4 * n) = w1; *(u32x2*)(d + 32 + 4 * n) = w2;
                        MEMFENCE();
                    }
                }
        } else if (pn < 18) {
            bf16_t* dst = (bf16_t*)(ws + WS_AV);
#pragma unroll
            for (int bj = 0; bj < 2; ++bj) {
                const int hh = 4 * (pn - 12) + 2 * bj + (wc >> 1), d0 = 32 * (wc & 1) + 8 * fq; const int gi = hh >> 3, sh = 2 * gi;
#pragma unroll
                for (int ai = 0; ai < 2; ++ai)
#pragma unroll
                    for (int m = 0; m < 4; ++m) {
                        const int row = row0 + ai * 128 + m * 16; const float rs = rstd_part(part, row);
                        const int bl = row >> 11, s = row & 2047;
                        const int perm = ((s & ((1 << sh) - 1)) << (11 - sh)) + (s >> sh);
                        const f32x4 a = acc[ai][bj][m][0] * rs, b = acc[ai][bj][m][1] * rs;
                        u32x4 w; w.x = pkbf(a.x, a.y); w.y = pkbf(a.z, a.w); w.z = pkbf(b.x, b.y); w.w = pkbf(b.z, b.w);
                        *(u32x4*)(dst + ((size_t)(bl * 24 + hh) * 2048 + perm) * 64 + d0) = w;
                        if (m & 1) MEMFENCE();
                    }
            }
        } else if (pn < 40) {
            bf16_t* dst; int ld, colt;
            if (pn < 28) { const int seg = (pn - 18) >> 1; dst = (bf16_t*)(ws + WS_MQ) + (size_t)seg * TG * 512; ld = 512; colt = 256 * ((pn - 18) & 1); }
            else { dst = (bf16_t*)(ws + WS_GTS); ld = 3072; colt = 256 * (pn - 28); }
            const int c0 = colt + wc * 32 + 8 * fq;
#pragma unroll
            for (int ai = 0; ai < 2; ++ai)
#pragma unroll
                for (int m = 0; m < 4; ++m) {
                    const int row = row0 + ai * 128 + m * 16; const float rs = rstd_part(part, row);
#pragma unroll
                    for (int bj = 0; bj < 2; ++bj) {
                        const f32x4 a = acc[ai][bj][m][0] * rs, b = acc[ai][bj][m][1] * rs;
                        u32x4 w; w.x = pkbf(a.x, a.y); w.y = pkbf(a.z, a.w); w.z = pkbf(b.x, b.y); w.w = pkbf(b.z, b.w);
                        *(u32x4*)(dst + (size_t)row * ld + c0 + bj * 128) = w;
                    }
                    if (m & 1) MEMFENCE();
                }
        } else {
            if (wc == 0 && fq < 2) {
                float* dst = (float*)(ws + WS_MIF);
#pragma unroll
                for (int ai = 0; ai < 2; ++ai)
#pragma unroll
                    for (int m = 0; m < 4; ++m) {
                        const int row = row0 + ai * 128 + m * 16; const float rs = rstd_part(part, row);
                        *(f32x4*)(dst + (size_t)row * 16 + 8 * fq) = acc[ai][0][m][0] * rs;
                        *(f32x4*)(dst + (size_t)row * 16 + 8 * fq + 4) = acc[ai][0][m][1] * rs;
                    }
            }
        }
    }
    DI void operator()(AccRef acc, const pg8::Unit& u, int wr, int wc, int fr, int fq) const {
        asm volatile("" : "+v"(fr), "+v"(fq));
        switch (kind) {
#ifndef NO_E0
            case EK_SWIGLU: swiglu(acc, u, wr, wc, fr, fq); break;
#endif
#ifndef NO_E1
            case EK_RESID: residual(acc, u, wr, wc, fr, fq); break;
#endif
#ifndef NO_E2
            case EK_WIN: win(acc, u, wr, wc, fr, fq); break;
#endif
#ifndef NO_E3
            case EK_MEMKV: memkv(acc, u, wr, wc, fr, fq); break;
#endif
#ifndef NO_E4
            case EK_BR0: branch<0>(acc, u, wr, wc, fr, fq); break;
            case EK_BR1: branch<1>(acc, u, wr, wc, fr, fq); break;
            default: branch<2>(acc, u, wr, wc, fr, fq); break;
#else
            default: break;
#endif
        }
    }
};

DI void tr_item(const float* __restrict__ W, int ldw, int src0, int nvalid, const float* __restrict__ gain,
                bf16_t* Bt, int K, int n0, int k0, LAS float* scr, int lane) {
    const int nn = lane & 31;
#pragma unroll 8
    for (int i = 0; i < 32; ++i) {
        const int kk = 2 * i + (lane >> 5); float v = 0.f;
        if (nn < nvalid) { v = W[(size_t)(k0 + kk) * ldw + src0 + nn]; if (gain) v *= gain[k0 + kk]; }
        scr[kk * 33 + nn] = v;
    }
    LDS_FENCE();
    const int c = lane & 7;
#pragma unroll
    for (int j = 0; j < 4; ++j) {
        const int n = (lane >> 3) + 8 * j; const LAS float* s = scr + (8 * c) * 33 + n;
        u32x4 o; o.x = pkbf(s[0 * 33], s[1 * 33]); o.y = pkbf(s[2 * 33], s[3 * 33]); o.z = pkbf(s[4 * 33], s[5 * 33]); o.w = pkbf(s[6 * 33], s[7 * 33]);
        *(u32x4*)(Bt + (size_t)(n0 + n) * K + k0 + 8 * c) = o;
    }
    LDS_FENCE();
}
DI void ffn_map(int n0, int& src0) { const int pn = n0 >> 8, bj = (n0 >> 7) & 1, i0 = n0 & 127; src0 = bj * DFF + 128 * pn + i0; }
DI void win_map(int n0, int& src0, int& nvalid) {
    const int pn = n0 >> 8, within = n0 & 255, bj = within >> 7, wc = (within >> 5) & 3; nvalid = 32;
    if (pn < 12) { const int seg = pn >= 6 ? 1 : 0; const int hh = 4 * (pn - 6 * seg) + wc; src0 = seg * 1536 + 64 * hh + 32 * bj; }
    else if (pn < 18) src0 = 3072 + (n0 - 12 * 256);
    else if (pn < 26) src0 = 4608 + (n0 - 18 * 256);
    else if (pn < 28) src0 = 6672 + (n0 - 26 * 256);
    else if (pn < 40) src0 = 7184 + (n0 - 28 * 256);
    else { src0 = 6656; nvalid = (n0 == 10240) ? 16 : 0; }
}
DI void prepass(KPC P, LAS unsigned char* lds, int gw, int NGW, int wave, int lane) {
    LAS float* scr = (LAS float*)(lds + wave * 16384);
    unsigned char* ws = P->ws;
    constexpr int I1 = 16 * 176, I2 = 44 * 32, I3 = 16 * 328, I4 = 16 * 32, I5 = 8 * 32, I6 = 16 * 32;
    constexpr int NIT = I1 + I2 + I3 + I4 + 3 * I5 + I6 + I1 + I2;
    for (int it = gw; it < NIT; it += NGW) {
        int r = it;
        if (r < I1) { const int kb = r / 176, nb = r % 176; int s0; ffn_map(32 * nb, s0); tr_item(P->w_ffn1_in, 2 * DFF, s0, 32, P->norm_ffn1, (bf16_t*)(ws + WS_W1), 1024, 32 * nb, 64 * kb, scr, lane); continue; } r -= I1;
        if (r < I2) { const int kb = r / 32, nb = r % 32; tr_item(P->w_ffn1_out, 1024, 32 * nb, 32, nullptr, (bf16_t*)(ws + WS_W2), DFF, 32 * nb, 64 * kb, scr, lane); continue; } r -= I2;
        if (r < I3) { const int kb = r / 328, nb = r % 328; int s0, nv; win_map(32 * nb, s0, nv); tr_item(P->w_in, NIN, s0, nv, P->norm_mix, (bf16_t*)(ws + WS_WIN), 1024, 32 * nb, 64 * kb, scr, lane); continue; } r -= I3;
        if (r < I4) { const int kb = r / 32, nb = r % 32; tr_item(P->w_mem_kv, 1024, 32 * nb, 32, P->norm_mem, (bf16_t*)(ws + WS_WMEM), 1024, 32 * nb, 64 * kb, scr, lane); continue; } r -= I4;
        if (r < 3 * I5) { const int b = r / I5, q = r % I5, kb = q / 32, nb = q % 32; const float* w = b == 0 ? P->w_br_att : (b == 1 ? P->w_br_ml : P->w_br_cx);
            tr_item(w, 1024, 32 * nb, 32, nullptr, (bf16_t*)(ws + WS_WBR) + (size_t)b * 1024 * 512, 512, 32 * nb, 64 * kb, scr, lane); continue; } r -= 3 * I5;
        if (r < I6) { const int kb = r / 32, nb = r % 32; tr_item(P->w_out, 1024, 32 * nb, 32, nullptr, (bf16_t*)(ws + WS_WOUT), 1024, 32 * nb, 64 * kb, scr, lane); continue; } r -= I6;
        if (r < I1) { const int kb = r / 176, nb = r % 176; int s0; ffn_map(32 * nb, s0); tr_item(P->w_ffn2_in, 2 * DFF, s0, 32, P->norm_ffn2, (bf16_t*)(ws + WS_W3), 1024, 32 * nb, 64 * kb, scr, lane); continue; } r -= I1;
        { const int kb = r / 32, nb = r % 32; tr_item(P->w_ffn2_out, 1024, 32 * nb, 32, nullptr, (bf16_t*)(ws + WS_W4), DFF, 32 * nb, 64 * kb, scr, lane); }
    }
    bf16_t* xb = (bf16_t*)(ws + WS_XB); float* part = (float*)(ws + WS_PART);
    bf16_t* memb = (bf16_t*)(ws + WS_MEMB); float* ssm = (float*)(ws + WS_SSM);
    for (int m = gw; m < T_ + MEMROWS; m += NGW) {
        const bool isx = m < T_; const int row = isx ? m : m - T_;
        const f32x4* xr = (const f32x4*)((isx ? P->x : P->mem) + (size_t)row * DM) + lane;
        unsigned long long* o8 = (unsigned long long*)((isx ? xb : memb) + (size_t)row * DM) + lane;
        float s = 0.f;
#pragma unroll
        for (int j = 0; j < 4; ++j) { const f32x4 v = xr[64 * j]; s += (v.x * v.x + v.y * v.y) + (v.z * v.z + v.w * v.w);
            o8[64 * j] = (unsigned long long)pkbf(v.x, v.y) | ((unsigned long long)pkbf(v.z, v.w) << 32); }
        s = wave_sum(s);
        if (isx) { if (lane < 4) part[(size_t)lane * (SS_STRIDE / 4) + row] = lane == 0 ? s : 0.f; }
        else if (lane == 0) ssm[row] = s;
    }
    float* rc = (float*)(ws + WS_ROPE); float* rsn = rc + 2048 * 32;
    for (int i = gw * 64 + lane; i < 2048 * 32; i += NGW * 64) {
        const int s = i >> 5, d = i & 31; const float inv = powf(10000.0f, -(float)(2 * d) / 64.0f); const float ang = (float)s * inv;
        rc[i] = cosf(ang); rsn[i] = sinf(ang);
    }
}

DI void cknorm(KPC P, int gw, int NGW, int lane) {
    bf16_t* ckv = (bf16_t*)(P->ws + WS_CKV);
    for (int it = gw; it < MEMROWS * 4; it += NGW) {
        const int row = it >> 2, hd = it & 3; unsigned* p = (unsigned*)(ckv + (size_t)row * 1024 + hd * 128) + lane;
        const unsigned w = *p; const float a = bflo(w), b = bfhi(w);
        const float ss = wave_sum(a * a + b * b); const float rs = 1.0f / sqrtf(ss * (1.0f / 128.0f) + EPS);
        *p = pkbf(a * rs * P->cx_k_gain[2 * lane], b * rs * P->cx_k_gain[2 * lane + 1]);
    }
}

template <int D, int NKB, bool BAND>
DI void attn_pass(const bf16_t* Kb, const bf16_t* Vb, long pitch, unsigned vmask, const bf16x8 (&qf)[D / 16],
                  float& m, float& l, f32x16 (&o)[D / 32], LAS unsigned char* vs, int lane) {
    const int r = lane & 31, h = lane >> 5;
    f32x16 st[NKB];
#pragma unroll
    for (int kb = 0; kb < NKB; ++kb) {
        if (vmask & (1u << kb)) {
            const bf16_t* kr = Kb + (long)(32 * kb + r) * pitch + 8 * h;
            f32x16 a = zero16();
#pragma unroll
            for (int ks = 0; ks < D / 16; ++ks) a = mfma32(*(const bf16x8*)(kr + 16 * ks), qf[ks], a);
            st[kb] = a;
            MEMFENCE();
        } else {
#pragma unroll
            for (int i = 0; i < 16; ++i) st[kb][i] = NEGF;
        }
    }
    if (BAND) {
#pragma unroll
        for (int i = 0; i < 16; ++i) { const int jj = crow(i, h); if (jj < r) st[0][i] = NEGF; if (jj > r) st[NKB - 1][i] = NEGF; }
    }
    float bm = NEGF;
#pragma unroll
    for (int kb = 0; kb < NKB; ++kb)
#pragma unroll
        for (int i = 0; i < 16; ++i) bm = fmaxf(bm, st[kb][i]);
    bm = fmaxf(bm, __shfl_xor(bm, 32));
    const float mn = fmaxf(m, bm); const float alpha = __expf(m - mn);
    float ls = 0.f;
#pragma unroll
    for (int kb = 0; kb < NKB; ++kb)
#pragma unroll
        for (int i = 0; i < 16; ++i) { const float p = __expf(st[kb][i] - mn); st[kb][i] = p; ls += p; }
    ls += __shfl_xor(ls, 32);
    l = l * alpha + ls; m = mn;
#pragma unroll
    for (int d0 = 0; d0 < D / 32; ++d0)
#pragma unroll
        for (int i = 0; i < 16; ++i) o[d0][i] *= alpha;
    const int q4 = (lane & 15) >> 2, p4 = lane & 3, blk = (lane >> 4) & 1;
    LAS unsigned char* vrd = vs + q4 * (2 * D) + 32 * blk + 8 * p4;
#pragma unroll
    for (int kb = 0; kb < NKB; ++kb) {
        if (vmask & (1u << kb)) {
            constexpr int CPR = D / 8;
#pragma unroll
            for (int t = 0; t < (32 * CPR) / 64; ++t) {
                const int ci = lane + 64 * t, row = ci / CPR, ch = ci % CPR;
                const u32x4 v = *(const u32x4*)(Vb + (long)(32 * kb + row) * pitch + 8 * ch);
                *(LAS u32x4*)(vs + row * (2 * D) + ch * 16) = v;
                if ((t & 3) == 3) MEMFENCE();
            }
            LDS_FENCE();
#pragma unroll
            for (int ks2 = 0; ks2 < 2; ++ks2) {
                const bf16x8 pb = pack8(st[kb], ks2);
#pragma unroll
                for (int d0 = 0; d0 < D / 32; ++d0) {
                    const s16x4 lo = trread(vrd + (16 * ks2 + 4 * h) * (2 * D) + 64 * d0);
                    const s16x4 hi = trread(vrd + (16 * ks2 + 8 + 4 * h) * (2 * D) + 64 * d0);
                    o[d0] = mfma32(cat44(lo, hi), pb, o[d0]);
                }
            }
            LDS_FENCE();
        }
    }
}

DI void att_unit(unsigned char* ws, int u, LAS unsigned char* vs, int lane, bool dry) {
    const int r = lane & 31, h = lane >> 5;
    const int qblk = u & 63, hb = u >> 6, head = hb % 24, bl = hb / 24;
    const int gi = head >> 3, slot = head & 7, sh = 2 * gi, n = 2048 >> sh;
    const int prow = 32 * qblk, c = prow >> (11 - sh), i0 = prow & (n - 1);
    const size_t hbase = (size_t)(bl * 24 + head) * 2048 * 64;
    bf16_t* Q = (bf16_t*)(ws + WS_AQ) + hbase; const bf16_t* K = (const bf16_t*)(ws + WS_AK) + hbase; const bf16_t* V = (const bf16_t*)(ws + WS_AV) + hbase;
    bf16x8 qf[4];
#pragma unroll
    for (int ks = 0; ks < 4; ++ks) qf[ks] = *(const bf16x8*)(Q + (size_t)(prow + r) * 64 + 16 * ks + 8 * h);
    unsigned vmask = 0;
#pragma unroll
    for (int kb = 0; kb < 5; ++kb) { const int j0 = i0 - 64 + 32 * kb; if (j0 >= 0 && j0 < n) vmask |= 1u << kb; }
    vmask = __builtin_amdgcn_readfirstlane(vmask);
    float m = NEGF, l = 0.f; f32x16 o[2]; o[0] = zero16(); o[1] = zero16();
    attn_pass<64, 5, true>(K + (long)(prow - 64) * 64, V + (long)(prow - 64) * 64, 64, vmask, qf, m, l, o, vs, lane);
    if (dry) return;
    const float inv = 1.0f / l;
    bf16_t* orow = Q + (size_t)(prow + r) * 64;
#pragma unroll
    for (int d0 = 0; d0 < 2; ++d0)
#pragma unroll
        for (int g4 = 0; g4 < 4; ++g4) {
            u32x2 w; w.x = pkbf(o[d0][4 * g4] * inv, o[d0][4 * g4 + 1] * inv); w.y = pkbf(o[d0][4 * g4 + 2] * inv, o[d0][4 * g4 + 3] * inv);
            *(u32x2*)(orow + 32 * d0 + 8 * g4 + 4 * h) = w;
        }
    if (h == 0) {
        const int s = c + ((i0 + r) << sh);
        float* lse = (float*)(ws + WS_LSE);
        lse[((size_t)gi * TG + (size_t)bl * 2048 + s) * 8 + slot] = m + __logf(l);
    }
}

DI void cross_unit(KPC P, int grp, int u, LAS unsigned char* vs, int lane, bool dry) {
    const int r = lane & 31, h = lane >> 5;
    const int qblk = u & 63, head = (u >> 6) & 3, bl = u >> 8;
    bf16_t* qrow = (bf16_t*)(P->ws + WS_CQ) + ((size_t)bl * 2048 + 32 * qblk + r) * 512 + head * 128;
    bf16x8 qf[8]; float ss = 0.f;
#pragma unroll
    for (int ks = 0; ks < 8; ++ks) { qf[ks] = *(const bf16x8*)(qrow + 16 * ks + 8 * h);
        const u32x4 w = __builtin_bit_cast(u32x4, qf[ks]);
        ss += (bflo(w.x) * bflo(w.x) + bfhi(w.x) * bfhi(w.x)) + (bflo(w.y) * bflo(w.y) + bfhi(w.y) * bfhi(w.y)) + (bflo(w.z) * bflo(w.z) + bfhi(w.z) * bfhi(w.z)) + (bflo(w.w) * bflo(w.w) + bfhi(w.w) * bfhi(w.w)); }
    ss += __shfl_xor(ss, 32);
    const float rq = (1.0f / sqrtf(ss * (1.0f / 128.0f) + EPS)) * 0.08838834764831845f;
#pragma unroll
    for (int ks = 0; ks < 8; ++ks) {
        const u32x4 w = __builtin_bit_cast(u32x4, qf[ks]); const float* g = P->cx_q_gain + 16 * ks + 8 * h;
        const f32x4 ga = *(const f32x4*)g, gb = *(const f32x4*)(g + 4);
        u32x4 o; o.x = pkbf(bflo(w.x) * rq * ga.x, bfhi(w.x) * rq * ga.y); o.y = pkbf(bflo(w.y) * rq * ga.z, bfhi(w.y) * rq * ga.w);
        o.z = pkbf(bflo(w.z) * rq * gb.x, bfhi(w.z) * rq * gb.y); o.w = pkbf(bflo(w.w) * rq * gb.z, bfhi(w.w) * rq * gb.w);
        qf[ks] = __builtin_bit_cast(bf16x8, o);
    }
    const bf16_t* K = (const bf16_t*)(P->ws + WS_CKV) + (size_t)(grp * BL + bl) * 256 * 1024 + head * 128;
    const bf16_t* V = K + 512;
    float m = NEGF, l = 0.f; f32x16 o[4];
#pragma unroll
    for (int d0 = 0; d0 < 4; ++d0) o[d0] = zero16();
#pragma unroll 1
    for (int ps = 0; ps < 4; ++ps) attn_pass<128, 2, false>(K + (size_t)ps * 64 * 1024, V + (size_t)ps * 64 * 1024, 1024, 0x3u, qf, m, l, o, vs, lane);
    if (dry) return;
    const float inv = 1.0f / l;
#pragma unroll
    for (int d0 = 0; d0 < 4; ++d0)
#pragma unroll
        for (int g4 = 0; g4 < 4; ++g4) {
            u32x2 w; w.x = pkbf(o[d0][4 * g4] * inv, o[d0][4 * g4 + 1] * inv); w.y = pkbf(o[d0][4 * g4 + 2] * inv, o[d0][4 * g4 + 3] * inv);
            *(u32x2*)(qrow + 32 * d0 + 8 * g4 + 4 * h) = w;
        }
}

DI float scan_add(float v, int lane) {
#pragma unroll
    for (int d = 1; d < 64; d <<= 1) { const float t = __shfl_up(v, d); if (lane >= d) v += t; }
    return v;
}
DI float scan_max(float v, int lane) {
#pragma unroll
    for (int d = 1; d < 64; d <<= 1) { const float t = __shfl_up(v, d); if (lane >= d) v = fmaxf(v, t); }
    return v;
}
DI float log_sigmoid(float x) { return x >= 0.f ? -log1pf(__expf(-x)) : x - log1pf(__expf(x)); }

template <int D, int NKB, bool BAND>
DI void attn_pass_lds(LAS unsigned char* Kimg, LAS unsigned char* Vimg, unsigned vmask, const bf16x8 (&qf)[D / 16],
                      float& m, float& l, f32x16 (&o)[D / 32], int lane) {
    constexpr int PB = 2 * D + 16;
    const int r = lane & 31, h = lane >> 5;
    f32x16 st[NKB];
#pragma unroll
    for (int kb = 0; kb < NKB; ++kb) {
        if (vmask & (1u << kb)) {
            LAS unsigned char* kr = Kimg + (32 * kb + r) * PB + 16 * h;
            f32x16 a = zero16();
#pragma unroll
            for (int ks = 0; ks < D / 16; ++ks) a = mfma32(*(const LAS bf16x8*)(kr + 32 * ks), qf[ks], a);
            st[kb] = a;
        } else {
#pragma unroll
            for (int i = 0; i < 16; ++i) st[kb][i] = NEGF;
        }
    }
    if (BAND) {
#pragma unroll
        for (int i = 0; i < 16; ++i) { const int jj = crow(i, h); if (jj < r) st[0][i] = NEGF; if (jj > r) st[NKB - 1][i] = NEGF; }
    }
    float bm = NEGF;
#pragma unroll
    for (int kb = 0; kb < NKB; ++kb)
#pragma unroll
        for (int i = 0; i < 16; ++i) bm = fmaxf(bm, st[kb][i]);
    bm = fmaxf(bm, __shfl_xor(bm, 32));
    const float mn = fmaxf(m, bm); const float alpha = __expf(m - mn);
    float ls = 0.f;
#pragma unroll
    for (int kb = 0; kb < NKB; ++kb)
#pragma unroll
        for (int i = 0; i < 16; ++i) { const float p = __expf(st[kb][i] - mn); st[kb][i] = p; ls += p; }
    ls += __shfl_xor(ls, 32);
    l = l * alpha + ls; m = mn;
#pragma unroll
    for (int d0 = 0; d0 < D / 32; ++d0)
#pragma unroll
        for (int i = 0; i < 16; ++i) o[d0][i] *= alpha;
    LAS unsigned char* vrd = Vimg + ((lane & 15) >> 2) * PB + 32 * ((lane >> 4) & 1) + 8 * (lane & 3);
#pragma unroll
    for (int kb = 0; kb < NKB; ++kb) {
        if (vmask & (1u << kb)) {
#pragma unroll
            for (int ks2 = 0; ks2 < 2; ++ks2) {
                const bf16x8 pb = pack8(st[kb], ks2);
#pragma unroll
                for (int d0 = 0; d0 < D / 32; ++d0) {
                    const s16x4 lo = trread(vrd + (32 * kb + 16 * ks2 + 4 * h) * PB + 64 * d0);
                    const s16x4 hi = trread(vrd + (32 * kb + 16 * ks2 + 8 + 4 * h) * PB + 64 * d0);
                    o[d0] = mfma32(cat44(lo, hi), pb, o[d0]);
                }
            }
        }
    }
}

DI void att_wg_unit(unsigned char* ws, LAS unsigned char* lds, int u, const int tid0) {
    int tid = tid0; asm volatile("" : "+v"(tid));
    const int lane = tid & 63, wave = __builtin_amdgcn_readfirstlane(tid0 >> 6), r = lane & 31, h = lane >> 5;
    constexpr int PB = 144;
    const int ublk = u & 7, hb = u >> 3, head = hb % 24, bl = hb / 24;
    const int gi = head >> 3, slot = head & 7, sh = 2 * gi, n = 2048 >> sh;
    const size_t hbase = (size_t)(bl * 24 + head) * 2048 * 64;
    bf16_t* Q = (bf16_t*)(ws + WS_AQ) + hbase; const bf16_t* K = (const bf16_t*)(ws + WS_AK) + hbase; const bf16_t* V = (const bf16_t*)(ws + WS_AV) + hbase;
    LAS unsigned char* Kimg = lds; LAS unsigned char* Vimg = lds + 384 * PB;
    const int w0 = 256 * ublk - 64;
#pragma unroll
    for (int i = 0; i < 6; ++i) {
        const int ix = tid + 512 * i, row = ix >> 3, ch = ix & 7; const int grow = w0 + row;
        if (grow >= 0 && grow < 2048) {
            *(LAS u32x4*)(Kimg + row * PB + ch * 16) = *(const u32x4*)(K + (size_t)grow * 64 + 8 * ch);
            *(LAS u32x4*)(Vimg + row * PB + ch * 16) = *(const u32x4*)(V + (size_t)grow * 64 + 8 * ch);
        }
    }
    const int prow = 256 * ublk + 32 * wave, c = prow >> (11 - sh), i0 = prow & (n - 1);
    bf16x8 qf[4];
#pragma unroll
    for (int ks = 0; ks < 4; ++ks) qf[ks] = *(const bf16x8*)(Q + (size_t)(prow + r) * 64 + 16 * ks + 8 * h);
    unsigned vmask = 0;
#pragma unroll
    for (int kb = 0; kb < 5; ++kb) { const int j0 = i0 - 64 + 32 * kb; if (j0 >= 0 && j0 < n) vmask |= 1u << kb; }
    vmask = __builtin_amdgcn_readfirstlane(vmask);
    __syncthreads();
    float m = NEGF, l = 0.f; f32x16 o[2]; o[0] = zero16(); o[1] = zero16();
    attn_pass_lds<64, 5, true>(Kimg + 32 * wave * PB, Vimg + 32 * wave * PB, vmask, qf, m, l, o, lane);
    const float inv = 1.0f / l;
    bf16_t* orow = Q + (size_t)(prow + r) * 64;
#pragma unroll
    for (int d0 = 0; d0 < 2; ++d0)
#pragma unroll
        for (int g4 = 0; g4 < 4; ++g4) {
            u32x2 w; w.x = pkbf(o[d0][4 * g4] * inv, o[d0][4 * g4 + 1] * inv); w.y = pkbf(o[d0][4 * g4 + 2] * inv, o[d0][4 * g4 + 3] * inv);
            *(u32x2*)(orow + 32 * d0 + 8 * g4 + 4 * h) = w;
        }
    if (h == 0) {
        const int s = c + ((i0 + r) << sh);
        float* lse = (float*)(ws + WS_LSE);
        lse[((size_t)gi * TG + (size_t)bl * 2048 + s) * 8 + slot] = m + __logf(l);
    }
    __syncthreads();
}

DI void cross_wg_unit(KPC P, LAS unsigned char* lds, int grp, int u, const int tid0) {
    int tid = tid0; asm volatile("" : "+v"(tid));
    const int lane = tid & 63, wave = __builtin_amdgcn_readfirstlane(tid0 >> 6), r = lane & 31, h = lane >> 5;
    constexpr int PB = 272;
    unsigned char* ws = P->ws; asm volatile("" : "+s"(ws));
    const int qq = u & 7, head = (u >> 3) & 3, bl = u >> 5;
    const bf16_t* K = (const bf16_t*)(ws + WS_CKV) + (size_t)(grp * BL + bl) * 256 * 1024 + head * 128;
    const bf16_t* V = K + 512;
    LAS unsigned char* Kimg = lds; LAS unsigned char* Vimg = lds + 256 * PB;
#pragma unroll
    for (int i = 0; i < 8; ++i) {
        const int ix = tid + 512 * i, row = ix >> 4, ch = ix & 15;
        *(LAS u32x4*)(Kimg + row * PB + ch * 16) = *(const u32x4*)(K + (size_t)row * 1024 + 8 * ch);
        *(LAS u32x4*)(Vimg + row * PB + ch * 16) = *(const u32x4*)(V + (size_t)row * 1024 + 8 * ch);
    }
    bf16_t* qrow = (bf16_t*)(ws + WS_CQ) + ((size_t)bl * 2048 + 256 * qq + 32 * wave + r) * 512 + head * 128;
    bf16x8 qf[8]; float ss = 0.f;
#pragma unroll
    for (int ks = 0; ks < 8; ++ks) { qf[ks] = *(const bf16x8*)(qrow + 16 * ks + 8 * h);
        const u32x4 w = __builtin_bit_cast(u32x4, qf[ks]);
        ss += (bflo(w.x) * bflo(w.x) + bfhi(w.x) * bfhi(w.x)) + (bflo(w.y) * bflo(w.y) + bfhi(w.y) * bfhi(w.y)) + (bflo(w.z) * bflo(w.z) + bfhi(w.z) * bfhi(w.z)) + (bflo(w.w) * bflo(w.w) + bfhi(w.w) * bfhi(w.w)); }
    ss += __shfl_xor(ss, 32);
    const float rq = (1.0f / sqrtf(ss * (1.0f / 128.0f) + EPS)) * 0.08838834764831845f;
#pragma unroll
    for (int ks = 0; ks < 8; ++ks) {
        const u32x4 w = __builtin_bit_cast(u32x4, qf[ks]); const float* g = P->cx_q_gain + 16 * ks + 8 * h;
        const f32x4 ga = *(const f32x4*)g, gb = *(const f32x4*)(g + 4);
        u32x4 o; o.x = pkbf(bflo(w.x) * rq * ga.x, bfhi(w.x) * rq * ga.y); o.y = pkbf(bflo(w.y) * rq * ga.z, bfhi(w.y) * rq * ga.w);
        o.z = pkbf(bflo(w.z) * rq * gb.x, bfhi(w.z) * rq * gb.y); o.w = pkbf(bflo(w.w) * rq * gb.z, bfhi(w.w) * rq * gb.w);
        qf[ks] = __builtin_bit_cast(bf16x8, o);
    }
    __syncthreads();
    float m = NEGF, l = 0.f; f32x16 o[4];
#pragma unroll
    for (int d0 = 0; d0 < 4; ++d0) o[d0] = zero16();
#pragma unroll 1
    for (int ps = 0; ps < 4; ++ps) attn_pass_lds<128, 2, false>(Kimg + ps * 64 * PB, Vimg + ps * 64 * PB, 0x3u, qf, m, l, o, lane);
    const float inv = 1.0f / l;
#pragma unroll
    for (int d0 = 0; d0 < 4; ++d0)
#pragma unroll
        for (int g4 = 0; g4 < 4; ++g4) {
            u32x2 w; w.x = pkbf(o[d0][4 * g4] * inv, o[d0][4 * g4 + 1] * inv); w.y = pkbf(o[d0][4 * g4 + 2] * inv, o[d0][4 * g4 + 3] * inv);
            *(u32x2*)(qrow + 32 * d0 + 8 * g4 + 4 * h) = w;
        }
    __syncthreads();
}

#ifndef REP_ML
#define REP_ML 1
#endif
constexpr size_t WS_DN = 493 * MiB;
constexpr size_t WS_SCL = 493 * MiB + 512 * 1024;
#define CHAIN_LANES() asm volatile("" : "+v"(tid)); const int lane = tid & 63, r = lane & 31, h = lane >> 5; const int trofs = ((lane & 15) >> 2) * MLP + 32 * ((lane >> 4) & 1) + 8 * (lane & 3); (void)r; (void)h; (void)trofs

DI void ml_conv_item(KPC P, const bf16_t* srcbase, LAS unsigned char* img, int sel, int cg8, int seg, int ci, int dir, size_t rowb, int head) {
    const int tl0 = 128 * ci + 8 * seg;
    const int pmin = dir ? 2047 - (tl0 + 7) : tl0;
    const bf16_t* src = srcbase + head * 128 + 8 * cg8;
    u32x4 raw[12];
#pragma unroll
    for (int i = 0; i < 12; ++i) { const int pp = pmin - 2 + i; raw[i] = (u32x4){0u, 0u, 0u, 0u}; if (pp >= 0 && pp < 2048) raw[i] = *(const u32x4*)(src + (rowb + pp) * 512); }
    const int ch = sel * 512 + head * 128 + 8 * cg8;
    f32x4 wv[5][2];
#pragma unroll
    for (int j = 0; j < 5; ++j) { wv[j][0] = *(const f32x4*)(P->ml_conv_w + j * 1024 + ch); wv[j][1] = *(const f32x4*)(P->ml_conv_w + j * 1024 + ch + 4); }
    const f32x4 b0 = *(const f32x4*)(P->ml_conv_b + ch), b1 = *(const f32x4*)(P->ml_conv_b + ch + 4);
    const float osc = sel ? 1.0f : 0.08838834764831845f;
    LAS unsigned char* dstb = img + cg8 * 16;
#pragma unroll
    for (int i = 0; i < 8; ++i) {
        f32x4 a0 = b0, a1 = b1;
#pragma unroll
        for (int j = 0; j < 5; ++j) {
            const u32x4 w = raw[i + j];
            a0 += wv[j][0] * (f32x4){bflo(w.x), bfhi(w.x), bflo(w.y), bfhi(w.y)};
            a1 += wv[j][1] * (f32x4){bflo(w.z), bfhi(w.z), bflo(w.w), bfhi(w.w)};
        }
        u32x4 o;
        o.x = pkbf(a0.x * sigmoidf_(a0.x) * osc, a0.y * sigmoidf_(a0.y) * osc); o.y = pkbf(a0.z * sigmoidf_(a0.z) * osc, a0.w * sigmoidf_(a0.w) * osc);
        o.z = pkbf(a1.x * sigmoidf_(a1.x) * osc, a1.y * sigmoidf_(a1.y) * osc); o.w = pkbf(a1.z * sigmoidf_(a1.z) * osc, a1.w * sigmoidf_(a1.w) * osc);
        const int tl = dir ? (8 * seg + 7 - i) : (8 * seg + i);
        *(LAS u32x4*)(dstb + tl * MLP) = o;
    }
}

DI void mlstm_p1(KPC P, LAS unsigned char* lds, int grp, int chain, int ci, const int tid0) {
    int tid = tid0; const int wave = __builtin_amdgcn_readfirstlane(tid0 >> 6);
    const int bl = chain >> 3, head = (chain >> 1) & 3, dir = chain & 1;
    unsigned char* ws = P->ws; asm volatile("" : "+s"(ws));
    LAS unsigned char* KI = lds + 128 * MLP; LAS unsigned char* VI = lds + 2 * 128 * MLP; LAS unsigned char* CI = lds + 3 * 128 * MLP;
    LAS float* twk = (LAS float*)(lds + TB_OFF) + 384;
    const size_t rowb = (size_t)bl * 2048;
    {
        CHAIN_LANES();
        if (tid < 256) {
            ml_conv_item(P, (const bf16_t*)(ws + WS_MK), KI, 1, tid & 15, (tid >> 4) & 15, ci, dir, rowb, head);
        } else {
            const int t2 = tid - 256; const int t = t2 >> 1, c0 = (t2 & 1) * 64; const int tau = 128 * ci + t; const int p = dir ? 2047 - tau : tau;
            const bf16_t* vsrc = (const bf16_t*)(ws + WS_MV) + (rowb + p) * 512 + head * 128 + c0;
#pragma unroll
            for (int sub = 0; sub < 8; ++sub) *(LAS u32x4*)(VI + t * MLP + c0 * 2 + sub * 16) = *(const u32x4*)(vsrc + 8 * sub);
            if (wave == 7) {
                const float* MIF = (const float*)(ws + WS_MIF);
                const float bli = P->ml_gate_b[(dir ? 8 : 0) + head], blf = P->ml_gate_b[(dir ? 12 : 4) + head];
                const int tau1 = 128 * ci + lane, tau2 = tau1 + 64; const int p1 = dir ? 2047 - tau1 : tau1, p2 = dir ? 2047 - tau2 : tau2;
                const float* r1 = MIF + (rowb + p1) * 16 + head; const float* r2 = MIF + (rowb + p2) * 16 + head;
                const float li1 = r1[dir ? 8 : 0] + bli, li2 = r2[dir ? 8 : 0] + bli;
                const float lf1 = log_sigmoid(r1[dir ? 12 : 4] + blf), lf2 = log_sigmoid(r2[dir ? 12 : 4] + blf);
                const float c1 = scan_add(lf1, lane); const float tot1 = __shfl(c1, 63); const float c2 = scan_add(lf2, lane) + tot1;
                const float g1 = li1 - c1, g2 = li2 - c2;
                float gm = fmaxf(g1, g2);
#pragma unroll
                for (int o = 1; o < 64; o <<= 1) gm = fmaxf(gm, __shfl_xor(gm, o));
                const float gtot = __shfl(c2, 63);
                twk[lane] = __expf(g1 - gm); twk[64 + lane] = __expf(g2 - gm);
                if (lane == 0) { float* scl = (float*)(ws + WS_SCL) + ((size_t)chain * 16 + ci) * 4; scl[0] = gtot; scl[1] = gm; }
            }
        }
    }
    __syncthreads();
    {
        CHAIN_LANES();
        const int s = tid >> 2, c0 = (tid & 3) * 32; const float wks = twk[s];
#pragma unroll
        for (int sub = 0; sub < 4; ++sub) {
            LAS u32x4* pp = (LAS u32x4*)(KI + s * MLP + c0 * 2 + sub * 16); const u32x4 w = *pp;
            u32x4 o; o.x = pkbf(bflo(w.x) * wks, bfhi(w.x) * wks); o.y = pkbf(bflo(w.y) * wks, bfhi(w.y) * wks); o.z = pkbf(bflo(w.z) * wks, bfhi(w.z) * wks); o.w = pkbf(bflo(w.w) * wks, bfhi(w.w) * wks);
            *pp = o;
        }
    }
    __syncthreads();
    {
        CHAIN_LANES();
        const int vb = wave >> 1, kh = wave & 1;
        f32x16 cacc[2], ntmp[2]; cacc[0] = zero16(); cacc[1] = zero16(); ntmp[0] = zero16(); ntmp[1] = zero16();
        const bf16x8 ones = (bf16x8){0x3F80, 0x3F80, 0x3F80, 0x3F80, 0x3F80, 0x3F80, 0x3F80, 0x3F80};
#pragma unroll
        for (int ks = 0; ks < 8; ++ks) {
            LAS unsigned char* vp = VI + trofs + (16 * ks + 8 * h) * MLP + 64 * vb;
            const bf16x8 af = cat44(trread(vp), trread(vp + 4 * MLP));
#pragma unroll
            for (int jk = 0; jk < 2; ++jk) {
                LAS unsigned char* kp = KI + trofs + (16 * ks + 8 * h) * MLP + 64 * (2 * kh + jk);
                const bf16x8 bfr = cat44(trread(kp), trread(kp + 4 * MLP));
                cacc[jk] = mfma32(af, bfr, cacc[jk]);
                if (vb == 0) ntmp[jk] = mfma32(ones, bfr, ntmp[jk]);
            }
        }
#pragma unroll
        for (int jk = 0; jk < 2; ++jk) {
            const int kcol = 32 * (2 * kh + jk) + r;
#pragma unroll
            for (int i = 0; i < 16; i += 1) {
                const unsigned short v = (unsigned short)(pkbf(cacc[jk][i], 0.f) & 0xffffu);
                *(LAS unsigned short*)(CI + (32 * vb + crow(i, h)) * MLP + kcol * 2) = v;
            }
            if (vb == 0 && h == 0) ((float*)(ws + WS_DN))[((size_t)chain * 16 + ci) * 128 + kcol] = ntmp[jk][0];
        }
    }
    __syncthreads();
    {
        CHAIN_LANES();
        bf16_t* dc = (bf16_t*)(ws + WS_XB) + (size_t)grp * TG * DM + ((size_t)chain * 16 + ci) * 16384;
#pragma unroll
        for (int i = 0; i < 4; ++i) { const int ix = tid + 512 * i; *(u32x4*)(dc + (size_t)ix * 8) = *(LAS u32x4*)(CI + (ix >> 4) * MLP + (ix & 15) * 16); }
    }
}

DI void mlstm_scan(unsigned char* ws, int grp, int w, int tid) {
    const int chain = w >> 2, quarter = w & 3;
    float* scl = (float*)(ws + WS_SCL) + (size_t)chain * 64;
    bf16_t* dc = (bf16_t*)(ws + WS_XB) + (size_t)grp * TG * DM + (size_t)chain * 16 * 16384 + (size_t)(quarter * 512 + tid) * 8;
    float* dn = (float*)(ws + WS_DN) + (size_t)chain * 16 * 128 + (tid & 127);
    const bool isn = quarter == 0 && tid < 128;
    u32x4 d[16]; float nd[16];
#pragma unroll
    for (int c = 0; c < 16; ++c) { d[c] = *(const u32x4*)(dc + (size_t)c * 16384); nd[c] = isn ? dn[c * 128] : 0.f; }
    float C[8]; float nn = 0.f, m = 0.f;
#pragma unroll
    for (int k = 0; k < 8; ++k) C[k] = 0.f;
#pragma unroll
    for (int c = 0; c < 16; ++c) {
        u32x4 o; o.x = pkbf(C[0], C[1]); o.y = pkbf(C[2], C[3]); o.z = pkbf(C[4], C[5]); o.w = pkbf(C[6], C[7]);
        *(u32x4*)(dc + (size_t)c * 16384) = o;
        if (isn) dn[c * 128] = nn;
        const float gt = scl[4 * c], gm = scl[4 * c + 1];
        const float mn = gt + fmaxf(m, gm); const float al = __expf(gt + m - mn), be = __expf(gt + gm - mn);
        if (quarter == 0 && tid == 0) scl[4 * c + 2] = m;
        const u32x4 w4 = d[c];
        C[0] = al * C[0] + be * bflo(w4.x); C[1] = al * C[1] + be * bfhi(w4.x); C[2] = al * C[2] + be * bflo(w4.y); C[3] = al * C[3] + be * bfhi(w4.y);
        C[4] = al * C[4] + be * bflo(w4.z); C[5] = al * C[5] + be * bfhi(w4.z); C[6] = al * C[6] + be * bflo(w4.w); C[7] = al * C[7] + be * bfhi(w4.w);
        nn = al * nn + be * nd[c]; m = mn;
    }
}

DI void mlstm_p3(KPC P, LAS unsigned char* lds, int grp, int chain, int ci, const int tid0) {
    int tid = tid0; const int wave = __builtin_amdgcn_readfirstlane(tid0 >> 6);
    const int bl = chain >> 3, head = (chain >> 1) & 3, dir = chain & 1;
    unsigned char* ws = P->ws; asm volatile("" : "+s"(ws));
    LAS unsigned char* QI = lds; LAS unsigned char* KI = lds + 128 * MLP; LAS unsigned char* VI = lds + 2 * 128 * MLP; LAS unsigned char* CI = lds + 3 * 128 * MLP;
    LAS float* tg = (LAS float*)(lds + TB_OFF); LAS float* tM = tg + 128; LAS float* tbc = tg + 256; LAS float* tnv = tg + 512; LAS float* scal = tg + 640;
    const size_t rowb = (size_t)bl * 2048;
    {
        CHAIN_LANES();
        ml_conv_item(P, (const bf16_t*)(ws + (tid >> 8 ? WS_MK : WS_MQ)), (tid >> 8) ? KI : QI, tid >> 8, tid & 15, (tid >> 4) & 15, ci, dir, rowb, head);
        {
            const int t = tid >> 2, c0 = (tid & 3) * 32; const int tau = 128 * ci + t; const int p = dir ? 2047 - tau : tau;
            const bf16_t* vsrc = (const bf16_t*)(ws + WS_MV) + (rowb + p) * 512 + head * 128 + c0;
#pragma unroll
            for (int sub = 0; sub < 4; ++sub) *(LAS u32x4*)(VI + t * MLP + c0 * 2 + sub * 16) = *(const u32x4*)(vsrc + 8 * sub);
            const bf16_t* dc = (const bf16_t*)(ws + WS_XB) + (size_t)grp * TG * DM + ((size_t)chain * 16 + ci) * 16384;
#pragma unroll
            for (int i = 0; i < 4; ++i) { const int ix = tid + 512 * i; *(LAS u32x4*)(CI + (ix >> 4) * MLP + (ix & 15) * 16) = *(const u32x4*)(dc + (size_t)ix * 8); }
        }
        if (wave == 1) tnv[lane] = ((const float*)(ws + WS_DN))[((size_t)chain * 16 + ci) * 128 + lane];
        if (wave == 2) tnv[64 + lane] = ((const float*)(ws + WS_DN))[((size_t)chain * 16 + ci) * 128 + 64 + lane];
        if (wave == 0) {
            const float* MIF = (const float*)(ws + WS_MIF);
            const float bli = P->ml_gate_b[(dir ? 8 : 0) + head], blf = P->ml_gate_b[(dir ? 12 : 4) + head];
            const float mcur = ((const float*)(ws + WS_SCL))[((size_t)chain * 16 + ci) * 4 + 2];
            const int tau1 = 128 * ci + lane, tau2 = tau1 + 64; const int p1 = dir ? 2047 - tau1 : tau1, p2 = dir ? 2047 - tau2 : tau2;
            const float* r1 = MIF + (rowb + p1) * 16 + head; const float* r2 = MIF + (rowb + p2) * 16 + head;
            const float li1 = r1[dir ? 8 : 0] + bli, li2 = r2[dir ? 8 : 0] + bli;
            const float lf1 = log_sigmoid(r1[dir ? 12 : 4] + blf), lf2 = log_sigmoid(r2[dir ? 12 : 4] + blf);
            const float c1 = scan_add(lf1, lane); const float tot1 = __shfl(c1, 63); const float c2 = scan_add(lf2, lane) + tot1;
            const float g1 = li1 - c1, g2 = li2 - c2;
            const float x1 = scan_max(g1, lane); const float mx1 = __shfl(x1, 63); const float x2 = fmaxf(scan_max(g2, lane), mx1);
            tg[lane] = g1; tg[64 + lane] = g2; tM[lane] = fmaxf(x1, mcur); tM[64 + lane] = fmaxf(x2, mcur); tbc[lane] = c1; tbc[64 + lane] = c2;
            if (lane == 0) scal[0] = mcur;
        }
    }
    __syncthreads();
    {
        CHAIN_LANES();
        bf16_t* Hout = (bf16_t*)(ws + (dir ? WS_HB : WS_HF));
        const int tb = wave >> 1, vh = wave & 1; const int t = 32 * tb + r;
        const float Mt = tM[t], bct = tbc[t], mold = scal[0];
        const float winter = __expf(mold - Mt), flo = __expf(-(Mt + bct));
        bf16x8 qf[8];
#pragma unroll
        for (int ks = 0; ks < 8; ++ks) qf[ks] = *(const LAS bf16x8*)(QI + t * MLP + (16 * ks + 8 * h) * 2);
        f32x16 na[2]; na[0] = zero16(); na[1] = zero16();
        float den = 0.f;
        for (int sb = 0; sb <= tb; ++sb) {
            f32x16 st = zero16();
#pragma unroll
            for (int ks = 0; ks < 8; ++ks) st = mfma32(*(const LAS bf16x8*)(KI + (32 * sb + r) * MLP + (16 * ks + 8 * h) * 2), qf[ks], st);
            MEMFENCE();
#pragma unroll
            for (int i = 0; i < 16; ++i) {
                const int sl = crow(i, h); const float wgt = __expf(tg[32 * sb + sl] - Mt);
                const bool valid = (sb < tb) || (sl <= r);
                const float v = valid ? st[i] * wgt : 0.f; st[i] = v; den += v;
            }
#pragma unroll
            for (int ks2 = 0; ks2 < 2; ++ks2) {
                const bf16x8 pb = pack8(st, ks2);
#pragma unroll
                for (int jv = 0; jv < 2; ++jv) {
                    LAS unsigned char* vp = VI + trofs + (32 * sb + 16 * ks2 + 4 * h) * MLP + 64 * (2 * vh + jv);
                    const s16x4 lo = trread(vp), hi = trread(vp + 8 * MLP);
                    na[jv] = mfma32(cat44(lo, hi), pb, na[jv]);
                }
            }
        }
        den += __shfl_xor(den, 32);
        float dq = 0.f;
#pragma unroll
        for (int ks = 0; ks < 8; ++ks) {
            const u32x4 w = __builtin_bit_cast(u32x4, qf[ks]); const LAS float* nv = tnv + 16 * ks + 8 * h;
            const float q0 = bflo(w.x), q1 = bfhi(w.x), q2 = bflo(w.y), q3 = bfhi(w.y), q4_ = bflo(w.z), q5 = bfhi(w.z), q6 = bflo(w.w), q7 = bfhi(w.w);
            dq += (nv[0] * q0 + nv[1] * q1) + (nv[2] * q2 + nv[3] * q3) + (nv[4] * q4_ + nv[5] * q5) + (nv[6] * q6 + nv[7] * q7);
            u32x4 o; o.x = pkbf(q0 * winter, q1 * winter); o.y = pkbf(q2 * winter, q3 * winter); o.z = pkbf(q4_ * winter, q5 * winter); o.w = pkbf(q6 * winter, q7 * winter);
            const bf16x8 qs = __builtin_bit_cast(bf16x8, o);
#pragma unroll
            for (int jv = 0; jv < 2; ++jv)
                na[jv] = mfma32(*(const LAS bf16x8*)(CI + (32 * (2 * vh + jv) + r) * MLP + (16 * ks + 8 * h) * 2), qs, na[jv]);
        }
        dq += __shfl_xor(dq, 32);
        den += winter * dq;
        const float inv = 1.0f / fmaxf(fabsf(den), flo);
        const int tau = 128 * ci + t; const int p = dir ? 2047 - tau : tau;
        bf16_t* dst = Hout + (rowb + p) * 512 + head * 128;
#pragma unroll
        for (int jv = 0; jv < 2; ++jv)
#pragma unroll
            for (int g4 = 0; g4 < 4; ++g4) {
                u32x2 w; w.x = pkbf(na[jv][4 * g4] * inv, na[jv][4 * g4 + 1] * inv); w.y = pkbf(na[jv][4 * g4 + 2] * inv, na[jv][4 * g4 + 3] * inv);
                *(u32x2*)(dst + 32 * (2 * vh + jv) + 8 * g4 + 4 * h) = w;
            }
    }
    __syncthreads();
}

DI void merge_pass(KPC P, int gw, int NGW, int lane, const bool do_att) {
    unsigned char* ws = P->ws;
    const bf16_t* AO = (const bf16_t*)(ws + WS_AQ); const float* LSE = (const float*)(ws + WS_LSE);
    const bf16_t* HF = (const bf16_t*)(ws + WS_HF); const bf16_t* HB = (const bf16_t*)(ws + WS_HB); const bf16_t* MO = (const bf16_t*)(ws + WS_MO);
    bf16_t* YA = (bf16_t*)(ws + WS_YATT); bf16_t* YM = (bf16_t*)(ws + WS_YML);
    for (int tok = gw; tok < TG; tok += NGW) {
        const int bl = tok >> 11, s = tok & 2047;
        if (do_att) {
            const int slot = lane >> 3, d0 = 8 * (lane & 7);
            float ls[3], mx = NEGF;
#pragma unroll
            for (int g = 0; g < 3; ++g) { ls[g] = LSE[((size_t)g * TG + tok) * 8 + slot]; mx = fmaxf(mx, ls[g]); }
            float e[3], sum = 0.f;
#pragma unroll
            for (int g = 0; g < 3; ++g) { e[g] = __expf(ls[g] - mx); sum += e[g]; }
            const float isum = 1.0f / sum;
            float acc[8];
#pragma unroll
            for (int k = 0; k < 8; ++k) acc[k] = 0.f;
#pragma unroll
            for (int g = 0; g < 3; ++g) {
                const int sh = 2 * g; const int perm = ((s & ((1 << sh) - 1)) << (11 - sh)) + (s >> sh);
                const u32x4 w = *(const u32x4*)(AO + ((size_t)(bl * 24 + g * 8 + slot) * 2048 + perm) * 64 + d0);
                const float a = e[g] * isum;
                acc[0] += a * bflo(w.x); acc[1] += a * bfhi(w.x); acc[2] += a * bflo(w.y); acc[3] += a * bfhi(w.y);
                acc[4] += a * bflo(w.z); acc[5] += a * bfhi(w.z); acc[6] += a * bflo(w.w); acc[7] += a * bfhi(w.w);
            }
            u32x4 o; o.x = pkbf(acc[0], acc[1]); o.y = pkbf(acc[2], acc[3]); o.z = pkbf(acc[4], acc[5]); o.w = pkbf(acc[6], acc[7]);
            *(u32x4*)(YA + (size_t)tok * 512 + slot * 64 + d0) = o;
        }
        if (!do_att) {
            const size_t off = (size_t)tok * 512 + 8 * lane;
            const u32x4 a = *(const u32x4*)(HF + off), b = *(const u32x4*)(HB + off), mo = *(const u32x4*)(MO + off);
            float v[8];
            v[0] = bflo(a.x) + bflo(b.x); v[1] = bfhi(a.x) + bfhi(b.x); v[2] = bflo(a.y) + bflo(b.y); v[3] = bfhi(a.y) + bfhi(b.y);
            v[4] = bflo(a.z) + bflo(b.z); v[5] = bfhi(a.z) + bfhi(b.z); v[6] = bflo(a.w) + bflo(b.w); v[7] = bfhi(a.w) + bfhi(b.w);
            float ss = 0.f;
#pragma unroll
            for (int k = 0; k < 8; ++k) ss += v[k] * v[k];
            ss += __shfl_xor(ss, 1); ss += __shfl_xor(ss, 2); ss += __shfl_xor(ss, 4); ss += __shfl_xor(ss, 8);
            const float rs = 1.0f / sqrtf(ss * (1.0f / 128.0f) + EPS);
            const f32x4 ga = *(const f32x4*)(P->ml_out_gain + 8 * lane), gb = *(const f32x4*)(P->ml_out_gain + 8 * lane + 4);
            float mg[8]; mg[0] = bflo(mo.x); mg[1] = bfhi(mo.x); mg[2] = bflo(mo.y); mg[3] = bfhi(mo.y); mg[4] = bflo(mo.z); mg[5] = bfhi(mo.z); mg[6] = bflo(mo.w); mg[7] = bfhi(mo.w);
            const float gg[8] = {ga.x, ga.y, ga.z, ga.w, gb.x, gb.y, gb.z, gb.w};
            float y[8];
#pragma unroll
            for (int k = 0; k < 8; ++k) y[k] = v[k] * rs * gg[k] * sigmoidf_(mg[k]);
            u32x4 o; o.x = pkbf(y[0], y[1]); o.y = pkbf(y[2], y[3]); o.z = pkbf(y[4], y[5]); o.w = pkbf(y[6], y[7]);
            *(u32x4*)(YM + off) = o;
        }
    }
}

DI void final_norm(KPC P, int gw, int NGW, int lane) {
    const float* part = (const float*)(P->ws + WS_PART + 3 * SS_STRIDE);
    for (int row = gw; row < T_; row += NGW) {
        const float rs = rstd_part(part, row);
        f32x4* xr = (f32x4*)(P->out + (size_t)row * DM) + lane; const f32x4* gr = (const f32x4*)P->norm_final + lane;
#pragma unroll
        for (int j = 0; j < 4; ++j) { const f32x4 v = xr[64 * j]; xr[64 * j] = v * rs * gr[64 * j]; }
    }
}

#define XB_TMO      128
#define XB_XCNT(j)  (256  + 64 * (j))
#define XB_XSUB(j)  (1280 + 64 * (j))
#define XB_XGEN(j)  (2304 + 64 * (j))
#define XB_TOP      3328
#define XB_TOPGEN   3392
#define XCD_BAR_WORDS 3456
#define XB_SPIN_CAP (1u << 22)
DI unsigned xb_ld(unsigned* p)              { return __hip_atomic_load(p, __ATOMIC_RELAXED, __HIP_MEMORY_SCOPE_AGENT); }
DI unsigned xb_add(unsigned* p, unsigned v) { return __hip_atomic_fetch_add(p, v, __ATOMIC_RELAXED, __HIP_MEMORY_SCOPE_AGENT); }
DI unsigned xb_xcc_id() { return (unsigned)__builtin_amdgcn_s_getreg((3 << 11) | 20) & 0xFu; }
#define XB_SPIN(cond, bar) do { unsigned _sp = 0; while (cond) { __builtin_amdgcn_s_sleep(1); \
    if ((++_sp & 255u) == 0u) { if (xb_ld(&(bar)[XB_TMO])) break; if (_sp > XB_SPIN_CAP) { atomicAdd(&(bar)[XB_TMO], 1u); break; } } } } while (0)
struct XcdBarrier { unsigned* bar; unsigned x; volatile LAS unsigned* st; };
DI XcdBarrier xcd_barrier_post(unsigned* bar, volatile LAS unsigned* st) {
    XcdBarrier b; b.bar = bar; b.x = xb_xcc_id(); b.st = st;
    if (threadIdx.x == 0) (void)xb_add(&bar[XB_XCNT(b.x)], 1u);
    return b;
}
DI void xcd_barrier_complete(unsigned* bar, unsigned x, unsigned& nloc, unsigned& nx) {
    const unsigned G = gridDim.x * gridDim.y * gridDim.z;
    unsigned sum, cnt, mine, sp = 0u;
    for (;;) {
        sum = 0u; cnt = 0u; mine = 0u;
#pragma unroll
        for (unsigned j = 0; j < 16; ++j) { const unsigned c = xb_ld(&bar[XB_XCNT(j)]); sum += c; cnt += (c > 0u) ? 1u : 0u; mine = (j == x) ? c : mine; }
        if (sum == G) break;
        __builtin_amdgcn_s_sleep(1);
        if ((++sp & 255u) == 0u) { if (xb_ld(&bar[XB_TMO])) break; if (sp > XB_SPIN_CAP) { atomicAdd(&bar[XB_TMO], 1u); break; } }
    }
    nloc = mine > 0u ? mine : 1u; nx = cnt > 0u ? cnt : 1u;
}
DI void xcd_barrier(const XcdBarrier& b) {
    asm volatile("s_waitcnt vmcnt(0)" ::: "memory");
    __syncthreads();
    if (threadIdx.x == 0) {
        unsigned* bar = b.bar;
        __builtin_amdgcn_s_waitcnt(0);
        unsigned nloc = b.st[0], nx = b.st[1];
        if (nloc == 0u) { xcd_barrier_complete(bar, b.x, nloc, nx); b.st[0] = nloc; b.st[1] = nx; }
        const unsigned old = xb_add(&bar[XB_XSUB(b.x)], 1u);
        const unsigned gen = old / nloc;
        if (old + 1u == (gen + 1u) * nloc) {
            __builtin_amdgcn_fence(__ATOMIC_RELEASE, "agent");
            asm volatile("s_waitcnt vmcnt(0)" ::: "memory");
            const unsigned og = xb_add(&bar[XB_TOP], 1u);
            const unsigned tg = og / nx;
            if (og + 1u == (tg + 1u) * nx) xb_add(&bar[XB_TOPGEN], 1u);
            else XB_SPIN(xb_ld(&bar[XB_TOPGEN]) == tg, bar);
            __builtin_amdgcn_fence(__ATOMIC_ACQUIRE, "agent");
            xb_add(&bar[XB_XGEN(b.x)], 1u);
            asm volatile("s_waitcnt vmcnt(0)" ::: "memory");
        } else {
            XB_SPIN(xb_ld(&bar[XB_XGEN(b.x)]) == gen, bar);
            __builtin_amdgcn_fence(__ATOMIC_ACQUIRE, "agent");
            asm volatile("s_waitcnt vmcnt(0)" ::: "memory");
        }
    }
    __syncthreads();
}

__global__ void __launch_bounds__(512, 2) mega_fwd(KP Pv, int step_lo, int step_hi, int coop) {
    extern __shared__ __attribute__((aligned(16))) unsigned char lds_raw[];
    LAS unsigned char* lds = (LAS unsigned char*)lds_raw;
    const int G = gridDim.x, NGW = G * 8;
    cg::grid_group grid = cg::this_grid();
    volatile LAS unsigned* misc = (volatile LAS unsigned*)(lds + LDS_BYTES - 256);
    if (threadIdx.x < 8) misc[threadIdx.x] = 0u;
    __syncthreads();
    XcdBarrier xbar = xcd_barrier_post((unsigned*)(Pv.ws + WS_CTL) + 4096, misc);
#pragma unroll 1
    for (int step = step_lo; step < step_hi; ++step) {
        int tid = threadIdx.x; asm volatile("" : "+v"(tid));
        const int lane = tid & 63, wave = __builtin_amdgcn_readfirstlane(tid >> 6);
        int bid = blockIdx.x; asm volatile("" : "+s"(bid));
        const int gw = bid * 8 + wave;
        KPC P = (KPC)__builtin_amdgcn_kernarg_segment_ptr(); asm volatile("" : "+s"(P));
        unsigned char* ws = P->ws; asm volatile("" : "+s"(ws));
        unsigned* ctl = (unsigned*)(ws + WS_CTL);
        bool is_gemm = false, do_sync = true, perm = true;
        pg8::Gemm g{nullptr, nullptr, 0, 0, 0};
        EpiAny E; E.kind = 0; E.aux = 0; E.goff = 0; E.ws = ws; E.kp = P;
        bf16_t* xb = (bf16_t*)(ws + WS_XB);
        int grp = 0, sub = -1;
        if (step >= 5 && step < 23) { grp = (step - 5) / 9; sub = (step - 5) % 9; }
        const int goff = grp * TG;
        if (step == 0) {
            prepass(P, lds, gw, NGW, wave, lane);
        } else if (step == 1) {
            is_gemm = true; do_sync = false; g = pg8::Gemm{xb, (const bf16_t*)(ws + WS_W1), T_, 2 * DFF, 1024};
            E.kind = EK_SWIGLU;
        } else if (step == 2) {
            is_gemm = true; g = pg8::Gemm{(const bf16_t*)(ws + WS_MEMB), (const bf16_t*)(ws + WS_WMEM), MEMROWS, 1024, 1024};
            E.kind = EK_MEMKV;
        } else if (step == 3) {
            cknorm(P, gw, NGW, lane); do_sync = false;
        } else if (step == 4) {
            is_gemm = true; perm = false; g = pg8::Gemm{(const bf16_t*)(ws + WS_ACT), (const bf16_t*)(ws + WS_W2), T_, 1024, DFF};
            E.kind = EK_RESID; E.aux = 0;
        } else if (sub == 0) {
            is_gemm = true; g = pg8::Gemm{xb + (size_t)goff * DM, (const bf16_t*)(ws + WS_WIN), TG, NWIN, 1024};
            E.kind = EK_WIN; E.goff = goff;
        } else if (sub == 1 || sub == 3) {
#pragma unroll 1
            for (int u = bid; u < 1024 * REP_ML; u += G) {
                if (sub == 1) mlstm_p1(P, lds, grp, (u >> 4) & 63, u & 15, tid);
                else mlstm_p3(P, lds, grp, (u >> 4) & 63, u & 15, tid);
            }
            __syncthreads();
#pragma unroll 1
            for (int u = bid; u < (sub == 1 ? BL * 24 * 8 : BL * 4 * 8); u += G) {
                if (sub == 1) att_wg_unit(ws, lds, u, tid);
                else cross_wg_unit(P, lds, grp, u, tid);
            }
        } else if (sub == 2) {
#pragma unroll 1
            for (int w = bid; w < 256; w += G) mlstm_scan(ws, grp, w, tid);
            merge_pass(P, gw, NGW, lane, true);
        } else if (sub == 4) {
            merge_pass(P, gw, NGW, lane, false);
        } else if (sub >= 5 && sub <= 7) {
            const int b = sub - 5; is_gemm = true; perm = false; do_sync = (b == 2);
            const bf16_t* A = (const bf16_t*)(ws + (b == 0 ? WS_YATT : (b == 1 ? WS_YML : WS_CQ)));
            g = pg8::Gemm{A, (const bf16_t*)(ws + WS_WBR) + (size_t)b * 1024 * 512, TG, 1024, 512};
            E.kind = EK_BR0 + b;
        } else if (sub == 8) {
            is_gemm = true; perm = false; g = pg8::Gemm{(const bf16_t*)(ws + WS_MB16), (const bf16_t*)(ws + WS_WOUT), TG, 1024, 1024};
            E.kind = EK_RESID; E.aux = 1; E.goff = goff;
        } else if (step == 23) {
            is_gemm = true; g = pg8::Gemm{xb, (const bf16_t*)(ws + WS_W3), T_, 2 * DFF, 1024};
            E.kind = EK_SWIGLU; E.aux = 1;
        } else if (step == 24) {
            is_gemm = true; perm = false; g = pg8::Gemm{(const bf16_t*)(ws + WS_ACT), (const bf16_t*)(ws + WS_W4), T_, 1024, DFF};
            E.kind = EK_RESID; E.aux = 2;
        } else if (step == 25) {
            final_norm(P, gw, NGW, lane); do_sync = false;
        }
        if (is_gemm) {
            pg8::StaticOrder S; S.init(g.M, g.N, G, bid);
#ifndef REP_MASK
#define REP_MASK 0
#endif
            const int nrep = 1 + (int)((REP_MASK >> step) & 1);
#pragma unroll 1
            for (int rp = 0; rp < nrep; ++rp) pg8::gemm_phase<EpiAny>(lds, g, S, E, perm, tid);
        }
        __syncthreads();
#ifndef REP_SYNC
#define REP_SYNC 1
#endif
        if (coop && do_sync && step + 1 < step_hi) { if (coop == 2) grid.sync(); else { for (int rp = 0; rp < REP_SYNC; ++rp) xcd_barrier(xbar); } }
    }
}

extern "C" void kernel_launch(void* const* d_in, const int* in_sizes, int n_in, void* d_out, int out_size, void* d_ws, size_t ws_size, hipStream_t stream) {
    static int grid = 0;
    if (grid == 0) {
        if (n_in != 26 || ws_size < WS_END) { fprintf(stderr, "kernel_launch: unexpected n_in %d or ws_size %zu (need %zu)\n", n_in, ws_size, (size_t)WS_END); grid = -1; return; }
        int dev = 0, cus = 0, per_cu = 0;
        hipGetDevice(&dev); hipDeviceGetAttribute(&cus, hipDeviceAttributeMultiprocessorCount, dev);
        if (hipFuncSetAttribute((const void*)mega_fwd, hipFuncAttributeMaxDynamicSharedMemorySize, LDS_BYTES) != hipSuccess) { fprintf(stderr, "kernel_launch: hipFuncSetAttribute failed\n"); }
        hipOccupancyMaxActiveBlocksPerMultiprocessor(&per_cu, (const void*)mega_fwd, 512, LDS_BYTES);
        (void)hipGetLastError();
        if (per_cu < 1) per_cu = 1;
        grid = cus;
        fprintf(stderr, "kernel_launch: cus %d per_cu %d grid %d ws %zu\n", cus, per_cu, grid, ws_size);
    }
    if (grid < 0) return;
    hipMemsetAsync((char*)d_ws + WS_CTL, 0, 65536, stream);
    KP p{};
    const float** pp = (const float**)&p;
    for (int i = 0; i < 26; ++i) pp[i] = (const float*)d_in[i];
    p.out = (float*)d_out; p.ws = (unsigned char*)d_ws;
    int lo = 0, hi = 26, coop = 1;
    void* args[] = {&p, &lo, &hi, &coop};
    hipError_t e = hipLaunchCooperativeKernel((const void*)mega_fwd, dim3(grid), dim3(512), args, LDS_BYTES, stream);
    if (e != hipSuccess) fprintf(stderr, "cooperative launch failed: %s (grid %d)\n", hipGetErrorString(e), grid);
}
```

```cpp
#include <hip/hip_runtime.h>
#include <hip/hip_cooperative_groups.h>
#include <cstdio>
#include <cstdint>
namespace cg = cooperative_groups;

#define LAS __attribute__((address_space(3)))
#define GAS __attribute__((address_space(1)))
#define DI __device__ __forceinline__
typedef unsigned short bf16_t;
typedef short bf16x8 __attribute__((ext_vector_type(8)));
typedef short s16x4 __attribute__((ext_vector_type(4)));
typedef float f32x4 __attribute__((ext_vector_type(4)));
typedef float f32x16 __attribute__((ext_vector_type(16)));
typedef unsigned u32x4 __attribute__((ext_vector_type(4)));
typedef unsigned u32x2 __attribute__((ext_vector_type(2)));

constexpr int T_ = 32768, TG = 16384, NGRP = 2, BL = 8, S_ = 2048, DM = 1024, DFF = 2816, MEMROWS = 4096;
constexpr int NWIN = 10496, NIN = 10256;
constexpr float EPS = 1e-6f;
constexpr float NEGF = -1e30f;

constexpr size_t MiB = 1u << 20;
constexpr size_t WS_CTL = 0;
constexpr size_t WS_W1 = 1 * MiB, WS_W2 = 12 * MiB, WS_WIN = 18 * MiB, WS_WMEM = 39 * MiB, WS_WBR = 41 * MiB, WS_WOUT = 44 * MiB, WS_W3 = 46 * MiB, WS_W4 = 57 * MiB;
constexpr size_t WS_ROPE = 63 * MiB;
constexpr size_t WS_SSM = 63 * MiB + 512 * 1024;
constexpr size_t WS_PART = 64 * MiB;
constexpr size_t SS_STRIDE = 131072;
constexpr size_t WS_CKV = 66 * MiB;
constexpr size_t WS_XB = 74 * MiB;
constexpr size_t WS_ACT = 138 * MiB;
constexpr size_t WS_AQ = 138 * MiB, WS_AK = 186 * MiB, WS_AV = 234 * MiB;
constexpr size_t WS_MQ = 282 * MiB;
constexpr size_t WS_MK = 298 * MiB, WS_MV = 314 * MiB, WS_MO = 330 * MiB, WS_CQ = 346 * MiB;
constexpr size_t WS_GTS = 362 * MiB;
constexpr size_t WS_MIF1 = 494 * MiB;
constexpr size_t WS_MIF = 458 * MiB;
constexpr size_t WS_LSE = 459 * MiB;
constexpr size_t WS_HF = 461 * MiB, WS_HB = 477 * MiB;
constexpr size_t WS_MEMB = 461 * MiB;
constexpr size_t WS_YATT = 186 * MiB, WS_YML = 202 * MiB, WS_YCX = 218 * MiB;
constexpr size_t WS_M32 = 234 * MiB;
constexpr size_t WS_MB16 = 298 * MiB;
constexpr size_t WS_END = 495 * MiB;

constexpr int LDS_BYTES = 163840;
constexpr int MLP = 272;
constexpr int MLT = 320;
constexpr int TB_OFF = 2 * 128 * MLP + 2 * 128 * MLT;

DI unsigned pkbf(float lo, float hi) {
    typedef float f2 __attribute__((ext_vector_type(2))); typedef __bf16 b2 __attribute__((ext_vector_type(2)));
    f2 v = {lo, hi}; b2 b = __builtin_convertvector(v, b2); return __builtin_bit_cast(unsigned, b);
}
DI float frcp(float x) { return __builtin_amdgcn_rcpf(x); }
DI float frsq(float x) { return __builtin_amdgcn_rsqf(x); }
DI float bflo(unsigned u) { return __uint_as_float(u << 16); }
DI float bfhi(unsigned u) { return __uint_as_float(u & 0xffff0000u); }
DI float shx(float v, int k, int lane) { return __int_as_float(__builtin_amdgcn_ds_bpermute((lane ^ k) << 2, __float_as_int(v))); }
DI float shup(float v, int d, int lane) { return __int_as_float(__builtin_amdgcn_ds_bpermute((lane - d) << 2, __float_as_int(v))); }
DI float rdlane(float v, int l) { return __int_as_float(__builtin_amdgcn_readlane(__float_as_int(v), l)); }
#define SHX(v, k) shx((v), (k), lane)
DI float wave_sum_l(float v, int lane) {
#pragma unroll
    for (int o = 1; o < 64; o <<= 1) v += shx(v, o, lane);
    return v;
}
#define wave_sum(v) wave_sum_l((v), lane)
DI int crow(int i, int h) { return (i & 3) + 8 * (i >> 2) + 4 * h; }
DI f32x16 mfma32(bf16x8 a, bf16x8 b, f32x16 c) { return __builtin_amdgcn_mfma_f32_32x32x16_bf16(a, b, c, 0, 0, 0); }
DI bf16x8 pack8(const f32x16& x, int s) {
    u32x4 p;
    p.x = pkbf(x[8 * s + 0], x[8 * s + 1]); p.y = pkbf(x[8 * s + 2], x[8 * s + 3]);
    p.z = pkbf(x[8 * s + 4], x[8 * s + 5]); p.w = pkbf(x[8 * s + 6], x[8 * s + 7]);
    return __builtin_bit_cast(bf16x8, p);
}
DI f32x16 zero16() { f32x16 z; for (int i = 0; i < 16; ++i) z[i] = 0.f; return z; }
typedef short v4i16_t __attribute__((ext_vector_type(4)));
DI s16x4 trread(LAS unsigned char* p) { return __builtin_bit_cast(s16x4, __builtin_amdgcn_ds_read_tr16_b64_v4i16((LAS v4i16_t*)p)); }
DI bf16x8 cat44(s16x4 lo, s16x4 hi) { return (bf16x8){lo[0], lo[1], lo[2], lo[3], hi[0], hi[1], hi[2], hi[3]}; }
#define LDS_FENCE() asm volatile("s_waitcnt lgkmcnt(0)" ::: "memory")
DI float rstd_part(const GAS float* part, int row) { return frsq(part[row] * (1.0f / 1024.0f) + EPS); }
#define MEMFENCE() asm volatile("" ::: "memory")
#define LOAD_RS8(rsv, part, row0) float rsv[2][4]; _Pragma("unroll") for (int ai_ = 0; ai_ < 2; ++ai_) _Pragma("unroll") for (int m_ = 0; m_ < 4; ++m_) rsv[ai_][m_] = (part)[(row0) + ai_ * 128 + m_ * 16]; \
    _Pragma("unroll") for (int ai_ = 0; ai_ < 2; ++ai_) _Pragma("unroll") for (int m_ = 0; m_ < 4; ++m_) rsv[ai_][m_] = frsq(rsv[ai_][m_] * (1.0f / 1024.0f) + EPS)
DI float sigmoidf_(float v) { return frcp(1.0f + __expf(-v)); }

struct KP {
    const float* x; const float* mem; const float* norm_ffn1; const float* w_ffn1_in; const float* w_ffn1_out;
    const float* norm_mix; const float* norm_mem; const float* w_in; const float* att_q_gain; const float* att_k_gain;
    const float* ml_conv_w; const float* ml_conv_b; const float* ml_gate_b; const float* ml_out_gain;
    const float* cx_q_gain; const float* cx_k_gain; const float* w_mem_kv; const float* mix_gate_b;
    const float* w_br_att; const float* w_br_ml; const float* w_br_cx; const float* w_out;
    const float* norm_ffn2; const float* w_ffn2_in; const float* w_ffn2_out; const float* norm_final;
    float* out; unsigned char* ws;
};
typedef const KP __attribute__((address_space(4)))* KPC;

enum EpiKind { EK_SWIGLU = 0, EK_RESID = 1, EK_WIN = 2, EK_MEMKV = 3, EK_BR0 = 4 };
namespace pg8 {
constexpr int BM = 256, BK = 64, HALF = 128, HTB = HALF * BK * 2, STAGE_BYTES = 8 * HTB, NXCD = 8, WGM = 8;
DI int lds_byte(int r, int c) { const int st = (r >> 4) * 2 + (c >> 5), rr = r & 15, cc = c & 31, ob = rr * 64 + cc * 2; return st * 1024 + (ob ^ (((ob >> 9) & 1) << 5)); }
DI void stage_rc(int b, int& R, int& C) { const int st = b / 1024, sb = b % 1024, swz = sb ^ (((sb >> 9) & 1) << 5); R = (st >> 1) * 16 + swz / 64; C = (st & 1) * 32 + (swz % 64) / 2; }
DI int perm32(int rho) { const int n = rho >> 4, i = rho & 15; return 8 * (i >> 2) + 4 * n + (i & 3); }
struct Unit { int pm, pn; };
struct Gemm { const GAS bf16_t* A; const GAS bf16_t* Bt; int M, N, K; };
struct StaticOrder {
    int nM, nN, nwg, G, c;
    DI void init(int M, int N, int G_, int c_) { nM = M / BM; nN = N / BM; nwg = nM * nN; G = G_; c = c_; }
    DI bool next(int i, Unit& u) const {
        const long L = (long)i * G + c; if (L >= nwg) return false;
        int wgid = (int)L; { const int q = nwg / NXCD, r = nwg % NXCD, xcd = wgid % NXCD, off = wgid / NXCD; wgid = (xcd < r ? xcd * (q + 1) : r * (q + 1) + (xcd - r) * q) + off; }
        const int nig = WGM * nN, gid = wgid / nig, fm = gid * WGM, gsz = (nM - fm) < WGM ? (nM - fm) : WGM;
        u.pm = fm + ((wgid % nig) % gsz); u.pn = (wgid % nig) / gsz; return true;
    }
};
template <class Epi>
DI void gemm_phase(LAS unsigned char* lds, const Gemm g, const StaticOrder& S, const Epi& E, const bool perm, const int tid) {
    const int wid = __builtin_amdgcn_readfirstlane(tid >> 6), lane = tid & 63, wr = wid >> 2, wc = wid & 3, fr = lane & 15, fq = lane >> 4;
    const int K = g.K, nt = K / BK;
    unsigned voffA[2], voffB[2];
#pragma unroll
    for (int i = 0; i < 2; ++i) { int R, C; stage_rc(tid * 16 + i * 8192, R, C); const int Rb = perm ? ((R & ~31) + perm32(R & 31)) : R;
        voffA[i] = (unsigned)(R * K + C) * 2u; voffB[i] = (unsigned)(Rb * K + C) * 2u; }
    const size_t kstep = (size_t)(BK * 2);
    const size_t hstep = (size_t)HALF * K * 2;
    const size_t tstep = 2 * hstep;
    const unsigned ldsw = (unsigned)wid * 1024u;
    const int aoff = lds_byte(wr * 64 + fr, fq * 8), boff = lds_byte(wc * 32 + fr, fq * 8);
#define PG8_SA(b, h) (((b) * 2 + (h)) * HTB)
#define PG8_SB(b, h) ((4 + (b) * 2 + (h)) * HTB)
#define PG8_STAGE(bufoff, gbase, voff) do { _Pragma("unroll") for (int _i = 0; _i < 2; ++_i) \
        __builtin_amdgcn_global_load_lds((const GAS unsigned*)((const char*)(gbase) + (voff)[_i]), (LAS unsigned*)(lds + (bufoff) + ldsw + _i * 8192), 16, 0, 0); } while (0)
#define PG8_LDA(dst, b, h) do { _Pragma("unroll") for (int m = 0; m < 4; ++m) _Pragma("unroll") for (int k = 0; k < 2; ++k) dst[m][k] = *(const LAS bf16x8*)(lds + PG8_SA(b, h) + aoff + m * 2048 + k * 1024); } while (0)
#define PG8_LDB(dst, b, h) do { _Pragma("unroll") for (int n = 0; n < 2; ++n) _Pragma("unroll") for (int k = 0; k < 2; ++k) dst[n][k] = *(const LAS bf16x8*)(lds + PG8_SB(b, h) + boff + n * 2048 + k * 1024); } while (0)
#define PG8_MMA(ai, bj, At, Bt) do { __builtin_amdgcn_s_setprio(1); _Pragma("unroll") for (int m = 0; m < 4; ++m) _Pragma("unroll") for (int n = 0; n < 2; ++n) _Pragma("unroll") for (int k = 0; k < 2; ++k) \
        acc[ai][bj][m][n] = __builtin_amdgcn_mfma_f32_16x16x32_bf16(Bt[n][k], At[m][k], acc[ai][bj][m][n], 0, 0, 0); __builtin_amdgcn_s_setprio(0); } while (0)
#define PG8_WAIT_V(n) asm volatile("s_waitcnt vmcnt(" #n ")" ::: "memory")
#define PG8_WAIT_L(n) asm volatile("s_waitcnt lgkmcnt(" #n ")" ::: "memory")
#define PG8_BAR __builtin_amdgcn_s_barrier()
#define PG8_SCHED __builtin_amdgcn_sched_barrier(0)
    Unit cur, nxt; int ui = 0;
    if (!S.next(0, cur)) return;
    f32x4 acc[2][2][4][2];
#pragma unroll
    for (int a = 0; a < 2; ++a)
#pragma unroll
        for (int b = 0; b < 2; ++b)
#pragma unroll
            for (int m = 0; m < 4; ++m)
#pragma unroll
                for (int n = 0; n < 2; ++n) acc[a][b][m][n] = (f32x4){0.f, 0.f, 0.f, 0.f};
    bf16x8 At[4][2], B0[2][2], B1[2][2];
    const char* cA = (const char*)g.A + (size_t)cur.pm * tstep; const char* cB = (const char*)g.Bt + (size_t)cur.pn * tstep;
    {
        PG8_STAGE(PG8_SB(0, 0), cB, voffB); PG8_STAGE(PG8_SB(0, 1), cB + hstep, voffB); PG8_STAGE(PG8_SA(0, 0), cA, voffA); PG8_STAGE(PG8_SA(0, 1), cA + hstep, voffA);
        if (wr == 1) PG8_BAR;
        PG8_WAIT_V(2); PG8_BAR;
        PG8_STAGE(PG8_SB(1, 0), cB + kstep, voffB); PG8_STAGE(PG8_SA(1, 0), cA + kstep, voffA); PG8_STAGE(PG8_SB(1, 1), cB + hstep + kstep, voffB);
        PG8_WAIT_V(6); PG8_BAR;
    }
    for (;;) {
        const bool has_next = S.next(ui + 1, nxt);
        const char* nA = has_next ? (const char*)g.A + (size_t)nxt.pm * tstep : cA; const char* nB = has_next ? (const char*)g.Bt + (size_t)nxt.pn * tstep : cB;
        for (int t = 0; t < nt; t += 2) {
            const bool last = (t == nt - 2);
            const char* a1 = cA + (size_t)(t + 1) * kstep;
            const char* a2 = last ? nA : cA + (size_t)(t + 2) * kstep; const char* b2 = last ? nB : cB + (size_t)(t + 2) * kstep;
            const char* a3 = a2 + kstep; const char* b3 = b2 + kstep;
            PG8_LDB(B0, 0, 0); PG8_LDB(B1, 0, 1); PG8_SCHED; PG8_LDA(At, 0, 0); PG8_STAGE(PG8_SA(1, 1), a1 + hstep, voffA);
            PG8_WAIT_V(8); PG8_WAIT_L(0); PG8_BAR; PG8_MMA(0, 0, At, B0); PG8_MMA(0, 1, At, B1); PG8_BAR; PG8_SCHED;
            PG8_LDA(At, 0, 1); PG8_STAGE(PG8_SB(0, 0), b2, voffB); PG8_STAGE(PG8_SB(0, 1), b2 + hstep, voffB); PG8_STAGE(PG8_SA(0, 0), a2, voffA);
            PG8_WAIT_V(8); PG8_WAIT_L(0); PG8_BAR; PG8_MMA(1, 0, At, B0); PG8_MMA(1, 1, At, B1); PG8_BAR; PG8_SCHED;
            PG8_LDB(B0, 1, 0); PG8_LDB(B1, 1, 1); PG8_SCHED; PG8_LDA(At, 1, 0); PG8_STAGE(PG8_SA(0, 1), a2 + hstep, voffA);
            PG8_WAIT_V(8); PG8_WAIT_L(0); PG8_BAR; PG8_MMA(0, 0, At, B0); PG8_MMA(0, 1, At, B1); PG8_BAR; PG8_SCHED;
            PG8_LDA(At, 1, 1); PG8_STAGE(PG8_SB(1, 0), b3, voffB); PG8_STAGE(PG8_SB(1, 1), b3 + hstep, voffB); PG8_STAGE(PG8_SA(1, 0), a3, voffA);
            PG8_WAIT_V(8); PG8_WAIT_L(0); PG8_BAR; PG8_MMA(1, 0, At, B0); PG8_MMA(1, 1, At, B1); PG8_BAR; PG8_SCHED;
            if (E.kind == EK_BR0 && (t == 6 || t == 14)) { E.hook(acc, cur, t == 6 ? 0 : 1, wr, wc, fr, fq); PG8_SCHED; }
        }
        if (wr == 0) PG8_BAR;
        E(acc, cur, wr, wc, fr, fq);
        if (!has_next) break;
#pragma unroll
        for (int a = 0; a < 2; ++a)
#pragma unroll
            for (int b = 0; b < 2; ++b)
#pragma unroll
                for (int m = 0; m < 4; ++m)
#pragma unroll
                    for (int n = 0; n < 2; ++n) acc[a][b][m][n] = (f32x4){0.f, 0.f, 0.f, 0.f};
        cur = nxt; cA = nA; cB = nB; ++ui;
        if (wr == 1) PG8_BAR;
    }
    PG8_WAIT_V(0);
    PG8_BAR;
#undef PG8_SA
#undef PG8_SB
#undef PG8_STAGE
#undef PG8_LDA
#undef PG8_LDB
#undef PG8_MMA
#undef PG8_WAIT_V
#undef PG8_WAIT_L
#undef PG8_BAR
#undef PG8_SCHED
}
}

typedef const f32x4 (&AccRef)[2][2][4][2];

struct EpiAny {
    int kind, aux, goff;
    GAS unsigned char* ws; KPC kp;

    DI void swiglu(AccRef acc, const pg8::Unit& u, int wr, int wc, int fr, int fq) const {
        const int lane = fr | (fq << 4); (void)lane;
        const int row0 = u.pm * 256 + wr * 64 + fr, col = u.pn * 128 + wc * 32 + 8 * fq;
        const GAS float* part = (const GAS float*)(ws + WS_PART + (aux ? 2 * SS_STRIDE : 0)); GAS bf16_t* xb = (GAS bf16_t*)(ws + WS_ACT);
        LOAD_RS8(rsv, part, row0);
#pragma unroll
        for (int ai = 0; ai < 2; ++ai)
#pragma unroll
            for (int m = 0; m < 4; ++m) {
                const int row = row0 + ai * 128 + m * 16; const float rs = rsv[ai][m];
                float o[8];
#pragma unroll
                for (int n = 0; n < 2; ++n)
#pragma unroll
                    for (int j = 0; j < 4; ++j) { const float gt = acc[ai][0][m][n][j] * rs, up = acc[ai][1][m][n][j] * rs; o[4 * n + j] = gt * sigmoidf_(gt) * up; }
                u32x4 w; w.x = pkbf(o[0], o[1]); w.y = pkbf(o[2], o[3]); w.z = pkbf(o[4], o[5]); w.w = pkbf(o[6], o[7]);
                *(GAS u32x4*)(xb + (size_t)row * DFF + col) = w;
                if (m & 1) MEMFENCE();
            }
    }
    DI void residual(AccRef acc, const pg8::Unit& u, int wr, int wc, int fr, int fq) const {
        const int lane = fr | (fq << 4); (void)lane;
        const int row0 = goff + u.pm * 256 + wr * 64 + fr, c0 = u.pn * 256 + wc * 32 + 4 * fq;
        const GAS float* resid = ((const GAS float*)kp->x); GAS bf16_t* xb = (GAS bf16_t*)(ws + WS_XB);
        GAS float* partw = (GAS float*)(ws + WS_PART + (size_t)(aux + 1) * SS_STRIDE); const float scale = aux == 1 ? 1.0f : 0.5f;
#pragma unroll
        for (int ai = 0; ai < 2; ++ai) {
            if (aux == 0) {
#pragma unroll
                for (int mh = 0; mh < 2; ++mh) {
                    f32x4 r[2][2][2];
#pragma unroll
                    for (int m2 = 0; m2 < 2; ++m2)
#pragma unroll
                        for (int bj = 0; bj < 2; ++bj)
#pragma unroll
                            for (int n = 0; n < 2; ++n) r[m2][bj][n] = *(const GAS f32x4*)(resid + (size_t)(row0 + ai * 128 + (2 * mh + m2) * 16) * DM + c0 + bj * 128 + n * 16);
#pragma unroll
                    for (int m2 = 0; m2 < 2; ++m2) {
                        const int m = 2 * mh + m2; const int row = row0 + ai * 128 + m * 16; float ssq = 0.f;
#pragma unroll
                        for (int bj = 0; bj < 2; ++bj)
#pragma unroll
                            for (int n = 0; n < 2; ++n) {
                                const f32x4 v = r[m2][bj][n] + acc[ai][bj][m][n] * scale;
                                u32x2 w; w.x = pkbf(v.x, v.y); w.y = pkbf(v.z, v.w); *(GAS u32x2*)(xb + (size_t)row * DM + c0 + bj * 128 + n * 16) = w;
                                ssq += (v.x * v.x + v.y * v.y) + (v.z * v.z + v.w * v.w);
                            }
                        ssq += SHX(ssq, 16); ssq += SHX(ssq, 32);
                        if (fq == 0) unsafeAtomicAdd((float*)(partw + row), ssq);
                    }
                    MEMFENCE();
                }
            } else {
                u32x2 rb[4][2][2];
#pragma unroll
                for (int m = 0; m < 4; ++m)
#pragma unroll
                    for (int bj = 0; bj < 2; ++bj)
#pragma unroll
                        for (int n = 0; n < 2; ++n) rb[m][bj][n] = *(const GAS u32x2*)(xb + (size_t)(row0 + ai * 128 + m * 16) * DM + c0 + bj * 128 + n * 16);
#pragma unroll
                for (int m = 0; m < 4; ++m) {
                    const int row = row0 + ai * 128 + m * 16; float ssq = 0.f;
#pragma unroll
                    for (int bj = 0; bj < 2; ++bj)
#pragma unroll
                        for (int n = 0; n < 2; ++n) {
                            const u32x2 q = rb[m][bj][n];
                            const f32x4 v = (f32x4){bflo(q.x), bfhi(q.x), bflo(q.y), bfhi(q.y)} + acc[ai][bj][m][n] * scale;
                            u32x2 w; w.x = pkbf(v.x, v.y); w.y = pkbf(v.z, v.w); *(GAS u32x2*)(xb + (size_t)row * DM + c0 + bj * 128 + n * 16) = w;
                            ssq += (v.x * v.x + v.y * v.y) + (v.z * v.z + v.w * v.w);
                        }
                    ssq += SHX(ssq, 16); ssq += SHX(ssq, 32);
                    if (fq == 0) unsafeAtomicAdd((float*)(partw + row), ssq);
                }
                MEMFENCE();
            }
        }
    }
    DI void memkv(AccRef acc, const pg8::Unit& u, int wr, int wc, int fr, int fq) const {
        const int lane = fr | (fq << 4); (void)lane;
        const int row0 = u.pm * 256 + wr * 64 + fr, c0 = u.pn * 256 + wc * 32 + 8 * fq;
        const GAS float* part = (const GAS float*)(ws + WS_SSM); GAS bf16_t* xb = (GAS bf16_t*)(ws + WS_CKV);
        LOAD_RS8(rsv, part, row0);
#pragma unroll
        for (int ai = 0; ai < 2; ++ai)
#pragma unroll
            for (int m = 0; m < 4; ++m) {
                const int row = row0 + ai * 128 + m * 16; const float rs = rsv[ai][m];
#pragma unroll
                for (int bj = 0; bj < 2; ++bj) {
                    const f32x4 a = acc[ai][bj][m][0] * rs, b = acc[ai][bj][m][1] * rs;
                    u32x4 w; w.x = pkbf(a.x, a.y); w.y = pkbf(a.z, a.w); w.z = pkbf(b.x, b.y); w.w = pkbf(b.z, b.w);
                    *(GAS u32x4*)(xb + (size_t)row * 1024 + c0 + bj * 128) = w;
                }
            }
    }
    DI void hook(f32x4 (&acc)[2][2][4][2], const pg8::Unit& u, int seg, int wr, int wc, int fr, int fq) const {
        asm volatile("" : "+v"(fr), "+v"(fq));
        const int row0 = u.pm * 256 + wr * 64 + fr, c0 = u.pn * 256 + wc * 32 + 4 * fq;
        const GAS bf16_t* gts = (const GAS bf16_t*)(ws + WS_GTS) + seg * 1024 + (size_t)row0 * 3072 + c0; const GAS float* gbias = ((const GAS float*)kp->mix_gate_b) + seg * 1024 + c0;
#pragma unroll
        for (int bj = 0; bj < 2; ++bj)
#pragma unroll
            for (int n = 0; n < 2; ++n) {
                u32x2 w0[2][4], w1[2][4];
#pragma unroll
                for (int ai = 0; ai < 2; ++ai)
#pragma unroll
                    for (int m = 0; m < 4; ++m) {
                        const GAS bf16_t* gr = gts + (size_t)(ai * 128 + m * 16) * 3072 + bj * 128 + n * 16;
                        w0[ai][m] = *(const GAS u32x2*)gr; w1[ai][m] = *(const GAS u32x2*)(gr + 1024);
                    }
                const f32x4 b0 = *(const GAS f32x4*)(gbias + bj * 128 + n * 16), b1 = *(const GAS f32x4*)(gbias + 1024 + bj * 128 + n * 16);
#pragma unroll
                for (int ai = 0; ai < 2; ++ai)
#pragma unroll
                    for (int m = 0; m < 4; ++m) {
                        const u32x2 a0 = w0[ai][m], a1 = w1[ai][m];
                        f32x4 rt;
                        rt.x = (1.0f + __expf(-(bflo(a1.x) + b1.x))) * frcp(1.0f + __expf(-(bflo(a0.x) + b0.x)));
                        rt.y = (1.0f + __expf(-(bfhi(a1.x) + b1.y))) * frcp(1.0f + __expf(-(bfhi(a0.x) + b0.y)));
                        rt.z = (1.0f + __expf(-(bflo(a1.y) + b1.z))) * frcp(1.0f + __expf(-(bflo(a0.y) + b0.z)));
                        rt.w = (1.0f + __expf(-(bfhi(a1.y) + b1.w))) * frcp(1.0f + __expf(-(bfhi(a0.y) + b0.w)));
                        acc[ai][bj][m][n] = acc[ai][bj][m][n] * rt;
                    }
                MEMFENCE();
            }
    }
    DI void branch_final(AccRef acc, const pg8::Unit& u, int wr, int wc, int fr, int fq) const {
        const int lane = fr | (fq << 4); (void)lane;
        const int row0 = u.pm * 256 + wr * 64 + fr, c0 = u.pn * 256 + wc * 32 + 4 * fq;
        const GAS bf16_t* gts = (const GAS bf16_t*)(ws + WS_GTS) + 2048 + (size_t)row0 * 3072 + c0; const GAS float* gbias = ((const GAS float*)kp->mix_gate_b) + 2048 + c0;
        GAS bf16_t* mb16 = (GAS bf16_t*)((GAS unsigned char*)((GAS float*)kp->out) + 32 * MiB) + (size_t)(goff + row0) * DM + c0;
#pragma unroll
        for (int bj = 0; bj < 2; ++bj) {
            u32x2 gw[2][4][2];
#pragma unroll
            for (int ai = 0; ai < 2; ++ai)
#pragma unroll
                for (int m = 0; m < 4; ++m)
#pragma unroll
                    for (int n = 0; n < 2; ++n) gw[ai][m][n] = *(const GAS u32x2*)(gts + (size_t)(ai * 128 + m * 16) * 3072 + bj * 128 + n * 16);
#pragma unroll
            for (int n = 0; n < 2; ++n) {
                const f32x4 gb = *(const GAS f32x4*)(gbias + bj * 128 + n * 16);
#pragma unroll
                for (int ai = 0; ai < 2; ++ai)
#pragma unroll
                    for (int m = 0; m < 4; ++m) {
                        const u32x2 g2 = gw[ai][m][n];
                        f32x4 gv; gv.x = sigmoidf_(bflo(g2.x) + gb.x); gv.y = sigmoidf_(bfhi(g2.x) + gb.y); gv.z = sigmoidf_(bflo(g2.y) + gb.z); gv.w = sigmoidf_(bfhi(g2.y) + gb.w);
                        const f32x4 v = gv * acc[ai][bj][m][n];
                        u32x2 w; w.x = pkbf(v.x, v.y); w.y = pkbf(v.z, v.w); *(GAS u32x2*)(mb16 + (size_t)(ai * 128 + m * 16) * DM + bj * 128 + n * 16) = w;
                    }
            }
            MEMFENCE();
        }
    }
    DI void win(AccRef acc, const pg8::Unit& u, int wr, int wc, int fr, int fq) const {
        const int lane = fr | (fq << 4); (void)lane;
        const int row0 = u.pm * 256 + wr * 64 + fr; const int pn = u.pn + aux;
        const GAS float* part = (const GAS float*)(ws + WS_PART + SS_STRIDE) + goff;
        if (pn < 12) {
            const int isk = pn >= 6 ? 1 : 0; const int hh = 4 * (pn - 6 * isk) + wc; const int gi = hh >> 3, sh = 2 * gi;
            const GAS float* gain = isk ? ((const GAS float*)kp->att_k_gain) : ((const GAS float*)kp->att_q_gain); const float qs = isk ? 1.0f : 0.125f;
            GAS bf16_t* dst = (GAS bf16_t*)(ws + (isk ? WS_AK : WS_AQ));
            const GAS float* rc = (const GAS float*)(ws + WS_ROPE); const GAS float* rsn = rc + 2048 * 32;
#pragma unroll
            for (int ai = 0; ai < 2; ++ai)
#pragma unroll
                for (int m = 0; m < 4; ++m) {
                    const int row = row0 + ai * 128 + m * 16; const float rs = rstd_part(part, row);
                    const int bl = row >> 11, s = row & 2047;
                    float ss = 0.f;
#pragma unroll
                    for (int bj = 0; bj < 2; ++bj)
#pragma unroll
                        for (int n = 0; n < 2; ++n) { const f32x4 v = acc[ai][bj][m][n]; ss += (v.x * v.x + v.y * v.y) + (v.z * v.z + v.w * v.w); }
                    ss *= rs * rs;
                    ss += SHX(ss, 16); ss += SHX(ss, 32);
                    const float rh = rs * qs * frsq(ss * (1.0f / 64.0f) + EPS);
                    const int perm = ((s & ((1 << sh) - 1)) << (11 - sh)) + (s >> sh);
                    GAS bf16_t* d = dst + ((size_t)(bl * 24 + hh) * 2048 + perm) * 64 + 8 * fq;
                    u32x2 w1[2], w2[2];
#pragma unroll
                    for (int n = 0; n < 2; ++n) {
                        const f32x4 ga = *(const GAS f32x4*)(gain + 8 * fq + 4 * n), gb = *(const GAS f32x4*)(gain + 32 + 8 * fq + 4 * n);
                        const f32x4 c = *(const GAS f32x4*)(rc + s * 32 + 8 * fq + 4 * n), sn = *(const GAS f32x4*)(rsn + s * 32 + 8 * fq + 4 * n);
                        const f32x4 v1 = acc[ai][0][m][n] * ga * rh, v2 = acc[ai][1][m][n] * gb * rh;
                        const f32x4 o1 = v1 * c - v2 * sn, o2 = v2 * c + v1 * sn;
                        w1[n].x = pkbf(o1.x, o1.y); w1[n].y = pkbf(o1.z, o1.w);
                        w2[n].x = pkbf(o2.x, o2.y); w2[n].y = pkbf(o2.z, o2.w);
                    }
                    *(GAS u32x4*)d = (u32x4){w1[0].x, w1[0].y, w1[1].x, w1[1].y}; *(GAS u32x4*)(d + 32) = (u32x4){w2[0].x, w2[0].y, w2[1].x, w2[1].y};
                    MEMFENCE();
                }
        } else if (pn < 18) {
            LOAD_RS8(rsv, part, row0);
            GAS bf16_t* dst = (GAS bf16_t*)(ws + WS_AV);
#pragma unroll
            for (int bj = 0; bj < 2; ++bj) {
                const int hh = 4 * (pn - 12) + 2 * bj + (wc >> 1), d0 = 32 * (wc & 1) + 8 * fq; const int gi = hh >> 3, sh = 2 * gi;
#pragma unroll
                for (int ai = 0; ai < 2; ++ai)
#pragma unroll
                    for (int m = 0; m < 4; ++m) {
                        const int row = row0 + ai * 128 + m * 16; const float rs = rsv[ai][m];
                        const int bl = row >> 11, s = row & 2047;
                        const int perm = ((s & ((1 << sh) - 1)) << (11 - sh)) + (s >> sh);
                        const f32x4 a = acc[ai][bj][m][0] * rs, b = acc[ai][bj][m][1] * rs;
                        u32x4 w; w.x = pkbf(a.x, a.y); w.y = pkbf(a.z, a.w); w.z = pkbf(b.x, b.y); w.w = pkbf(b.z, b.w);
                        *(GAS u32x4*)(dst + ((size_t)(bl * 24 + hh) * 2048 + perm) * 64 + d0) = w;
                        if (m & 1) MEMFENCE();
                    }
            }
        } else if (pn < 40) {
            LOAD_RS8(rsv, part, row0);
            GAS bf16_t* dst; int ld, colt;
            if (pn < 28) { const int seg = (pn - 18) >> 1; dst = (GAS bf16_t*)(ws + WS_MQ) + (size_t)seg * TG * 512; ld = 512; colt = 256 * ((pn - 18) & 1); }
            else { dst = (GAS bf16_t*)(ws + WS_GTS); ld = 3072; colt = 256 * (pn - 28); }
            const int c0 = colt + wc * 32 + 8 * fq;
#pragma unroll
            for (int ai = 0; ai < 2; ++ai)
#pragma unroll
                for (int m = 0; m < 4; ++m) {
                    const int row = row0 + ai * 128 + m * 16; const float rs = rsv[ai][m];
#pragma unroll
                    for (int bj = 0; bj < 2; ++bj) {
                        const f32x4 a = acc[ai][bj][m][0] * rs, b = acc[ai][bj][m][1] * rs;
                        u32x4 w; w.x = pkbf(a.x, a.y); w.y = pkbf(a.z, a.w); w.z = pkbf(b.x, b.y); w.w = pkbf(b.z, b.w);
                        *(GAS u32x4*)(dst + (size_t)row * ld + c0 + bj * 128) = w;
                    }
                    if (m & 1) MEMFENCE();
                }
        } else {
            if (wc == 0 && fq < 2) {
                LOAD_RS8(rsv, part, row0);
                GAS float* dst = (GAS float*)(ws + (goff ? WS_MIF1 : WS_MIF));
#pragma unroll
                for (int ai = 0; ai < 2; ++ai)
#pragma unroll
                    for (int m = 0; m < 4; ++m) {
                        const int row = row0 + ai * 128 + m * 16; const float rs = rsv[ai][m];
                        *(GAS f32x4*)(dst + (size_t)row * 16 + 8 * fq) = acc[ai][0][m][0] * rs;
                        *(GAS f32x4*)(dst + (size_t)row * 16 + 8 * fq + 4) = acc[ai][0][m][1] * rs;
                    }
            }
        }
    }
    DI void operator()(AccRef acc, const pg8::Unit& u, int wr, int wc, int fr, int fq) const {
        asm volatile("" : "+v"(fr), "+v"(fq));
        switch (kind) {
#ifndef NO_E0
            case EK_SWIGLU: swiglu(acc, u, wr, wc, fr, fq); break;
#endif
#ifndef NO_E1
            case EK_RESID: residual(acc, u, wr, wc, fr, fq); break;
#endif
#ifndef NO_E2
            case EK_WIN: win(acc, u, wr, wc, fr, fq); break;
#endif
#ifndef NO_E3
            case EK_MEMKV: memkv(acc, u, wr, wc, fr, fq); break;
#endif
#ifndef NO_E4
            default: branch_final(acc, u, wr, wc, fr, fq); break;
#else
            default: break;
#endif
        }
    }
};

DI int colmap(int mk, int n) {
    if (mk == 0) return n;
    if (mk == 1) { const int pn = n >> 8, bj = (n >> 7) & 1, i0 = n & 127; return bj * DFF + 128 * pn + i0; }
    const int pn = n >> 8, within = n & 255, bj = within >> 7, wc = (within >> 5) & 3, i = within & 31;
    if (pn < 12) { const int seg = pn >= 6 ? 1 : 0; const int hh = 4 * (pn - 6 * seg) + wc; return seg * 1536 + 64 * hh + 32 * bj + i; }
    if (pn < 18) return 3072 + (n - 12 * 256);
    if (pn < 26) return 4608 + (n - 18 * 256);
    if (pn < 28) return 6672 + (n - 26 * 256);
    if (pn < 40) return 7184 + (n - 28 * 256);
    return n < 10256 ? 6656 + (n - 10240) : -1;
}
DI void tr_item64(const GAS float* __restrict__ W, int ldw, int mk, const GAS float* __restrict__ gain, GAS bf16_t* Bt, int K, int n0, int k0, LAS float* scr, int lane) {
    const int nl = (lane & 15) * 4, kr = lane >> 4;
    const int src = colmap(mk, n0 + nl);
    f32x4 v[16];
#pragma unroll
    for (int i = 0; i < 16; ++i) {
        const int k = k0 + kr + 4 * i; v[i] = (f32x4){0.f, 0.f, 0.f, 0.f};
        if (src >= 0) { v[i] = *(const GAS f32x4*)(W + (size_t)k * ldw + src); if (gain) v[i] = v[i] * gain[k]; }
    }
#pragma unroll
    for (int i = 0; i < 16; ++i) { LAS float* d = scr + (kr + 4 * i) * 65 + nl; d[0] = v[i].x; d[1] = v[i].y; d[2] = v[i].z; d[3] = v[i].w; }
    LDS_FENCE();
    const int c = lane & 7;
#pragma unroll
    for (int j = 0; j < 8; ++j) {
        const int n = (lane >> 3) + 8 * j; const LAS float* sp = scr + (8 * c) * 65 + n;
        u32x4 o; o.x = pkbf(sp[0 * 65], sp[1 * 65]); o.y = pkbf(sp[2 * 65], sp[3 * 65]); o.z = pkbf(sp[4 * 65], sp[5 * 65]); o.w = pkbf(sp[6 * 65], sp[7 * 65]);
        *(GAS u32x4*)(Bt + (size_t)(n0 + n) * K + k0 + 8 * c) = o;
    }
    LDS_FENCE();
}
DI void prepass(KPC P, LAS unsigned char* lds, int gw, int NGW, int wave, int lane, const int which) {
    LAS float* scr = (LAS float*)(lds + wave * 16640);
    GAS unsigned char* ws = ((GAS unsigned char*)P->ws);
    constexpr int I1 = 16 * 88, I2 = 44 * 16, I3 = 16 * 164, I4 = 16 * 16, I5 = 8 * 16, I6 = 16 * 16;
    constexpr int NIT = I1 + I2 + I3 + I4 + 3 * I5 + I6 + I1 + I2;
    constexpr int NIT0 = NIT - I1 - I2;
    for (int it = which ? NIT0 + gw : gw; it < (which ? NIT : NIT0); it += NGW) {
        int r = it;
        if (r < I1) { const int kb = r / 88, nb = r % 88; tr_item64(((const GAS float*)P->w_ffn1_in), 2 * DFF, 1, ((const GAS float*)P->norm_ffn1), (GAS bf16_t*)(ws + WS_W1), 1024, 64 * nb, 64 * kb, scr, lane); continue; } r -= I1;
        if (r < I2) { const int kb = r / 16, nb = r % 16; tr_item64(((const GAS float*)P->w_ffn1_out), 1024, 0, nullptr, (GAS bf16_t*)(ws + WS_W2), DFF, 64 * nb, 64 * kb, scr, lane); continue; } r -= I2;
        if (r < I3) { const int kb = r / 164, nb = r % 164; tr_item64(((const GAS float*)P->w_in), NIN, 2, ((const GAS float*)P->norm_mix), (GAS bf16_t*)(ws + WS_WIN), 1024, 64 * nb, 64 * kb, scr, lane); continue; } r -= I3;
        if (r < I4) { const int kb = r / 16, nb = r % 16; tr_item64(((const GAS float*)P->w_mem_kv), 1024, 0, ((const GAS float*)P->norm_mem), (GAS bf16_t*)(ws + WS_WMEM), 1024, 64 * nb, 64 * kb, scr, lane); continue; } r -= I4;
        if (r < 3 * I5) { const int b = r / I5, q = r % I5, kb = q / 16, nb = q % 16; const GAS float* w = b == 0 ? ((const GAS float*)P->w_br_att) : (b == 1 ? ((const GAS float*)P->w_br_ml) : ((const GAS float*)P->w_br_cx));
            tr_item64(w, 1024, 0, nullptr, (GAS bf16_t*)(ws + WS_WBR) + (size_t)b * 512, 1536, 64 * nb, 64 * kb, scr, lane); continue; } r -= 3 * I5;
        if (r < I6) { const int kb = r / 16, nb = r % 16; tr_item64(((const GAS float*)P->w_out), 1024, 0, nullptr, (GAS bf16_t*)(ws + WS_WOUT), 1024, 64 * nb, 64 * kb, scr, lane); continue; } r -= I6;
        if (r < I1) { const int kb = r / 88, nb = r % 88; tr_item64(((const GAS float*)P->w_ffn2_in), 2 * DFF, 1, ((const GAS float*)P->norm_ffn2), (GAS bf16_t*)(ws + WS_W3), 1024, 64 * nb, 64 * kb, scr, lane); continue; } r -= I1;
        { const int kb = r / 16, nb = r % 16; tr_item64(((const GAS float*)P->w_ffn2_out), 1024, 0, nullptr, (GAS bf16_t*)(ws + WS_W4), DFF, 64 * nb, 64 * kb, scr, lane); }
    }
    if (which) return;
    GAS bf16_t* xb = (GAS bf16_t*)(ws + WS_XB); GAS float* part = (GAS float*)(ws + WS_PART);
    GAS bf16_t* memb = (GAS bf16_t*)(ws + WS_MEMB); GAS float* ssm = (GAS float*)(ws + WS_SSM);
    for (int m4 = gw; m4 < (T_ + MEMROWS) / 4; m4 += NGW) {
        const bool isx = m4 < T_ / 4; const int row0 = isx ? 4 * m4 : 4 * m4 - T_;
        const GAS f32x4* xr = (const GAS f32x4*)((isx ? ((const GAS float*)P->x) : ((const GAS float*)P->mem)) + (size_t)row0 * DM) + lane;
        GAS unsigned long long* o8 = (GAS unsigned long long*)((isx ? xb : memb) + (size_t)row0 * DM) + lane;
        f32x4 v[4][4];
#pragma unroll
        for (int rr = 0; rr < 4; ++rr)
#pragma unroll
            for (int j = 0; j < 4; ++j) v[rr][j] = xr[rr * 256 + 64 * j];
#pragma unroll
        for (int rr = 0; rr < 4; ++rr) {
            float sq = 0.f;
#pragma unroll
            for (int j = 0; j < 4; ++j) { const f32x4 t = v[rr][j]; sq += (t.x * t.x + t.y * t.y) + (t.z * t.z + t.w * t.w);
                o8[rr * 256 + 64 * j] = (unsigned long long)pkbf(t.x, t.y) | ((unsigned long long)pkbf(t.z, t.w) << 32); }
            sq = wave_sum(sq);
            const int row = row0 + rr;
            if (isx) { if (lane < 4) part[(size_t)lane * (SS_STRIDE / 4) + row] = lane == 0 ? sq : 0.f; }
            else if (lane == 0) ssm[row] = sq;
        }
    }
    GAS float* rc = (GAS float*)(ws + WS_ROPE); GAS float* rsn = rc + 2048 * 32;
    for (int i = gw * 64 + lane; i < 2048 * 32; i += NGW * 64) {
        const int sq = i >> 5, d = i & 31; const float inv = powf(10000.0f, -(float)(2 * d) / 64.0f); const float ang = (float)sq * inv;
        rc[i] = cosf(ang); rsn[i] = sinf(ang);
    }
}

DI void cknorm(KPC P, int gw, int NGW, int lane) {
    GAS bf16_t* ckv = (GAS bf16_t*)(((GAS unsigned char*)P->ws) + WS_CKV);
    for (int it = gw; it < MEMROWS * 4; it += NGW) {
        const int row = it >> 2, hd = it & 3; GAS unsigned* p = (GAS unsigned*)(ckv + (size_t)row * 1024 + hd * 128) + lane;
        const unsigned w = *p; const float a = bflo(w), b = bfhi(w);
        const float ss = wave_sum(a * a + b * b); const float rs = frsq(ss * (1.0f / 128.0f) + EPS);
        *p = pkbf(a * rs * ((const GAS float*)P->cx_k_gain)[2 * lane], b * rs * ((const GAS float*)P->cx_k_gain)[2 * lane + 1]);
    }
}

template <int D, int NKB, bool BAND>
DI void attn_pass(const GAS bf16_t* Kb, const GAS bf16_t* Vb, long pitch, unsigned vmask, const bf16x8 (&qf)[D / 16],
                  float& m, float& l, f32x16 (&o)[D / 32], LAS unsigned char* vs, int lane) {
    const int r = lane & 31, h = lane >> 5;
    f32x16 st[NKB];
#pragma unroll
    for (int kb = 0; kb < NKB; ++kb) {
        if (vmask & (1u << kb)) {
            const GAS bf16_t* kr = Kb + (long)(32 * kb + r) * pitch + 8 * h;
            f32x16 a = zero16();
#pragma unroll
            for (int ks = 0; ks < D / 16; ++ks) a = mfma32(*(const GAS bf16x8*)(kr + 16 * ks), qf[ks], a);
            st[kb] = a;
            MEMFENCE();
        } else {
#pragma unroll
            for (int i = 0; i < 16; ++i) st[kb][i] = NEGF;
        }
    }
    if (BAND) {
#pragma unroll
        for (int i = 0; i < 16; ++i) { const int jj = crow(i, h); if (jj < r) st[0][i] = NEGF; if (jj > r) st[NKB - 1][i] = NEGF; }
    }
    float bm = NEGF;
#pragma unroll
    for (int kb = 0; kb < NKB; ++kb)
#pragma unroll
        for (int i = 0; i < 16; ++i) bm = fmaxf(bm, st[kb][i]);
    bm = fmaxf(bm, SHX(bm, 32));
    const float mn = fmaxf(m, bm); const float alpha = __expf(m - mn);
    float ls = 0.f;
#pragma unroll
    for (int kb = 0; kb < NKB; ++kb)
#pragma unroll
        for (int i = 0; i < 16; ++i) { const float p = __expf(st[kb][i] - mn); st[kb][i] = p; ls += p; }
    ls += SHX(ls, 32);
    l = l * alpha + ls; m = mn;
#pragma unroll
    for (int d0 = 0; d0 < D / 32; ++d0)
#pragma unroll
        for (int i = 0; i < 16; ++i) o[d0][i] *= alpha;
    const int q4 = (lane & 15) >> 2, p4 = lane & 3, blk = (lane >> 4) & 1;
    LAS unsigned char* vrd = vs + q4 * (2 * D) + 32 * blk + 8 * p4;
#pragma unroll
    for (int kb = 0; kb < NKB; ++kb) {
        if (vmask & (1u << kb)) {
            constexpr int CPR = D / 8;
#pragma unroll
            for (int t = 0; t < (32 * CPR) / 64; ++t) {
                const int ci = lane + 64 * t, row = ci / CPR, ch = ci % CPR;
                const u32x4 v = *(const GAS u32x4*)(Vb + (long)(32 * kb + row) * pitch + 8 * ch);
                *(LAS u32x4*)(vs + row * (2 * D) + ch * 16) = v;
                if ((t & 3) == 3) MEMFENCE();
            }
            LDS_FENCE();
#pragma unroll
            for (int ks2 = 0; ks2 < 2; ++ks2) {
                const bf16x8 pb = pack8(st[kb], ks2);
#pragma unroll
                for (int d0 = 0; d0 < D / 32; ++d0) {
                    const s16x4 lo = trread(vrd + (16 * ks2 + 4 * h) * (2 * D) + 64 * d0);
                    const s16x4 hi = trread(vrd + (16 * ks2 + 8 + 4 * h) * (2 * D) + 64 * d0);
                    o[d0] = mfma32(cat44(lo, hi), pb, o[d0]);
                }
            }
            LDS_FENCE();
        }
    }
}

DI void att_unit(GAS unsigned char* ws, int u, LAS unsigned char* vs, int lane, bool dry) {
    const int r = lane & 31, h = lane >> 5;
    const int qblk = u & 63, hb = u >> 6, head = hb % 24, bl = hb / 24;
    const int gi = head >> 3, slot = head & 7, sh = 2 * gi, n = 2048 >> sh;
    const int prow = 32 * qblk, c = prow >> (11 - sh), i0 = prow & (n - 1);
    const size_t hbase = (size_t)(bl * 24 + head) * 2048 * 64;
    GAS bf16_t* Q = (GAS bf16_t*)(ws + WS_AQ) + hbase; const GAS bf16_t* K = (const GAS bf16_t*)(ws + WS_AK) + hbase; const GAS bf16_t* V = (const GAS bf16_t*)(ws + WS_AV) + hbase;
    bf16x8 qf[4];
#pragma unroll
    for (int ks = 0; ks < 4; ++ks) qf[ks] = *(const GAS bf16x8*)(Q + (size_t)(prow + r) * 64 + 16 * ks + 8 * h);
    unsigned vmask = 0;
#pragma unroll
    for (int kb = 0; kb < 5; ++kb) { const int j0 = i0 - 64 + 32 * kb; if (j0 >= 0 && j0 < n) vmask |= 1u << kb; }
    vmask = __builtin_amdgcn_readfirstlane(vmask);
    float m = NEGF, l = 0.f; f32x16 o[2]; o[0] = zero16(); o[1] = zero16();
    attn_pass<64, 5, true>(K + (long)(prow - 64) * 64, V + (long)(prow - 64) * 64, 64, vmask, qf, m, l, o, vs, lane);
    if (dry) return;
    const float inv = frcp(l);
    GAS bf16_t* orow = Q + (size_t)(prow + r) * 64;
#pragma unroll
    for (int d0 = 0; d0 < 2; ++d0)
#pragma unroll
        for (int g4 = 0; g4 < 4; ++g4) {
            u32x2 w; w.x = pkbf(o[d0][4 * g4] * inv, o[d0][4 * g4 + 1] * inv); w.y = pkbf(o[d0][4 * g4 + 2] * inv, o[d0][4 * g4 + 3] * inv);
            *(GAS u32x2*)(orow + 32 * d0 + 8 * g4 + 4 * h) = w;
        }
    if (h == 0) {
        const int s = c + ((i0 + r) << sh);
        GAS float* lse = (GAS float*)(ws + WS_LSE);
        lse[((size_t)gi * TG + (size_t)bl * 2048 + s) * 8 + slot] = m + __logf(l);
    }
}

DI void cross_unit(KPC P, int grp, int u, LAS unsigned char* vs, int lane, bool dry) {
    const int r = lane & 31, h = lane >> 5;
    const int qblk = u & 63, head = (u >> 6) & 3, bl = u >> 8;
    GAS bf16_t* qrow = (GAS bf16_t*)(((GAS unsigned char*)P->ws) + WS_CQ) + ((size_t)bl * 2048 + 32 * qblk + r) * 512 + head * 128;
    bf16x8 qf[8]; float ss = 0.f;
#pragma unroll
    for (int ks = 0; ks < 8; ++ks) { qf[ks] = *(const GAS bf16x8*)(qrow + 16 * ks + 8 * h);
        const u32x4 w = __builtin_bit_cast(u32x4, qf[ks]);
        ss += (bflo(w.x) * bflo(w.x) + bfhi(w.x) * bfhi(w.x)) + (bflo(w.y) * bflo(w.y) + bfhi(w.y) * bfhi(w.y)) + (bflo(w.z) * bflo(w.z) + bfhi(w.z) * bfhi(w.z)) + (bflo(w.w) * bflo(w.w) + bfhi(w.w) * bfhi(w.w)); }
    ss += SHX(ss, 32);
    const float rq = (frsq(ss * (1.0f / 128.0f) + EPS)) * 0.08838834764831845f;
#pragma unroll
    for (int ks = 0; ks < 8; ++ks) {
        const u32x4 w = __builtin_bit_cast(u32x4, qf[ks]); const GAS float* g = ((const GAS float*)P->cx_q_gain) + 16 * ks + 8 * h;
        const f32x4 ga = *(const GAS f32x4*)g, gb = *(const GAS f32x4*)(g + 4);
        u32x4 o; o.x = pkbf(bflo(w.x) * rq * ga.x, bfhi(w.x) * rq * ga.y); o.y = pkbf(bflo(w.y) * rq * ga.z, bfhi(w.y) * rq * ga.w);
        o.z = pkbf(bflo(w.z) * rq * gb.x, bfhi(w.z) * rq * gb.y); o.w = pkbf(bflo(w.w) * rq * gb.z, bfhi(w.w) * rq * gb.w);
        qf[ks] = __builtin_bit_cast(bf16x8, o);
    }
    const GAS bf16_t* K = (const GAS bf16_t*)(((GAS unsigned char*)P->ws) + WS_CKV) + (size_t)(grp * BL + bl) * 256 * 1024 + head * 128;
    const GAS bf16_t* V = K + 512;
    float m = NEGF, l = 0.f; f32x16 o[4];
#pragma unroll
    for (int d0 = 0; d0 < 4; ++d0) o[d0] = zero16();
#pragma unroll 1
    for (int ps = 0; ps < 4; ++ps) attn_pass<128, 2, false>(K + (size_t)ps * 64 * 1024, V + (size_t)ps * 64 * 1024, 1024, 0x3u, qf, m, l, o, vs, lane);
    if (dry) return;
    const float inv = frcp(l);
#pragma unroll
    for (int d0 = 0; d0 < 4; ++d0)
#pragma unroll
        for (int g4 = 0; g4 < 4; ++g4) {
            u32x2 w; w.x = pkbf(o[d0][4 * g4] * inv, o[d0][4 * g4 + 1] * inv); w.y = pkbf(o[d0][4 * g4 + 2] * inv, o[d0][4 * g4 + 3] * inv);
            *(GAS u32x2*)(qrow + 32 * d0 + 8 * g4 + 4 * h) = w;
        }
}

DI float scan_add(float v, int lane) {
#pragma unroll
    for (int d = 1; d < 64; d <<= 1) { const float t = shup(v, d, lane); if (lane >= d) v += t; }
    return v;
}
DI float scan_max(float v, int lane) {
#pragma unroll
    for (int d = 1; d < 64; d <<= 1) { const float t = shup(v, d, lane); if (lane >= d) v = fmaxf(v, t); }
    return v;
}
DI float log_sigmoid(float x) { return x >= 0.f ? -log1pf(__expf(-x)) : x - log1pf(__expf(x)); }

template <int D, int NKB, bool BAND>
DI void attn_pass_lds(LAS unsigned char* Kimg, LAS unsigned char* Vimg, unsigned vmask, const bf16x8 (&qf)[D / 16],
                      float& m, float& l, f32x16 (&o)[D / 32], int lane) {
    constexpr int PB = 2 * D + 16;
    constexpr int PBV = (D == 64) ? 192 : 320;
    const int r = lane & 31, h = lane >> 5;
    f32x16 st[NKB];
#pragma unroll
    for (int kb = 0; kb < NKB; ++kb) {
        if (vmask & (1u << kb)) {
            LAS unsigned char* kr = Kimg + (32 * kb + r) * PB + 16 * h;
            f32x16 a = zero16();
#pragma unroll
            for (int ks = 0; ks < D / 16; ++ks) a = mfma32(*(const LAS bf16x8*)(kr + 32 * ks), qf[ks], a);
            st[kb] = a;
        } else {
#pragma unroll
            for (int i = 0; i < 16; ++i) st[kb][i] = NEGF;
        }
    }
    if (BAND) {
#pragma unroll
        for (int i = 0; i < 16; ++i) { const int jj = crow(i, h); if (jj < r) st[0][i] = NEGF; if (jj > r) st[NKB - 1][i] = NEGF; }
    }
    float bm = NEGF;
#pragma unroll
    for (int kb = 0; kb < NKB; ++kb)
#pragma unroll
        for (int i = 0; i < 16; ++i) bm = fmaxf(bm, st[kb][i]);
    bm = fmaxf(bm, SHX(bm, 32));
    const float mn = fmaxf(m, bm); const float alpha = __expf(m - mn);
    float ls = 0.f;
#pragma unroll
    for (int kb = 0; kb < NKB; ++kb)
#pragma unroll
        for (int i = 0; i < 16; ++i) { const float p = __expf(st[kb][i] - mn); st[kb][i] = p; ls += p; }
    ls += SHX(ls, 32);
    l = l * alpha + ls; m = mn;
#pragma unroll
    for (int d0 = 0; d0 < D / 32; ++d0)
#pragma unroll
        for (int i = 0; i < 16; ++i) o[d0][i] *= alpha;
    LAS unsigned char* vrd = Vimg + ((lane & 15) >> 2) * PBV + 32 * ((lane >> 4) & 1) + 8 * (lane & 3);
#pragma unroll
    for (int kb = 0; kb < NKB; ++kb) {
        if (vmask & (1u << kb)) {
#pragma unroll
            for (int ks2 = 0; ks2 < 2; ++ks2) {
                const bf16x8 pb = pack8(st[kb], ks2);
#pragma unroll
                for (int d0 = 0; d0 < D / 32; ++d0) {
                    const s16x4 lo = trread(vrd + (32 * kb + 16 * ks2 + 4 * h) * PBV + 64 * d0);
                    const s16x4 hi = trread(vrd + (32 * kb + 16 * ks2 + 8 + 4 * h) * PBV + 64 * d0);
                    o[d0] = mfma32(cat44(lo, hi), pb, o[d0]);
                }
            }
        }
    }
}

DI void att_wg_loop(GAS unsigned char* ws, LAS unsigned char* lds, int ubeg, int ustep, int uend, const int tid0) {
    int tid = tid0; asm volatile("" : "+v"(tid));
    const int lane = tid & 63, wave = __builtin_amdgcn_readfirstlane(tid0 >> 6), r = lane & 31, h = lane >> 5;
    constexpr int PB = 144, PBV = 192;
    LAS unsigned char* Kimg = lds; LAS unsigned char* Vimg = lds + 384 * PB;
    u32x4 kreg[6], vreg[6];
    auto issue = [&](int u) {
        const int ublk = u & 7, hb = u >> 3, head = hb % 24, bl = hb / 24;
        const size_t hbase = (size_t)(bl * 24 + head) * 2048 * 64;
        const GAS bf16_t* K = (const GAS bf16_t*)(ws + WS_AK) + hbase; const GAS bf16_t* V = (const GAS bf16_t*)(ws + WS_AV) + hbase;
        const int w0 = 256 * ublk - 64;
#pragma unroll
        for (int i = 0; i < 6; ++i) {
            const int ix = tid + 512 * i, row = ix >> 3, ch = ix & 7; const int grow = w0 + row;
            kreg[i] = (u32x4){0u, 0u, 0u, 0u}; vreg[i] = (u32x4){0u, 0u, 0u, 0u};
            if (grow >= 0 && grow < 2048) { kreg[i] = *(const GAS u32x4*)(K + (size_t)grow * 64 + 8 * ch); vreg[i] = *(const GAS u32x4*)(V + (size_t)grow * 64 + 8 * ch); }
        }
    };
    if (ubeg < uend) issue(ubeg);
#pragma unroll 1
    for (int u = ubeg; u < uend; u += ustep) {
#pragma unroll
        for (int i = 0; i < 6; ++i) { const int ix = tid + 512 * i, row = ix >> 3, ch = ix & 7;
            *(LAS u32x4*)(Kimg + row * PB + ch * 16) = kreg[i]; *(LAS u32x4*)(Vimg + row * PBV + ch * 16) = vreg[i]; }
        const int ublk = u & 7, hb = u >> 3, head = hb % 24, bl = hb / 24;
        const int gi = head >> 3, slot = head & 7, sh = 2 * gi, n = 2048 >> sh;
        GAS bf16_t* Q = (GAS bf16_t*)(ws + WS_AQ) + (size_t)(bl * 24 + head) * 2048 * 64;
        const int prow = 256 * ublk + 32 * wave, c = prow >> (11 - sh), i0 = prow & (n - 1);
        bf16x8 qf[4];
#pragma unroll
        for (int ks = 0; ks < 4; ++ks) qf[ks] = *(const GAS bf16x8*)(Q + (size_t)(prow + r) * 64 + 16 * ks + 8 * h);
        unsigned vmask = 0;
#pragma unroll
        for (int kb = 0; kb < 5; ++kb) { const int j0 = i0 - 64 + 32 * kb; if (j0 >= 0 && j0 < n) vmask |= 1u << kb; }
        vmask = __builtin_amdgcn_readfirstlane(vmask);
        __syncthreads();
        if (u + ustep < uend) issue(u + ustep);
        float m = NEGF, l = 0.f; f32x16 o[2]; o[0] = zero16(); o[1] = zero16();
        attn_pass_lds<64, 5, true>(Kimg + 32 * wave * PB, Vimg + 32 * wave * PBV, vmask, qf, m, l, o, lane);
        const float inv = frcp(l);
        GAS bf16_t* orow = Q + (size_t)(prow + r) * 64;
#pragma unroll
        for (int d0 = 0; d0 < 2; ++d0)
#pragma unroll
            for (int g4 = 0; g4 < 4; ++g4) {
                u32x2 w; w.x = pkbf(o[d0][4 * g4] * inv, o[d0][4 * g4 + 1] * inv); w.y = pkbf(o[d0][4 * g4 + 2] * inv, o[d0][4 * g4 + 3] * inv);
                *(GAS u32x2*)(orow + 32 * d0 + 8 * g4 + 4 * h) = w;
            }
        if (h == 0) {
            const int sq = c + ((i0 + r) << sh);
            GAS float* lse = (GAS float*)(ws + WS_LSE);
            lse[((size_t)gi * TG + (size_t)bl * 2048 + sq) * 8 + slot] = m + __logf(l);
        }
        __syncthreads();
    }
}

DI void cross_wg_unit(KPC P, LAS unsigned char* lds, int grp, int u, const int tid0) {
    int tid = tid0; asm volatile("" : "+v"(tid));
    const int lane = tid & 63, wave = __builtin_amdgcn_readfirstlane(tid0 >> 6), r = lane & 31, h = lane >> 5;
    constexpr int PB = 272, PBV = 320;
    GAS unsigned char* ws = ((GAS unsigned char*)P->ws); asm volatile("" : "+s"(ws));
    const int qq = u & 7, head = (u >> 3) & 3, bl = u >> 5;
    const GAS bf16_t* K = (const GAS bf16_t*)(ws + WS_CKV) + (size_t)(grp * BL + bl) * 256 * 1024 + head * 128;
    const GAS bf16_t* V = K + 512;
    LAS unsigned char* Kimg = lds; LAS unsigned char* Vimg = lds + 256 * PB;
#pragma unroll
    for (int i = 0; i < 8; ++i) {
        const int ix = tid + 512 * i, row = ix >> 4, ch = ix & 15;
        *(LAS u32x4*)(Kimg + row * PB + ch * 16) = *(const GAS u32x4*)(K + (size_t)row * 1024 + 8 * ch);
        *(LAS u32x4*)(Vimg + row * PBV + ch * 16) = *(const GAS u32x4*)(V + (size_t)row * 1024 + 8 * ch);
    }
    GAS bf16_t* qrow = (GAS bf16_t*)(ws + WS_CQ) + ((size_t)bl * 2048 + 256 * qq + 32 * wave + r) * 512 + head * 128;
    bf16x8 qf[8]; float ss = 0.f;
#pragma unroll
    for (int ks = 0; ks < 8; ++ks) { qf[ks] = *(const GAS bf16x8*)(qrow + 16 * ks + 8 * h);
        const u32x4 w = __builtin_bit_cast(u32x4, qf[ks]);
        ss += (bflo(w.x) * bflo(w.x) + bfhi(w.x) * bfhi(w.x)) + (bflo(w.y) * bflo(w.y) + bfhi(w.y) * bfhi(w.y)) + (bflo(w.z) * bflo(w.z) + bfhi(w.z) * bfhi(w.z)) + (bflo(w.w) * bflo(w.w) + bfhi(w.w) * bfhi(w.w)); }
    ss += SHX(ss, 32);
    const float rq = (frsq(ss * (1.0f / 128.0f) + EPS)) * 0.08838834764831845f;
#pragma unroll
    for (int ks = 0; ks < 8; ++ks) {
        const u32x4 w = __builtin_bit_cast(u32x4, qf[ks]); const GAS float* g = ((const GAS float*)P->cx_q_gain) + 16 * ks + 8 * h;
        const f32x4 ga = *(const GAS f32x4*)g, gb = *(const GAS f32x4*)(g + 4);
        u32x4 o; o.x = pkbf(bflo(w.x) * rq * ga.x, bfhi(w.x) * rq * ga.y); o.y = pkbf(bflo(w.y) * rq * ga.z, bfhi(w.y) * rq * ga.w);
        o.z = pkbf(bflo(w.z) * rq * gb.x, bfhi(w.z) * rq * gb.y); o.w = pkbf(bflo(w.w) * rq * gb.z, bfhi(w.w) * rq * gb.w);
        qf[ks] = __builtin_bit_cast(bf16x8, o);
    }
    __syncthreads();
    float m = NEGF, l = 0.f; f32x16 o[4];
#pragma unroll
    for (int d0 = 0; d0 < 4; ++d0) o[d0] = zero16();
#pragma unroll 1
    for (int ps = 0; ps < 4; ++ps) attn_pass_lds<128, 2, false>(Kimg + ps * 64 * PB, Vimg + ps * 64 * PBV, 0x3u, qf, m, l, o, lane);
    const float inv = frcp(l);
    GAS bf16_t* orow = (GAS bf16_t*)(ws + WS_YATT) + ((size_t)bl * 2048 + 256 * qq + 32 * wave + r) * 1536 + 1024 + head * 128;
#pragma unroll
    for (int d0 = 0; d0 < 4; ++d0)
#pragma unroll
        for (int g4 = 0; g4 < 4; ++g4) {
            u32x2 w; w.x = pkbf(o[d0][4 * g4] * inv, o[d0][4 * g4 + 1] * inv); w.y = pkbf(o[d0][4 * g4 + 2] * inv, o[d0][4 * g4 + 3] * inv);
            *(GAS u32x2*)(orow + 32 * d0 + 8 * g4 + 4 * h) = w;
        }
    __syncthreads();
}

#ifndef REP_ML
#define REP_ML 1
#endif
constexpr size_t WS_DN = 493 * MiB;
constexpr size_t WS_SCL = 493 * MiB + 512 * 1024;
#define CHAIN_LANES() asm volatile("" : "+v"(tid)); const int lane = tid & 63, r = lane & 31, h = lane >> 5; const int trofs = ((lane & 15) >> 2) * MLP + 32 * ((lane >> 4) & 1) + 8 * (lane & 3); (void)r; (void)h; (void)trofs

DI void ml_conv_item(KPC P, const GAS bf16_t* srcbase, LAS unsigned char* img, int sel, int cg8, int seg, int ci, int dir, size_t rowb, int head) {
    const int tl0 = 128 * ci + 8 * seg;
    const int pmin = dir ? 2047 - (tl0 + 7) : tl0;
    const GAS bf16_t* src = srcbase + head * 128 + 8 * cg8;
    u32x4 raw[12];
#pragma unroll
    for (int i = 0; i < 12; ++i) { const int pp = pmin - 2 + i; raw[i] = (u32x4){0u, 0u, 0u, 0u}; if (pp >= 0 && pp < 2048) raw[i] = *(const GAS u32x4*)(src + (rowb + pp) * 512); }
    const int ch = sel * 512 + head * 128 + 8 * cg8;
    f32x4 wv[5][2];
#pragma unroll
    for (int j = 0; j < 5; ++j) { wv[j][0] = *(const GAS f32x4*)(((const GAS float*)P->ml_conv_w) + j * 1024 + ch); wv[j][1] = *(const GAS f32x4*)(((const GAS float*)P->ml_conv_w) + j * 1024 + ch + 4); }
    const f32x4 b0 = *(const GAS f32x4*)(((const GAS float*)P->ml_conv_b) + ch), b1 = *(const GAS f32x4*)(((const GAS float*)P->ml_conv_b) + ch + 4);
    const float osc = sel ? 1.0f : 0.08838834764831845f;
    LAS unsigned char* dstb = img + cg8 * 16;
#pragma unroll
    for (int i = 0; i < 8; ++i) {
        f32x4 a0 = b0, a1 = b1;
#pragma unroll
        for (int j = 0; j < 5; ++j) {
            const u32x4 w = raw[i + j];
            a0 += wv[j][0] * (f32x4){bflo(w.x), bfhi(w.x), bflo(w.y), bfhi(w.y)};
            a1 += wv[j][1] * (f32x4){bflo(w.z), bfhi(w.z), bflo(w.w), bfhi(w.w)};
        }
        u32x4 o;
        o.x = pkbf(a0.x * sigmoidf_(a0.x) * osc, a0.y * sigmoidf_(a0.y) * osc); o.y = pkbf(a0.z * sigmoidf_(a0.z) * osc, a0.w * sigmoidf_(a0.w) * osc);
        o.z = pkbf(a1.x * sigmoidf_(a1.x) * osc, a1.y * sigmoidf_(a1.y) * osc); o.w = pkbf(a1.z * sigmoidf_(a1.z) * osc, a1.w * sigmoidf_(a1.w) * osc);
        const int tl = dir ? (8 * seg + 7 - i) : (8 * seg + i);
        *(LAS u32x4*)(dstb + tl * MLP) = o;
    }
}

DI void mlstm_p1(KPC P, LAS unsigned char* lds, int grp, int chain, int ci, const int tid0) {
    int tid = tid0; const int wave = __builtin_amdgcn_readfirstlane(tid0 >> 6);
    const int bl = chain >> 3, head = (chain >> 1) & 3, dir = chain & 1;
    GAS unsigned char* ws = ((GAS unsigned char*)P->ws); asm volatile("" : "+s"(ws));
    LAS unsigned char* KI = lds + 128 * MLP; LAS unsigned char* VI = lds + 2 * 128 * MLP; LAS unsigned char* CI = lds + 3 * 128 * MLP;
    LAS float* twk = (LAS float*)(lds + TB_OFF) + 384;
    const size_t rowb = (size_t)bl * 2048;
    {
        CHAIN_LANES();
        if (tid < 256) {
            ml_conv_item(P, (const GAS bf16_t*)(ws + WS_MK), KI, 1, tid & 15, (tid >> 4) & 15, ci, dir, rowb, head);
        } else {
            const int t2 = tid - 256; const int t = t2 >> 1, c0 = (t2 & 1) * 64; const int tau = 128 * ci + t; const int p = dir ? 2047 - tau : tau;
            const GAS bf16_t* vsrc = (const GAS bf16_t*)(ws + WS_MV) + (rowb + p) * 512 + head * 128 + c0;
#pragma unroll
            for (int sub = 0; sub < 8; ++sub) *(LAS u32x4*)(VI + t * MLP + c0 * 2 + sub * 16) = *(const GAS u32x4*)(vsrc + 8 * sub);
            if (wave == 7) {
                const GAS float* MIF = (const GAS float*)(ws + WS_MIF);
                const float bli = ((const GAS float*)P->ml_gate_b)[(dir ? 8 : 0) + head], blf = ((const GAS float*)P->ml_gate_b)[(dir ? 12 : 4) + head];
                const int tau1 = 128 * ci + lane, tau2 = tau1 + 64; const int p1 = dir ? 2047 - tau1 : tau1, p2 = dir ? 2047 - tau2 : tau2;
                const GAS float* r1 = MIF + (rowb + p1) * 16 + head; const GAS float* r2 = MIF + (rowb + p2) * 16 + head;
                const float li1 = r1[dir ? 8 : 0] + bli, li2 = r2[dir ? 8 : 0] + bli;
                const float lf1 = log_sigmoid(r1[dir ? 12 : 4] + blf), lf2 = log_sigmoid(r2[dir ? 12 : 4] + blf);
                const float c1 = scan_add(lf1, lane); const float tot1 = rdlane(c1, 63); const float c2 = scan_add(lf2, lane) + tot1;
                const float g1 = li1 - c1, g2 = li2 - c2;
                float gm = fmaxf(g1, g2);
#pragma unroll
                for (int o = 1; o < 64; o <<= 1) gm = fmaxf(gm, SHX(gm, o));
                const float gtot = rdlane(c2, 63);
                twk[lane] = __expf(g1 - gm); twk[64 + lane] = __expf(g2 - gm);
                if (lane == 0) { GAS float* scl = (GAS float*)(ws + WS_SCL) + ((size_t)chain * 16 + ci) * 4; scl[0] = gtot; scl[1] = gm; }
            }
        }
    }
    __syncthreads();
    {
        CHAIN_LANES();
        const int s = tid >> 2, c0 = (tid & 3) * 32; const float wks = twk[s];
#pragma unroll
        for (int sub = 0; sub < 4; ++sub) {
            LAS u32x4* pp = (LAS u32x4*)(KI + s * MLP + c0 * 2 + sub * 16); const u32x4 w = *pp;
            u32x4 o; o.x = pkbf(bflo(w.x) * wks, bfhi(w.x) * wks); o.y = pkbf(bflo(w.y) * wks, bfhi(w.y) * wks); o.z = pkbf(bflo(w.z) * wks, bfhi(w.z) * wks); o.w = pkbf(bflo(w.w) * wks, bfhi(w.w) * wks);
            *pp = o;
        }
    }
    __syncthreads();
    {
        CHAIN_LANES();
        const int vb = wave >> 1, kh = wave & 1;
        f32x16 cacc[2], ntmp[2]; cacc[0] = zero16(); cacc[1] = zero16(); ntmp[0] = zero16(); ntmp[1] = zero16();
        const bf16x8 ones = (bf16x8){0x3F80, 0x3F80, 0x3F80, 0x3F80, 0x3F80, 0x3F80, 0x3F80, 0x3F80};
#pragma unroll
        for (int ks = 0; ks < 8; ++ks) {
            LAS unsigned char* vp = VI + trofs + (16 * ks + 8 * h) * MLP + 64 * vb;
            const bf16x8 af = cat44(trread(vp), trread(vp + 4 * MLP));
#pragma unroll
            for (int jk = 0; jk < 2; ++jk) {
                LAS unsigned char* kp = KI + trofs + (16 * ks + 8 * h) * MLP + 64 * (2 * kh + jk);
                const bf16x8 bfr = cat44(trread(kp), trread(kp + 4 * MLP));
                cacc[jk] = mfma32(af, bfr, cacc[jk]);
                if (vb == 0) ntmp[jk] = mfma32(ones, bfr, ntmp[jk]);
            }
        }
#pragma unroll
        for (int jk = 0; jk < 2; ++jk) {
            const int kcol = 32 * (2 * kh + jk) + r;
#pragma unroll
            for (int i = 0; i < 16; i += 1) {
                const unsigned short v = (unsigned short)(pkbf(cacc[jk][i], 0.f) & 0xffffu);
                *(LAS unsigned short*)(CI + (32 * vb + crow(i, h)) * MLP + kcol * 2) = v;
            }
            if (vb == 0 && h == 0) ((GAS float*)(ws + WS_DN))[((size_t)chain * 16 + ci) * 128 + kcol] = ntmp[jk][0];
        }
    }
    __syncthreads();
    {
        CHAIN_LANES();
        GAS bf16_t* dc = (GAS bf16_t*)((GAS float*)P->out) + ((size_t)chain * 16 + ci) * 16384;
#pragma unroll
        for (int i = 0; i < 4; ++i) { const int ix = tid + 512 * i; *(GAS u32x4*)(dc + (size_t)ix * 8) = *(LAS u32x4*)(CI + (ix >> 4) * MLP + (ix & 15) * 16); }
    }
}

DI void mlstm_p1f(KPC P, LAS unsigned char* lds, int grp, int bl, int head, int pc, const int tid0) {
    int tid = tid0; const int wave = __builtin_amdgcn_readfirstlane(tid0 >> 6);
    GAS unsigned char* ws = ((GAS unsigned char*)P->ws); asm volatile("" : "+s"(ws));
    LAS unsigned char* KW = lds; LAS unsigned char* KI = lds + 128 * MLT; LAS unsigned char* VI = lds + 128 * MLT + 128 * MLP; LAS unsigned char* CI = lds + 2 * 128 * MLT + 128 * MLP;
    LAS float* twk = (LAS float*)(lds + TB_OFF) + 256;
    const size_t rowb = (size_t)bl * 2048;
    {
        CHAIN_LANES();
        if (tid < 256) {
            ml_conv_item(P, (const GAS bf16_t*)(ws + WS_MK), KI, 1, tid & 15, (tid >> 4) & 15, pc, 0, rowb, head);
        } else {
            const int d = wave == 7 ? 0 : 1;
            const int ci = d ? 15 - pc : pc; const int chain = bl * 8 + head * 2 + d;
            float gl[4] = {0.f, 0.f, 0.f, 0.f};
            if (wave >= 6) {
                const GAS float* MIF = (const GAS float*)(ws + (grp ? WS_MIF1 : WS_MIF));
                const int tau1 = 128 * ci + lane, tau2 = tau1 + 64; const int p1 = d ? 2047 - tau1 : tau1, p2 = d ? 2047 - tau2 : tau2;
                const GAS float* r1 = MIF + (rowb + p1) * 16 + head; const GAS float* r2 = MIF + (rowb + p2) * 16 + head;
                gl[0] = r1[d ? 8 : 0]; gl[1] = r2[d ? 8 : 0]; gl[2] = r1[d ? 12 : 4]; gl[3] = r2[d ? 12 : 4];
            }
            const int t2 = tid - 256; const int t = t2 >> 1, c0 = (t2 & 1) * 64;
            const GAS bf16_t* vsrc = (const GAS bf16_t*)(ws + WS_MV) + (rowb + 128 * pc + t) * 512 + head * 128 + c0;
#pragma unroll
            for (int sub = 0; sub < 8; ++sub) *(LAS u32x4*)(VI + t * MLT + c0 * 2 + sub * 16) = *(const GAS u32x4*)(vsrc + 8 * sub);
            if (wave >= 6) {
                const float bli = ((const GAS float*)P->ml_gate_b)[(d ? 8 : 0) + head], blf = ((const GAS float*)P->ml_gate_b)[(d ? 12 : 4) + head];
                const float li1 = gl[0] + bli, li2 = gl[1] + bli;
                const float lf1 = log_sigmoid(gl[2] + blf), lf2 = log_sigmoid(gl[3] + blf);
                const float c1 = scan_add(lf1, lane); const float tot1 = rdlane(c1, 63); const float c2 = scan_add(lf2, lane) + tot1;
                const float g1 = li1 - c1, g2 = li2 - c2;
                float gm = fmaxf(g1, g2);
#pragma unroll
                for (int o = 1; o < 64; o <<= 1) gm = fmaxf(gm, SHX(gm, o));
                const float gtot = rdlane(c2, 63);
                const int po1 = d ? 127 - lane : lane, po2 = d ? 63 - lane : 64 + lane;
                twk[d * 128 + po1] = __expf(g1 - gm); twk[d * 128 + po2] = __expf(g2 - gm);
                if (lane == 0) { GAS float* scl = (GAS float*)(ws + WS_SCL) + ((size_t)chain * 16 + ci) * 4; scl[0] = gtot; scl[1] = gm; }
            }
        }
    }
    __syncthreads();
#pragma unroll 1
    for (int d = 0; d < 2; ++d) {
        const int ci = d ? 15 - pc : pc; const int chain = bl * 8 + head * 2 + d;
        {
            CHAIN_LANES();
            const int sp = tid >> 2, c0 = (tid & 3) * 32; const float wks = twk[d * 128 + sp];
#pragma unroll
            for (int sub = 0; sub < 4; ++sub) {
                const u32x4 w = *(const LAS u32x4*)(KI + sp * MLP + c0 * 2 + sub * 16);
                u32x4 o; o.x = pkbf(bflo(w.x) * wks, bfhi(w.x) * wks); o.y = pkbf(bflo(w.y) * wks, bfhi(w.y) * wks); o.z = pkbf(bflo(w.z) * wks, bfhi(w.z) * wks); o.w = pkbf(bflo(w.w) * wks, bfhi(w.w) * wks);
                *(LAS u32x4*)(KW + sp * MLT + c0 * 2 + sub * 16) = o;
            }
        }
        __syncthreads();
        {
            CHAIN_LANES();
            const int vb = wave >> 1, kh = wave & 1;
            const int trt = ((lane & 15) >> 2) * MLT + 32 * ((lane >> 4) & 1) + 8 * (lane & 3);
            f32x16 cacc[2], ntmp[2]; cacc[0] = zero16(); cacc[1] = zero16(); ntmp[0] = zero16(); ntmp[1] = zero16();
            const bf16x8 ones = (bf16x8){0x3F80, 0x3F80, 0x3F80, 0x3F80, 0x3F80, 0x3F80, 0x3F80, 0x3F80};
#pragma unroll
            for (int ks = 0; ks < 8; ++ks) {
                LAS unsigned char* vp = VI + trt + (16 * ks + 8 * h) * MLT + 64 * vb;
                const bf16x8 af = cat44(trread(vp), trread(vp + 4 * MLT));
#pragma unroll
                for (int jk = 0; jk < 2; ++jk) {
                    LAS unsigned char* kp = KW + trt + (16 * ks + 8 * h) * MLT + 64 * (2 * kh + jk);
                    const bf16x8 bfr = cat44(trread(kp), trread(kp + 4 * MLT));
                    cacc[jk] = mfma32(af, bfr, cacc[jk]);
                    if (vb == 0) ntmp[jk] = mfma32(ones, bfr, ntmp[jk]);
                }
            }
#pragma unroll
            for (int jk = 0; jk < 2; ++jk) {
                const int kcol = 32 * (2 * kh + jk) + r;
#pragma unroll
                for (int i = 0; i < 16; i += 1) {
                    const unsigned short v = (unsigned short)(pkbf(cacc[jk][i], 0.f) & 0xffffu);
                    *(LAS unsigned short*)(CI + (32 * vb + crow(i, h)) * MLP + kcol * 2) = v;
                }
                if (vb == 0 && h == 0) ((GAS float*)(ws + WS_DN))[((size_t)chain * 16 + ci) * 128 + kcol] = ntmp[jk][0];
            }
        }
        __syncthreads();
        {
            CHAIN_LANES();
            GAS bf16_t* dc = (GAS bf16_t*)((GAS float*)P->out) + ((size_t)chain * 16 + ci) * 16384;
#pragma unroll
            for (int i = 0; i < 4; ++i) { const int ix = tid + 512 * i; *(GAS u32x4*)(dc + (size_t)ix * 8) = *(LAS u32x4*)(CI + (ix >> 4) * MLP + (ix & 15) * 16); }
        }
    }
}

DI void mlstm_scan(GAS unsigned char* ws, GAS float* dcbase, int w, int tid) {
    const int chain = w >> 2, quarter = w & 3;
    GAS float* scl = (GAS float*)(ws + WS_SCL) + (size_t)chain * 64;
    GAS bf16_t* dc = (GAS bf16_t*)dcbase + (size_t)chain * 16 * 16384 + (size_t)(quarter * 512 + tid) * 8;
    GAS float* dn = (GAS float*)(ws + WS_DN) + (size_t)chain * 16 * 128 + (tid & 127);
    const bool isn = quarter == 0 && tid < 128;
    u32x4 d[16]; float nd[16];
#pragma unroll
    for (int c = 0; c < 16; ++c) { d[c] = *(const GAS u32x4*)(dc + (size_t)c * 16384); nd[c] = isn ? dn[c * 128] : 0.f; }
    float C[8]; float nn = 0.f, m = 0.f; float zinit = 0.f; asm volatile("" : "+v"(zinit));
#pragma unroll
    for (int k = 0; k < 8; ++k) C[k] = zinit;
#pragma unroll
    for (int c = 0; c < 16; ++c) {
        u32x4 o; o.x = pkbf(C[0], C[1]); o.y = pkbf(C[2], C[3]); o.z = pkbf(C[4], C[5]); o.w = pkbf(C[6], C[7]);
        *(GAS u32x4*)(dc + (size_t)c * 16384) = o;
        if (isn) dn[c * 128] = nn;
        const float gt = scl[4 * c], gm = scl[4 * c + 1];
        const float mn = gt + fmaxf(m, gm); const float al = __expf(gt + m - mn), be = __expf(gt + gm - mn);
        if (quarter == 0 && tid == 0) scl[4 * c + 2] = m;
        const u32x4 w4 = d[c];
        C[0] = al * C[0] + be * bflo(w4.x); C[1] = al * C[1] + be * bfhi(w4.x); C[2] = al * C[2] + be * bflo(w4.y); C[3] = al * C[3] + be * bfhi(w4.y);
        C[4] = al * C[4] + be * bflo(w4.z); C[5] = al * C[5] + be * bfhi(w4.z); C[6] = al * C[6] + be * bflo(w4.w); C[7] = al * C[7] + be * bfhi(w4.w);
        nn = al * nn + be * nd[c]; m = mn;
    }
}

DI void mlstm_p3(KPC P, LAS unsigned char* lds, int grp, int chain, int ci, const int tid0) {
    int tid = tid0; const int wave = __builtin_amdgcn_readfirstlane(tid0 >> 6);
    const int bl = chain >> 3, head = (chain >> 1) & 3, dir = chain & 1;
    GAS unsigned char* ws = ((GAS unsigned char*)P->ws); asm volatile("" : "+s"(ws));
    LAS unsigned char* QI = lds; LAS unsigned char* KI = lds + 128 * MLP; LAS unsigned char* VI = lds + 2 * 128 * MLP; LAS unsigned char* CI = lds + 3 * 128 * MLP;
    LAS float* tg = (LAS float*)(lds + TB_OFF); LAS float* tM = tg + 128; LAS float* tbc = tg + 256; LAS float* tnv = tg + 512; LAS float* scal = tg + 640;
    const size_t rowb = (size_t)bl * 2048;
    {
        CHAIN_LANES();
        ml_conv_item(P, (const GAS bf16_t*)(ws + (tid >> 8 ? WS_MK : WS_MQ)), (tid >> 8) ? KI : QI, tid >> 8, tid & 15, (tid >> 4) & 15, ci, dir, rowb, head);
        {
            const int t = tid >> 2, c0 = (tid & 3) * 32; const int tau = 128 * ci + t; const int p = dir ? 2047 - tau : tau;
            const GAS bf16_t* vsrc = (const GAS bf16_t*)(ws + WS_MV) + (rowb + p) * 512 + head * 128 + c0;
#pragma unroll
            for (int sub = 0; sub < 4; ++sub) *(LAS u32x4*)(VI + t * MLP + c0 * 2 + sub * 16) = *(const GAS u32x4*)(vsrc + 8 * sub);
            const GAS bf16_t* dc = (const GAS bf16_t*)((GAS float*)P->out) + ((size_t)chain * 16 + ci) * 16384;
#pragma unroll
            for (int i = 0; i < 4; ++i) { const int ix = tid + 512 * i; *(LAS u32x4*)(CI + (ix >> 4) * MLP + (ix & 15) * 16) = *(const GAS u32x4*)(dc + (size_t)ix * 8); }
        }
        if (wave == 1) tnv[lane] = ((const GAS float*)(ws + WS_DN))[((size_t)chain * 16 + ci) * 128 + lane];
        if (wave == 2) tnv[64 + lane] = ((const GAS float*)(ws + WS_DN))[((size_t)chain * 16 + ci) * 128 + 64 + lane];
        if (wave == 0) {
            const GAS float* MIF = (const GAS float*)(ws + WS_MIF);
            const float bli = ((const GAS float*)P->ml_gate_b)[(dir ? 8 : 0) + head], blf = ((const GAS float*)P->ml_gate_b)[(dir ? 12 : 4) + head];
            const float mcur = ((const GAS float*)(ws + WS_SCL))[((size_t)chain * 16 + ci) * 4 + 2];
            const int tau1 = 128 * ci + lane, tau2 = tau1 + 64; const int p1 = dir ? 2047 - tau1 : tau1, p2 = dir ? 2047 - tau2 : tau2;
            const GAS float* r1 = MIF + (rowb + p1) * 16 + head; const GAS float* r2 = MIF + (rowb + p2) * 16 + head;
            const float li1 = r1[dir ? 8 : 0] + bli, li2 = r2[dir ? 8 : 0] + bli;
            const float lf1 = log_sigmoid(r1[dir ? 12 : 4] + blf), lf2 = log_sigmoid(r2[dir ? 12 : 4] + blf);
            const float c1 = scan_add(lf1, lane); const float tot1 = rdlane(c1, 63); const float c2 = scan_add(lf2, lane) + tot1;
            const float g1 = li1 - c1, g2 = li2 - c2;
            const float x1 = scan_max(g1, lane); const float mx1 = rdlane(x1, 63); const float x2 = fmaxf(scan_max(g2, lane), mx1);
            tg[lane] = g1; tg[64 + lane] = g2; tM[lane] = fmaxf(x1, mcur); tM[64 + lane] = fmaxf(x2, mcur); tbc[lane] = c1; tbc[64 + lane] = c2;
            if (lane == 0) scal[0] = mcur;
        }
    }
    __syncthreads();
    {
        CHAIN_LANES();
        GAS bf16_t* Hout = (GAS bf16_t*)(ws + (dir ? WS_HB : WS_HF));
        const int tb = wave >> 1, vh = wave & 1; const int t = 32 * tb + r;
        const float Mt = tM[t], bct = tbc[t], mold = scal[0];
        const float winter = __expf(mold - Mt), flo = __expf(-(Mt + bct));
        bf16x8 qf[8];
#pragma unroll
        for (int ks = 0; ks < 8; ++ks) qf[ks] = *(const LAS bf16x8*)(QI + t * MLP + (16 * ks + 8 * h) * 2);
        f32x16 na[2]; na[0] = zero16(); na[1] = zero16();
        float den = 0.f;
        for (int sb = 0; sb <= tb; ++sb) {
            f32x16 st = zero16();
#pragma unroll
            for (int ks = 0; ks < 8; ++ks) st = mfma32(*(const LAS bf16x8*)(KI + (32 * sb + r) * MLP + (16 * ks + 8 * h) * 2), qf[ks], st);
            MEMFENCE();
#pragma unroll
            for (int i = 0; i < 16; ++i) {
                const int sl = crow(i, h); const float wgt = __expf(tg[32 * sb + sl] - Mt);
                const bool valid = (sb < tb) || (sl <= r);
                const float v = valid ? st[i] * wgt : 0.f; st[i] = v; den += v;
            }
#pragma unroll
            for (int ks2 = 0; ks2 < 2; ++ks2) {
                const bf16x8 pb = pack8(st, ks2);
#pragma unroll
                for (int jv = 0; jv < 2; ++jv) {
                    LAS unsigned char* vp = VI + trofs + (32 * sb + 16 * ks2 + 4 * h) * MLP + 64 * (2 * vh + jv);
                    const s16x4 lo = trread(vp), hi = trread(vp + 8 * MLP);
                    na[jv] = mfma32(cat44(lo, hi), pb, na[jv]);
                }
            }
        }
        den += SHX(den, 32);
        float dq = 0.f;
#pragma unroll
        for (int ks = 0; ks < 8; ++ks) {
            const u32x4 w = __builtin_bit_cast(u32x4, qf[ks]); const LAS float* nv = tnv + 16 * ks + 8 * h;
            const float q0 = bflo(w.x), q1 = bfhi(w.x), q2 = bflo(w.y), q3 = bfhi(w.y), q4_ = bflo(w.z), q5 = bfhi(w.z), q6 = bflo(w.w), q7 = bfhi(w.w);
            dq += (nv[0] * q0 + nv[1] * q1) + (nv[2] * q2 + nv[3] * q3) + (nv[4] * q4_ + nv[5] * q5) + (nv[6] * q6 + nv[7] * q7);
            u32x4 o; o.x = pkbf(q0 * winter, q1 * winter); o.y = pkbf(q2 * winter, q3 * winter); o.z = pkbf(q4_ * winter, q5 * winter); o.w = pkbf(q6 * winter, q7 * winter);
            const bf16x8 qs = __builtin_bit_cast(bf16x8, o);
#pragma unroll
            for (int jv = 0; jv < 2; ++jv)
                na[jv] = mfma32(*(const LAS bf16x8*)(CI + (32 * (2 * vh + jv) + r) * MLP + (16 * ks + 8 * h) * 2), qs, na[jv]);
        }
        dq += SHX(dq, 32);
        den += winter * dq;
        const float inv = frcp(fmaxf(fabsf(den), flo));
        const int tau = 128 * ci + t; const int p = dir ? 2047 - tau : tau;
        GAS bf16_t* dst = Hout + (rowb + p) * 512 + head * 128;
#pragma unroll
        for (int jv = 0; jv < 2; ++jv)
#pragma unroll
            for (int g4 = 0; g4 < 4; ++g4) {
                u32x2 w; w.x = pkbf(na[jv][4 * g4] * inv, na[jv][4 * g4 + 1] * inv); w.y = pkbf(na[jv][4 * g4 + 2] * inv, na[jv][4 * g4 + 3] * inv);
                *(GAS u32x2*)(dst + 32 * (2 * vh + jv) + 8 * g4 + 4 * h) = w;
            }
    }
    __syncthreads();
}

DI void mlstm_p3f(KPC P, LAS unsigned char* lds, int grp, int bl, int head, int pc, const int tid0) {
    int tid = tid0; const int wave = __builtin_amdgcn_readfirstlane(tid0 >> 6);
    GAS unsigned char* ws = ((GAS unsigned char*)P->ws); asm volatile("" : "+s"(ws));
    LAS unsigned char* QI = lds; LAS unsigned char* KI = lds + 128 * MLP; LAS unsigned char* VI = lds + 2 * 128 * MLP; LAS unsigned char* CI = lds + 2 * 128 * MLP + 128 * MLT;
    LAS float* tg = (LAS float*)(lds + TB_OFF); LAS float* tM = tg + 128; LAS float* tbc = tg + 256; LAS float* tnv = tg + 512; LAS float* scal = tg + 640; LAS float* ssx = tg + 656;
    const size_t rowb = (size_t)bl * 2048;
    {
        CHAIN_LANES();
        const int tv = tid >> 2, cv0 = (tid & 3) * 32;
        const GAS bf16_t* vsrc = (const GAS bf16_t*)(ws + WS_MV) + (rowb + 128 * pc + tv) * 512 + head * 128 + cv0;
        u32x4 vr[4];
#pragma unroll
        for (int sub = 0; sub < 4; ++sub) vr[sub] = *(const GAS u32x4*)(vsrc + 8 * sub);
        ml_conv_item(P, (const GAS bf16_t*)(ws + (tid >> 8 ? WS_MK : WS_MQ)), (tid >> 8) ? KI : QI, tid >> 8, tid & 15, (tid >> 4) & 15, pc, 0, rowb, head);
#pragma unroll
        for (int sub = 0; sub < 4; ++sub) *(LAS u32x4*)(VI + tv * MLT + cv0 * 2 + sub * 16) = vr[sub];
    }
#pragma unroll 1
    for (int d = 0; d < 2; ++d) {
        const int ci = d ? 15 - pc : pc; const int chain = bl * 8 + head * 2 + d;
        {
            CHAIN_LANES();
            const GAS bf16_t* dc = (const GAS bf16_t*)((GAS float*)P->out) + ((size_t)chain * 16 + ci) * 16384;
#pragma unroll
            for (int i = 0; i < 4; ++i) { const int ix = tid + 512 * i; *(LAS u32x4*)(CI + (ix >> 4) * MLP + (ix & 15) * 16) = *(const GAS u32x4*)(dc + (size_t)ix * 8); }
            if (wave == 1) tnv[lane] = ((const GAS float*)(ws + WS_DN))[((size_t)chain * 16 + ci) * 128 + lane];
            if (wave == 2) tnv[64 + lane] = ((const GAS float*)(ws + WS_DN))[((size_t)chain * 16 + ci) * 128 + 64 + lane];
            if (wave == 0) {
                const GAS float* MIF = (const GAS float*)(ws + (grp ? WS_MIF1 : WS_MIF));
                const float bli = ((const GAS float*)P->ml_gate_b)[(d ? 8 : 0) + head], blf = ((const GAS float*)P->ml_gate_b)[(d ? 12 : 4) + head];
                const float mcur = ((const GAS float*)(ws + WS_SCL))[((size_t)chain * 16 + ci) * 4 + 2];
                const int tau1 = 128 * ci + lane, tau2 = tau1 + 64; const int p1 = d ? 2047 - tau1 : tau1, p2 = d ? 2047 - tau2 : tau2;
                const GAS float* r1 = MIF + (rowb + p1) * 16 + head; const GAS float* r2 = MIF + (rowb + p2) * 16 + head;
                const float li1 = r1[d ? 8 : 0] + bli, li2 = r2[d ? 8 : 0] + bli;
                const float lf1 = log_sigmoid(r1[d ? 12 : 4] + blf), lf2 = log_sigmoid(r2[d ? 12 : 4] + blf);
                const float c1 = scan_add(lf1, lane); const float tot1 = rdlane(c1, 63); const float c2 = scan_add(lf2, lane) + tot1;
                const float g1 = li1 - c1, g2 = li2 - c2;
                const float x1 = scan_max(g1, lane); const float mx1 = rdlane(x1, 63); const float x2 = fmaxf(scan_max(g2, lane), mx1);
                tg[lane] = g1; tg[64 + lane] = g2; tM[lane] = fmaxf(x1, mcur); tM[64 + lane] = fmaxf(x2, mcur); tbc[lane] = c1; tbc[64 + lane] = c2;
                if (lane == 0) scal[0] = mcur;
            }
        }
        __syncthreads();
        {
            CHAIN_LANES();
            const int q4l = (lane & 15) >> 2, cofs = 32 * ((lane >> 4) & 1) + 8 * (lane & 3);
            const int tb = wave >> 1, vh = wave & 1; const int t = 32 * tb + r;
            const int pot = d ? 127 - t : t;
            const float Mt = tM[t], bct = tbc[t], mold = scal[0];
            const float winter = __expf(mold - Mt), flo = __expf(-(Mt + bct));
            bf16x8 qf[8];
#pragma unroll
            for (int ks = 0; ks < 8; ++ks) qf[ks] = *(const LAS bf16x8*)(QI + pot * MLP + (16 * ks + 8 * h) * 2);
            f32x16 na[2]; na[0] = zero16(); na[1] = zero16();
            float den = 0.f;
            for (int sb = 0; sb <= tb; ++sb) {
                f32x16 st = zero16();
                const int srow = 32 * sb + r; const int pos_s = d ? 127 - srow : srow;
#pragma unroll
                for (int ks = 0; ks < 8; ++ks) st = mfma32(*(const LAS bf16x8*)(KI + pos_s * MLP + (16 * ks + 8 * h) * 2), qf[ks], st);
                MEMFENCE();
#pragma unroll
                for (int i = 0; i < 16; ++i) {
                    const int sl = crow(i, h); const float wgt = __expf(tg[32 * sb + sl] - Mt);
                    const bool valid = (sb < tb) || (sl <= r);
                    const float v = valid ? st[i] * wgt : 0.f; st[i] = v; den += v;
                }
#pragma unroll
                for (int ks2 = 0; ks2 < 2; ++ks2) {
                    const bf16x8 pb = pack8(st, ks2);
                    const int rlo = 32 * sb + 16 * ks2 + 4 * h + q4l, rhi = rlo + 8;
                    const int plo = d ? 127 - rlo : rlo, phi = d ? 127 - rhi : rhi;
#pragma unroll
                    for (int jv = 0; jv < 2; ++jv) {
                        const s16x4 lo = trread(VI + plo * MLT + cofs + 64 * (2 * vh + jv)), hi = trread(VI + phi * MLT + cofs + 64 * (2 * vh + jv));
                        na[jv] = mfma32(cat44(lo, hi), pb, na[jv]);
                    }
                }
            }
            den += SHX(den, 32);
            float dq = 0.f;
#pragma unroll
            for (int ks = 0; ks < 8; ++ks) {
                const u32x4 w = __builtin_bit_cast(u32x4, qf[ks]); const LAS float* nv = tnv + 16 * ks + 8 * h;
                const float q0 = bflo(w.x), q1 = bfhi(w.x), q2 = bflo(w.y), q3 = bfhi(w.y), q4_ = bflo(w.z), q5 = bfhi(w.z), q6 = bflo(w.w), q7 = bfhi(w.w);
                dq += (nv[0] * q0 + nv[1] * q1) + (nv[2] * q2 + nv[3] * q3) + (nv[4] * q4_ + nv[5] * q5) + (nv[6] * q6 + nv[7] * q7);
                u32x4 o; o.x = pkbf(q0 * winter, q1 * winter); o.y = pkbf(q2 * winter, q3 * winter); o.z = pkbf(q4_ * winter, q5 * winter); o.w = pkbf(q6 * winter, q7 * winter);
                const bf16x8 qs = __builtin_bit_cast(bf16x8, o);
#pragma unroll
                for (int jv = 0; jv < 2; ++jv)
                    na[jv] = mfma32(*(const LAS bf16x8*)(CI + (32 * (2 * vh + jv) + r) * MLP + (16 * ks + 8 * h) * 2), qs, na[jv]);
            }
            dq += SHX(dq, 32);
            den += winter * dq;
            const float inv = frcp(fmaxf(fabsf(den), flo));
            const size_t tok = rowb + 128 * pc + pot;
            GAS bf16_t* hf = (GAS bf16_t*)(ws + WS_HF) + tok * 512 + head * 128;
            if (d == 0) {
#pragma unroll
                for (int jv = 0; jv < 2; ++jv)
#pragma unroll
                    for (int g4 = 0; g4 < 4; ++g4) {
                        u32x2 w; w.x = pkbf(na[jv][4 * g4] * inv, na[jv][4 * g4 + 1] * inv); w.y = pkbf(na[jv][4 * g4 + 2] * inv, na[jv][4 * g4 + 3] * inv);
                        *(GAS u32x2*)(hf + 32 * (2 * vh + jv) + 8 * g4 + 4 * h) = w;
                    }
            } else {
                float ssq = 0.f;
#pragma unroll
                for (int jv = 0; jv < 2; ++jv)
#pragma unroll
                    for (int g4 = 0; g4 < 4; ++g4) {
                        const u32x2 w = *(const GAS u32x2*)(hf + 32 * (2 * vh + jv) + 8 * g4 + 4 * h);
                        na[jv][4 * g4] = na[jv][4 * g4] * inv + bflo(w.x); na[jv][4 * g4 + 1] = na[jv][4 * g4 + 1] * inv + bfhi(w.x);
                        na[jv][4 * g4 + 2] = na[jv][4 * g4 + 2] * inv + bflo(w.y); na[jv][4 * g4 + 3] = na[jv][4 * g4 + 3] * inv + bfhi(w.y);
                        ssq += (na[jv][4 * g4] * na[jv][4 * g4] + na[jv][4 * g4 + 1] * na[jv][4 * g4 + 1]) + (na[jv][4 * g4 + 2] * na[jv][4 * g4 + 2] + na[jv][4 * g4 + 3] * na[jv][4 * g4 + 3]);
                        if (g4 & 1) MEMFENCE();
                    }
                ssq += SHX(ssq, 32);
                if (h == 0) ssx[2 * t + vh] = ssq;
                __syncthreads();
                const float rs = frsq((ssx[2 * t] + ssx[2 * t + 1]) * (1.0f / 128.0f) + EPS);
                const GAS bf16_t* mo = (const GAS bf16_t*)(ws + WS_MO) + tok * 512 + head * 128;
                GAS bf16_t* ym = (GAS bf16_t*)(ws + WS_YATT) + tok * 1536 + 512 + head * 128;
                const GAS float* gn = ((const GAS float*)P->ml_out_gain) + head * 128;
#pragma unroll
                for (int jv = 0; jv < 2; ++jv)
#pragma unroll
                    for (int g4 = 0; g4 < 4; ++g4) {
                        const int vo = 32 * (2 * vh + jv) + 8 * g4 + 4 * h;
                        const u32x2 mw = *(const GAS u32x2*)(mo + vo); const f32x4 gv = *(const GAS f32x4*)(gn + vo);
                        const float y0 = na[jv][4 * g4] * rs * gv.x * sigmoidf_(bflo(mw.x)), y1 = na[jv][4 * g4 + 1] * rs * gv.y * sigmoidf_(bfhi(mw.x));
                        const float y2 = na[jv][4 * g4 + 2] * rs * gv.z * sigmoidf_(bflo(mw.y)), y3 = na[jv][4 * g4 + 3] * rs * gv.w * sigmoidf_(bfhi(mw.y));
                        u32x2 w; w.x = pkbf(y0, y1); w.y = pkbf(y2, y3);
                        *(GAS u32x2*)(ym + vo) = w;
                        if (g4 & 1) MEMFENCE();
                    }
            }
        }
        __syncthreads();
    }
}

DI void merge_pass(KPC P, int gw, int NGW, int lane, const bool do_att) {
    GAS unsigned char* ws = ((GAS unsigned char*)P->ws);
    const GAS bf16_t* AO = (const GAS bf16_t*)(ws + WS_AQ); const GAS float* LSE = (const GAS float*)(ws + WS_LSE);
    const GAS bf16_t* HF = (const GAS bf16_t*)(ws + WS_HF); const GAS bf16_t* HB = (const GAS bf16_t*)(ws + WS_HB); const GAS bf16_t* MO = (const GAS bf16_t*)(ws + WS_MO);
    GAS bf16_t* YA = (GAS bf16_t*)(ws + WS_YATT); GAS bf16_t* YM = YA + 512;
    constexpr int U = 2;
    for (int t0 = gw * U; t0 < TG; t0 += NGW * U) {
        if (do_att) {
            const int slot = lane >> 3, d0 = 8 * (lane & 7);
            float ls[U][3]; u32x4 w[U][3];
#pragma unroll
            for (int k = 0; k < U; ++k) {
                const int tok = t0 + k, bl = tok >> 11, sq = tok & 2047;
#pragma unroll
                for (int g = 0; g < 3; ++g) {
                    ls[k][g] = LSE[((size_t)g * TG + tok) * 8 + slot];
                    const int sh = 2 * g; const int perm = ((sq & ((1 << sh) - 1)) << (11 - sh)) + (sq >> sh);
                    w[k][g] = *(const GAS u32x4*)(AO + ((size_t)(bl * 24 + g * 8 + slot) * 2048 + perm) * 64 + d0);
                }
            }
#pragma unroll
            for (int k = 0; k < U; ++k) {
                const int tok = t0 + k;
                const float mx = fmaxf(fmaxf(ls[k][0], ls[k][1]), ls[k][2]);
                float e[3], sum = 0.f;
#pragma unroll
                for (int g = 0; g < 3; ++g) { e[g] = __expf(ls[k][g] - mx); sum += e[g]; }
                const float isum = frcp(sum);
                float acc[8];
#pragma unroll
                for (int q = 0; q < 8; ++q) acc[q] = 0.f;
#pragma unroll
                for (int g = 0; g < 3; ++g) {
                    const float a = e[g] * isum; const u32x4 x = w[k][g];
                    acc[0] += a * bflo(x.x); acc[1] += a * bfhi(x.x); acc[2] += a * bflo(x.y); acc[3] += a * bfhi(x.y);
                    acc[4] += a * bflo(x.z); acc[5] += a * bfhi(x.z); acc[6] += a * bflo(x.w); acc[7] += a * bfhi(x.w);
                }
                u32x4 o; o.x = pkbf(acc[0], acc[1]); o.y = pkbf(acc[2], acc[3]); o.z = pkbf(acc[4], acc[5]); o.w = pkbf(acc[6], acc[7]);
                *(GAS u32x4*)(YA + (size_t)tok * 1536 + slot * 64 + d0) = o;
            }
        } else {
            u32x4 a[U], b[U], mo[U];
#pragma unroll
            for (int k = 0; k < U; ++k) { const size_t off = (size_t)(t0 + k) * 512 + 8 * lane; a[k] = *(const GAS u32x4*)(HF + off); b[k] = *(const GAS u32x4*)(HB + off); mo[k] = *(const GAS u32x4*)(MO + off); }
            const f32x4 ga = *(const GAS f32x4*)(((const GAS float*)P->ml_out_gain) + 8 * lane), gb = *(const GAS f32x4*)(((const GAS float*)P->ml_out_gain) + 8 * lane + 4);
            const float gg[8] = {ga.x, ga.y, ga.z, ga.w, gb.x, gb.y, gb.z, gb.w};
#pragma unroll
            for (int k = 0; k < U; ++k) {
                float v[8];
                v[0] = bflo(a[k].x) + bflo(b[k].x); v[1] = bfhi(a[k].x) + bfhi(b[k].x); v[2] = bflo(a[k].y) + bflo(b[k].y); v[3] = bfhi(a[k].y) + bfhi(b[k].y);
                v[4] = bflo(a[k].z) + bflo(b[k].z); v[5] = bfhi(a[k].z) + bfhi(b[k].z); v[6] = bflo(a[k].w) + bflo(b[k].w); v[7] = bfhi(a[k].w) + bfhi(b[k].w);
                float ss = 0.f;
#pragma unroll
                for (int q = 0; q < 8; ++q) ss += v[q] * v[q];
                ss += SHX(ss, 1); ss += SHX(ss, 2); ss += SHX(ss, 4); ss += SHX(ss, 8);
                const float rs = frsq(ss * (1.0f / 128.0f) + EPS);
                const u32x4 mq = mo[k];
                float mg[8]; mg[0] = bflo(mq.x); mg[1] = bfhi(mq.x); mg[2] = bflo(mq.y); mg[3] = bfhi(mq.y); mg[4] = bflo(mq.z); mg[5] = bfhi(mq.z); mg[6] = bflo(mq.w); mg[7] = bfhi(mq.w);
                float y[8];
#pragma unroll
                for (int q = 0; q < 8; ++q) y[q] = v[q] * rs * gg[q] * sigmoidf_(mg[q]);
                u32x4 o; o.x = pkbf(y[0], y[1]); o.y = pkbf(y[2], y[3]); o.z = pkbf(y[4], y[5]); o.w = pkbf(y[6], y[7]);
                *(GAS u32x4*)(YM + (size_t)(t0 + k) * 1536 + 8 * lane) = o;
            }
        }
    }
}

DI void final_norm(KPC P, int gw, int NGW, int lane) {
    const GAS float* part = (const GAS float*)(((GAS unsigned char*)P->ws) + WS_PART + 3 * SS_STRIDE);
    const GAS bf16_t* xb = (const GAS bf16_t*)(((GAS unsigned char*)P->ws) + WS_XB);
    for (int row4 = gw; row4 < T_ / 4; row4 += NGW) {
        u32x2 v[4][4]; float rs[4];
#pragma unroll
        for (int rr = 0; rr < 4; ++rr) {
            rs[rr] = part[4 * row4 + rr];
#pragma unroll
            for (int j = 0; j < 4; ++j) v[rr][j] = *((const GAS u32x2*)(xb + (size_t)(4 * row4 + rr) * DM) + lane + 64 * j);
        }
        const GAS f32x4* gr = (const GAS f32x4*)((const GAS float*)P->norm_final) + lane;
        f32x4 gv[4];
#pragma unroll
        for (int j = 0; j < 4; ++j) gv[j] = gr[64 * j];
#pragma unroll
        for (int rr = 0; rr < 4; ++rr) {
            const int row = 4 * row4 + rr; const float r1 = frsq(rs[rr] * (1.0f / 1024.0f) + EPS);
            GAS f32x4* xr = (GAS f32x4*)(((GAS float*)P->out) + (size_t)row * DM) + lane;
#pragma unroll
            for (int j = 0; j < 4; ++j) { const u32x2 w = v[rr][j]; xr[64 * j] = (f32x4){bflo(w.x), bfhi(w.x), bflo(w.y), bfhi(w.y)} * r1 * gv[j]; }
        }
    }
}

#define XB_TMO      128
#define XB_XCNT(j)  (256  + 64 * (j))
#define XB_XSUB(j)  (1280 + 64 * (j))
#define XB_XGEN(j)  (2304 + 64 * (j))
#define XB_TOP      3328
#define XB_TOPGEN   3392
#define XCD_BAR_WORDS 3456
#define XB_SPIN_CAP (1u << 22)
DI unsigned xb_ld(unsigned* p)              { return __hip_atomic_load(p, __ATOMIC_RELAXED, __HIP_MEMORY_SCOPE_AGENT); }
DI unsigned xb_add(unsigned* p, unsigned v) { return __hip_atomic_fetch_add(p, v, __ATOMIC_RELAXED, __HIP_MEMORY_SCOPE_AGENT); }
DI unsigned xb_xcc_id() { return (unsigned)__builtin_amdgcn_s_getreg((3 << 11) | 20) & 0xFu; }
#define XB_SPIN(cond, bar) do { unsigned _sp = 0; while (cond) { __builtin_amdgcn_s_sleep(1); \
    if ((++_sp & 255u) == 0u) { if (xb_ld(&(bar)[XB_TMO])) break; if (_sp > XB_SPIN_CAP) { atomicAdd(&(bar)[XB_TMO], 1u); break; } } } } while (0)
struct XcdBarrier { unsigned* bar; unsigned x; volatile LAS unsigned* st; };
DI XcdBarrier xcd_barrier_post(unsigned* bar, volatile LAS unsigned* st) {
    XcdBarrier b; b.bar = bar; b.x = xb_xcc_id(); b.st = st;
    if (threadIdx.x == 0) (void)xb_add(&bar[XB_XCNT(b.x)], 1u);
    return b;
}
DI void xcd_barrier_complete(unsigned* bar, unsigned x, unsigned& nloc, unsigned& nx) {
    const unsigned G = gridDim.x * gridDim.y * gridDim.z;
    unsigned sum, cnt, mine, sp = 0u;
    for (;;) {
        sum = 0u; cnt = 0u; mine = 0u;
#pragma unroll 1
        for (unsigned j = 0; j < 16; ++j) { const unsigned c = xb_ld(&bar[XB_XCNT(j)]); sum += c; cnt += (c > 0u) ? 1u : 0u; mine = (j == x) ? c : mine; }
        if (sum == G) break;
        __builtin_amdgcn_s_sleep(1);
        if ((++sp & 255u) == 0u) { if (xb_ld(&bar[XB_TMO])) break; if (sp > XB_SPIN_CAP) { atomicAdd(&bar[XB_TMO], 1u); break; } }
    }
    nloc = mine > 0u ? mine : 1u; nx = cnt > 0u ? cnt : 1u;
}
DI void xcd_barrier(const XcdBarrier& b) {
    asm volatile("s_waitcnt vmcnt(0)" ::: "memory");
    __syncthreads();
    if (threadIdx.x == 0) {
        unsigned* bar = b.bar;
        __builtin_amdgcn_s_waitcnt(0);
        unsigned nloc = b.st[0], nx = b.st[1];
        if (nloc == 0u) { xcd_barrier_complete(bar, b.x, nloc, nx); b.st[0] = nloc; b.st[1] = nx; }
        const unsigned old = xb_add(&bar[XB_XSUB(b.x)], 1u);
        const unsigned gen = old / nloc;
        if (old + 1u == (gen + 1u) * nloc) {
            __builtin_amdgcn_fence(__ATOMIC_RELEASE, "agent");
            asm volatile("s_waitcnt vmcnt(0)" ::: "memory");
            const unsigned og = xb_add(&bar[XB_TOP], 1u);
            const unsigned tg = og / nx;
            if (og + 1u == (tg + 1u) * nx) xb_add(&bar[XB_TOPGEN], 1u);
            else XB_SPIN(xb_ld(&bar[XB_TOPGEN]) == tg, bar);
            __builtin_amdgcn_fence(__ATOMIC_ACQUIRE, "agent");
            xb_add(&bar[XB_XGEN(b.x)], 1u);
            asm volatile("s_waitcnt vmcnt(0)" ::: "memory");
        } else {
            XB_SPIN(xb_ld(&bar[XB_XGEN(b.x)]) == gen, bar);
            __builtin_amdgcn_fence(__ATOMIC_ACQUIRE, "agent");
            asm volatile("s_waitcnt vmcnt(0)" ::: "memory");
        }
    }
    __syncthreads();
}

__global__ void __launch_bounds__(512, 2) mega_fwd(KP Pv, int step_lo, int step_hi, int coop) {
    extern __shared__ __attribute__((aligned(16))) unsigned char lds_raw[];
    LAS unsigned char* lds = (LAS unsigned char*)lds_raw;
    const int G = gridDim.x, NGW = G * 8;
    const int wave0 = __builtin_amdgcn_readfirstlane((int)threadIdx.x >> 6);
    volatile LAS unsigned* misc = (volatile LAS unsigned*)(lds + LDS_BYTES - 256);
    if (threadIdx.x < 8) misc[threadIdx.x] = 0u;
    __syncthreads();
    XcdBarrier xbar = xcd_barrier_post((unsigned*)(Pv.ws + WS_CTL) + 4096, misc);
#ifdef TS_PROBE
    if (blockIdx.x == 0 && threadIdx.x == 0) ((GAS unsigned long long*)(((GAS unsigned char*)Pv.ws) + WS_CTL + 32768))[0] = __builtin_amdgcn_s_memrealtime();
#endif
#pragma unroll 1
    for (int step = step_lo; step < step_hi; ++step) {
        unsigned mb0 = 0u; asm volatile("" : "+s"(mb0));
        int tid = wave0 * 64 + (int)__builtin_amdgcn_mbcnt_hi(~0u, __builtin_amdgcn_mbcnt_lo(~0u, mb0)); asm volatile("" : "+v"(tid));
        const int lane = tid & 63, wave = __builtin_amdgcn_readfirstlane(tid >> 6);
        int bid = blockIdx.x; asm volatile("" : "+s"(bid));
        const int gw = bid * 8 + wave;
        KPC P = (KPC)__builtin_amdgcn_kernarg_segment_ptr(); asm volatile("" : "+s"(P));
        GAS unsigned char* ws = ((GAS unsigned char*)P->ws); asm volatile("" : "+s"(ws));
        GAS unsigned* ctl = (GAS unsigned*)(ws + WS_CTL);
        bool is_gemm = false, do_sync = true, perm = true;
        pg8::Gemm g{nullptr, nullptr, 0, 0, 0};
        EpiAny E; E.kind = 0; E.aux = 0; E.goff = 0; E.ws = ws; E.kp = P;
        GAS bf16_t* xb = (GAS bf16_t*)(ws + WS_XB);
        int grp = 0, sub = -1;
        if (step >= 3 && step < 13) { grp = (step - 3) / 5; sub = (step - 3) % 5; }
        const int goff = grp * TG;
        if (step == 0) {
            prepass(P, lds, gw, NGW, wave, lane, 0);
        } else if (step == 1) {
            is_gemm = true; g = pg8::Gemm{xb, (const GAS bf16_t*)(ws + WS_W1), T_, 2 * DFF, 1024};
            E.kind = EK_SWIGLU;
        } else if (step == 2) {
            is_gemm = true; perm = false; g = pg8::Gemm{(const GAS bf16_t*)(ws + WS_ACT), (const GAS bf16_t*)(ws + WS_W2), T_, 1024, DFF};
            E.kind = EK_RESID; E.aux = 0;
        } else if (sub == 0) {
            is_gemm = true; g = pg8::Gemm{xb + (size_t)goff * DM, (const GAS bf16_t*)(ws + WS_WIN), TG, grp ? NWIN - 256 : NWIN, 1024};
            E.kind = EK_WIN; E.goff = goff;
        } else if (sub == 1 || sub == 3) {
            if (sub == 1) {
#pragma unroll 1
                for (int u = bid; u < 512; u += G) mlstm_p1f(P, lds, grp, u >> 6, (u >> 4) & 3, u & 15, tid);
            } else {
#pragma unroll 1
                for (int u = bid; u < 512; u += G) mlstm_p3f(P, lds, grp, u >> 6, (u >> 4) & 3, u & 15, tid);
            }
            __syncthreads();
            if (sub == 1) att_wg_loop(ws, lds, bid, G, BL * 24 * 8, tid);
            else {
#pragma unroll 1
                for (int u = bid; u < BL * 4 * 8; u += G) cross_wg_unit(P, lds, grp, u, tid);
            }
        } else if (sub == 2) {
            if (grp == 0) cknorm(P, gw, NGW, lane);
#pragma unroll 1
            for (int w = bid; w < 256; w += G) mlstm_scan(ws, ((GAS float*)P->out), w, tid);
            merge_pass(P, gw, NGW, lane, true);
        } else if (sub == 4) {
            is_gemm = true; perm = false;
            g = pg8::Gemm{(const GAS bf16_t*)(ws + WS_YATT), (const GAS bf16_t*)(ws + WS_WBR), TG, 1024, 1536};
            E.kind = EK_BR0; E.goff = goff;
        } else if (step == 13) {
            is_gemm = true; perm = false; g = pg8::Gemm{(const GAS bf16_t*)((GAS unsigned char*)((GAS float*)P->out) + 32 * MiB), (const GAS bf16_t*)(ws + WS_WOUT), T_, 1024, 1024};
            E.kind = EK_RESID; E.aux = 1; E.goff = 0;
        } else if (step == 14) {
            is_gemm = true; g = pg8::Gemm{xb, (const GAS bf16_t*)(ws + WS_W3), T_, 2 * DFF, 1024};
            E.kind = EK_SWIGLU; E.aux = 1;
        } else if (step == 15) {
            is_gemm = true; perm = false; g = pg8::Gemm{(const GAS bf16_t*)(ws + WS_ACT), (const GAS bf16_t*)(ws + WS_W4), T_, 1024, DFF};
            E.kind = EK_RESID; E.aux = 2;
        } else if (step == 16) {
            final_norm(P, gw, NGW, lane); do_sync = false;
        }
        if (is_gemm) {
            const int npass = (sub == 0 && grp == 0) ? 3 : 1;
#pragma unroll 1
            for (int ps = 0; ps < npass; ++ps) {
                pg8::StaticOrder S;
                if (ps == 0) S.init(g.M, g.N, G, bid);
                else if (ps == 1) {
                    g = pg8::Gemm{(const GAS bf16_t*)(ws + WS_MEMB), (const GAS bf16_t*)(ws + WS_WMEM), MEMROWS, 1024, 1024};
                    E.kind = EK_MEMKV; perm = true;
                    const int c2 = (bid >= 64 && bid < 128) ? bid - 64 : (1 << 20);
                    S.init(MEMROWS, 1024, 64, c2);
                } else {
                    g = pg8::Gemm{xb + (size_t)TG * DM, (const GAS bf16_t*)(ws + WS_WIN) + (size_t)(NWIN - 256) * 1024, TG, 256, 1024};
                    E.kind = EK_WIN; E.aux = 40; E.goff = TG; perm = true;
                    const int c3 = (bid >= 128 && bid < 192) ? bid - 128 : (1 << 20);
                    S.init(TG, 256, 64, c3);
                }
                pg8::gemm_phase<EpiAny>(lds, g, S, E, perm, tid);
            }
            if (npass == 3 && G >= 64 && bid >= G - 64) {
                __syncthreads();
                prepass(P, lds, (bid - (G - 64)) * 8 + wave, 512, wave, lane, 1);
            }
        }
        __syncthreads();
#ifndef REP_SYNC
#define REP_SYNC 1
#endif
#ifdef TS_PROBE
        if (step == 17) xcd_barrier(xbar);
        if (bid == 0 && tid == 0) { asm volatile("s_waitcnt vmcnt(0)" ::: "memory"); ((GAS unsigned long long*)(ws + WS_CTL + 32768))[step + 1] = __builtin_amdgcn_s_memrealtime(); }
        if (step == 17) {
            GAS unsigned long long* ts = (GAS unsigned long long*)(ws + WS_CTL + 32768);
            if (bid == 0 && tid == 0) {
                const unsigned long long a = ts[TS_A1] - ts[TS_A0], b = ts[TS_B1] - ts[TS_B0];
                unsigned ua = (unsigned)(a / 400ull), ub = (unsigned)(b / 400ull); if (ua > 191u) ua = 191u; if (ub > 191u) ub = 191u;
                __hip_atomic_store((GAS unsigned*)(ws + WS_CTL + 49152), 7u * (ua + 192u * ub), __ATOMIC_RELAXED, __HIP_MEMORY_SCOPE_AGENT);
            }
            xcd_barrier(xbar);
            const unsigned N = __hip_atomic_load((GAS unsigned*)(ws + WS_CTL + 49152), __ATOMIC_RELAXED, __HIP_MEMORY_SCOPE_AGENT);
            for (unsigned i = (unsigned)(bid * 512 + tid); i < N; i += (unsigned)(G * 512)) ((GAS float*)P->out)[(size_t)i * 97u] += 0.1f;
        }
#endif
        if (coop && do_sync && step + 1 < step_hi) { if (coop == 2) cg::this_grid().sync(); else { for (int rp = 0; rp < REP_SYNC; ++rp) xcd_barrier(xbar); } }
    }
}

extern "C" void kernel_launch(void* const* d_in, const int* in_sizes, int n_in, void* d_out, int out_size, void* d_ws, size_t ws_size, hipStream_t stream) {
    static int grid = 0;
    if (grid == 0) {
        if (n_in != 26 || ws_size < WS_END) { fprintf(stderr, "kernel_launch: unexpected n_in %d or ws_size %zu (need %zu)\n", n_in, ws_size, (size_t)WS_END); grid = -1; return; }
        int dev = 0, cus = 0, per_cu = 0;
        hipGetDevice(&dev); hipDeviceGetAttribute(&cus, hipDeviceAttributeMultiprocessorCount, dev);
        if (hipFuncSetAttribute((const void*)mega_fwd, hipFuncAttributeMaxDynamicSharedMemorySize, LDS_BYTES) != hipSuccess) { fprintf(stderr, "kernel_launch: hipFuncSetAttribute failed\n"); }
        hipOccupancyMaxActiveBlocksPerMultiprocessor(&per_cu, (const void*)mega_fwd, 512, LDS_BYTES);
        (void)hipGetLastError();
        if (per_cu < 1) per_cu = 1;
        grid = cus;
        fprintf(stderr, "kernel_launch: cus %d per_cu %d grid %d ws %zu\n", cus, per_cu, grid, ws_size);
    }
    if (grid < 0) return;
    hipMemsetAsync((char*)d_ws + WS_CTL, 0, 65536, stream);
    KP p{};
    const float** pp = (const float**)&p;
    for (int i = 0; i < 26; ++i) pp[i] = (const float*)d_in[i];
    p.out = (float*)d_out; p.ws = (unsigned char*)d_ws;
    int lo = 0, hi = 17, coop = 1;
    void* args[] = {&p, &lo, &hi, &coop};
    hipError_t e = hipLaunchCooperativeKernel((const void*)mega_fwd, dim3(grid), dim3(512), args, LDS_BYTES, stream);
    if (e != hipSuccess) fprintf(stderr, "cooperative launch failed: %s (grid %d)\n", hipGetErrorString(e), grid);
}
```

```cpp
#include <hip/hip_runtime.h>
#include <hip/hip_cooperative_groups.h>
#include <cstdio>
#include <cstdint>
namespace cg = cooperative_groups;

#define LAS __attribute__((address_space(3)))
#define GAS __attribute__((address_space(1)))
#define DI __device__ __forceinline__
typedef unsigned short bf16_t;
typedef short bf16x8 __attribute__((ext_vector_type(8)));
typedef short s16x4 __attribute__((ext_vector_type(4)));
typedef float f32x4 __attribute__((ext_vector_type(4)));
typedef float f32x16 __attribute__((ext_vector_type(16)));
typedef unsigned u32x4 __attribute__((ext_vector_type(4)));
typedef unsigned u32x2 __attribute__((ext_vector_type(2)));

constexpr int T_ = 32768, TG = 16384, NGRP = 2, BL = 8, S_ = 2048, DM = 1024, DFF = 2816, MEMROWS = 4096;
constexpr int NWIN = 10496, NIN = 10256;
constexpr float EPS = 1e-6f;
constexpr float NEGF = -1e30f;

constexpr size_t MiB = 1u << 20;
constexpr size_t WS_CTL = 0;
constexpr size_t WS_W1 = 1 * MiB, WS_W2 = 12 * MiB, WS_WIN = 18 * MiB, WS_WMEM = 39 * MiB, WS_WBR = 41 * MiB, WS_WOUT = 44 * MiB, WS_W3 = 46 * MiB, WS_W4 = 57 * MiB;
constexpr size_t WS_ROPE = 63 * MiB;
constexpr size_t WS_SSM = 63 * MiB + 512 * 1024;
constexpr size_t WS_PART = 64 * MiB;
constexpr size_t SS_STRIDE = 131072;
constexpr size_t WS_CKV = 66 * MiB;
constexpr size_t WS_XB = 74 * MiB;
constexpr size_t WS_ACT = 138 * MiB;
constexpr size_t WS_AQ = 138 * MiB, WS_AK = 186 * MiB, WS_AV = 234 * MiB;
constexpr size_t WS_MQ = 282 * MiB;
constexpr size_t WS_MK = 298 * MiB, WS_MV = 314 * MiB, WS_MO = 330 * MiB, WS_CQ = 346 * MiB;
constexpr size_t WS_GTS = 362 * MiB;
constexpr size_t WS_MIF1 = 494 * MiB;
constexpr size_t WS_MIF = 458 * MiB;
constexpr size_t WS_LSE = 459 * MiB;
constexpr size_t WS_HF = 461 * MiB, WS_HB = 477 * MiB;
constexpr size_t WS_MEMB = 461 * MiB;
constexpr size_t WS_YATT = 186 * MiB, WS_YML = 202 * MiB, WS_YCX = 218 * MiB;
constexpr size_t WS_M32 = 234 * MiB;
constexpr size_t WS_MB16 = 298 * MiB;
constexpr size_t WS_END = 495 * MiB;

constexpr int LDS_BYTES = 163840;
constexpr int MLP = 272;
constexpr int MLT = 320;
constexpr int TB_OFF = 2 * 128 * MLP + 2 * 128 * MLT;

DI unsigned pkbf(float lo, float hi) {
    typedef float f2 __attribute__((ext_vector_type(2))); typedef __bf16 b2 __attribute__((ext_vector_type(2)));
    f2 v = {lo, hi}; b2 b = __builtin_convertvector(v, b2); return __builtin_bit_cast(unsigned, b);
}
DI float frcp(float x) { return __builtin_amdgcn_rcpf(x); }
DI float frsq(float x) { return __builtin_amdgcn_rsqf(x); }
DI float bflo(unsigned u) { return __uint_as_float(u << 16); }
DI float bfhi(unsigned u) { return __uint_as_float(u & 0xffff0000u); }
DI float shx(float v, int k, int lane) { return __int_as_float(__builtin_amdgcn_ds_bpermute((lane ^ k) << 2, __float_as_int(v))); }
DI float shup(float v, int d, int lane) { return __int_as_float(__builtin_amdgcn_ds_bpermute((lane - d) << 2, __float_as_int(v))); }
DI float rdlane(float v, int l) { return __int_as_float(__builtin_amdgcn_readlane(__float_as_int(v), l)); }
#define SHX(v, k) shx((v), (k), lane)
DI float wave_sum_l(float v, int lane) {
#pragma unroll
    for (int o = 1; o < 64; o <<= 1) v += shx(v, o, lane);
    return v;
}
#define wave_sum(v) wave_sum_l((v), lane)
DI int crow(int i, int h) { return (i & 3) + 8 * (i >> 2) + 4 * h; }
DI f32x16 mfma32(bf16x8 a, bf16x8 b, f32x16 c) { return __builtin_amdgcn_mfma_f32_32x32x16_bf16(a, b, c, 0, 0, 0); }
DI bf16x8 pack8(const f32x16& x, int s) {
    u32x4 p;
    p.x = pkbf(x[8 * s + 0], x[8 * s + 1]); p.y = pkbf(x[8 * s + 2], x[8 * s + 3]);
    p.z = pkbf(x[8 * s + 4], x[8 * s + 5]); p.w = pkbf(x[8 * s + 6], x[8 * s + 7]);
    return __builtin_bit_cast(bf16x8, p);
}
DI f32x16 zero16() { f32x16 z; for (int i = 0; i < 16; ++i) z[i] = 0.f; return z; }
typedef short v4i16_t __attribute__((ext_vector_type(4)));
DI s16x4 trread(LAS unsigned char* p) { return __builtin_bit_cast(s16x4, __builtin_amdgcn_ds_read_tr16_b64_v4i16((LAS v4i16_t*)p)); }
DI bf16x8 cat44(s16x4 lo, s16x4 hi) { return (bf16x8){lo[0], lo[1], lo[2], lo[3], hi[0], hi[1], hi[2], hi[3]}; }
#define LDS_FENCE() asm volatile("s_waitcnt lgkmcnt(0)" ::: "memory")
DI float rstd_part(const GAS float* part, int row) { return frsq(part[row] * (1.0f / 1024.0f) + EPS); }
#define MEMFENCE() asm volatile("" ::: "memory")
#define LOAD_RS8(rsv, part, row0) float rsv[2][4]; _Pragma("unroll") for (int ai_ = 0; ai_ < 2; ++ai_) _Pragma("unroll") for (int m_ = 0; m_ < 4; ++m_) rsv[ai_][m_] = (part)[(row0) + ai_ * 128 + m_ * 16]; \
    _Pragma("unroll") for (int ai_ = 0; ai_ < 2; ++ai_) _Pragma("unroll") for (int m_ = 0; m_ < 4; ++m_) rsv[ai_][m_] = frsq(rsv[ai_][m_] * (1.0f / 1024.0f) + EPS)
DI float sigmoidf_(float v) { return frcp(1.0f + __expf(-v)); }

struct KP {
    const float* x; const float* mem; const float* norm_ffn1; const float* w_ffn1_in; const float* w_ffn1_out;
    const float* norm_mix; const float* norm_mem; const float* w_in; const float* att_q_gain; const float* att_k_gain;
    const float* ml_conv_w; const float* ml_conv_b; const float* ml_gate_b; const float* ml_out_gain;
    const float* cx_q_gain; const float* cx_k_gain; const float* w_mem_kv; const float* mix_gate_b;
    const float* w_br_att; const float* w_br_ml; const float* w_br_cx; const float* w_out;
    const float* norm_ffn2; const float* w_ffn2_in; const float* w_ffn2_out; const float* norm_final;
    float* out; unsigned char* ws;
};
typedef const KP __attribute__((address_space(4)))* KPC;

enum EpiKind { EK_SWIGLU = 0, EK_RESID = 1, EK_WIN = 2, EK_MEMKV = 3, EK_BR0 = 4 };
namespace pg8 {
constexpr int BM = 256, BK = 64, HALF = 128, HTB = HALF * BK * 2, STAGE_BYTES = 8 * HTB, NXCD = 8, WGM = 8;
DI int lds_byte(int r, int c) { const int st = (r >> 4) * 2 + (c >> 5), rr = r & 15, cc = c & 31, ob = rr * 64 + cc * 2; return st * 1024 + (ob ^ (((ob >> 9) & 1) << 5)); }
DI void stage_rc(int b, int& R, int& C) { const int st = b / 1024, sb = b % 1024, swz = sb ^ (((sb >> 9) & 1) << 5); R = (st >> 1) * 16 + swz / 64; C = (st & 1) * 32 + (swz % 64) / 2; }
DI int perm32(int rho) { const int n = rho >> 4, i = rho & 15; return 8 * (i >> 2) + 4 * n + (i & 3); }
struct Unit { int pm, pn; };
struct Gemm { const GAS bf16_t* A; const GAS bf16_t* Bt; int M, N, K; };
struct StaticOrder {
    int nM, nN, nwg, G, c;
    DI void init(int M, int N, int G_, int c_) { nM = M / BM; nN = N / BM; nwg = nM * nN; G = G_; c = c_; }
    DI bool next(int i, Unit& u) const {
        const long L = (long)i * G + c; if (L >= nwg) return false;
        int wgid = (int)L; { const int q = nwg / NXCD, r = nwg % NXCD, xcd = wgid % NXCD, off = wgid / NXCD; wgid = (xcd < r ? xcd * (q + 1) : r * (q + 1) + (xcd - r) * q) + off; }
        const int nig = WGM * nN, gid = wgid / nig, fm = gid * WGM, gsz = (nM - fm) < WGM ? (nM - fm) : WGM;
        u.pm = fm + ((wgid % nig) % gsz); u.pn = (wgid % nig) / gsz; return true;
    }
};
template <class Epi>
DI void gemm_phase(LAS unsigned char* lds, const Gemm g, const StaticOrder& S, const Epi& E, const bool perm, const int tid) {
    const int wid = __builtin_amdgcn_readfirstlane(tid >> 6), lane = tid & 63, wr = wid >> 2, wc = wid & 3, fr = lane & 15, fq = lane >> 4;
    const int K = g.K, nt = K / BK;
    unsigned voffA[2], voffB[2];
#pragma unroll
    for (int i = 0; i < 2; ++i) { int R, C; stage_rc(tid * 16 + i * 8192, R, C); const int Rb = perm ? ((R & ~31) + perm32(R & 31)) : R;
        voffA[i] = (unsigned)(R * K + C) * 2u; voffB[i] = (unsigned)(Rb * K + C) * 2u; }
    const size_t kstep = (size_t)(BK * 2);
    const size_t hstep = (size_t)HALF * K * 2;
    const size_t tstep = 2 * hstep;
    const unsigned ldsw = (unsigned)wid * 1024u;
    const int aoff = lds_byte(wr * 64 + fr, fq * 8), boff = lds_byte(wc * 32 + fr, fq * 8);
#define PG8_SA(b, h) (((b) * 2 + (h)) * HTB)
#define PG8_SB(b, h) ((4 + (b) * 2 + (h)) * HTB)
#define PG8_STAGE(bufoff, gbase, voff) do { _Pragma("unroll") for (int _i = 0; _i < 2; ++_i) \
        __builtin_amdgcn_global_load_lds((const GAS unsigned*)((const char*)(gbase) + (voff)[_i]), (LAS unsigned*)(lds + (bufoff) + ldsw + _i * 8192), 16, 0, 0); } while (0)
#define PG8_LDA(dst, b, h) do { _Pragma("unroll") for (int m = 0; m < 4; ++m) _Pragma("unroll") for (int k = 0; k < 2; ++k) dst[m][k] = *(const LAS bf16x8*)(lds + PG8_SA(b, h) + aoff + m * 2048 + k * 1024); } while (0)
#define PG8_LDB(dst, b, h) do { _Pragma("unroll") for (int n = 0; n < 2; ++n) _Pragma("unroll") for (int k = 0; k < 2; ++k) dst[n][k] = *(const LAS bf16x8*)(lds + PG8_SB(b, h) + boff + n * 2048 + k * 1024); } while (0)
#define PG8_MMA(ai, bj, At, Bt) do { __builtin_amdgcn_s_setprio(1); _Pragma("unroll") for (int m = 0; m < 4; ++m) _Pragma("unroll") for (int n = 0; n < 2; ++n) _Pragma("unroll") for (int k = 0; k < 2; ++k) \
        acc[ai][bj][m][n] = __builtin_amdgcn_mfma_f32_16x16x32_bf16(Bt[n][k], At[m][k], acc[ai][bj][m][n], 0, 0, 0); __builtin_amdgcn_s_setprio(0); } while (0)
#define PG8_WAIT_V(n) asm volatile("s_waitcnt vmcnt(" #n ")" ::: "memory")
#define PG8_WAIT_L(n) asm volatile("s_waitcnt lgkmcnt(" #n ")" ::: "memory")
#define PG8_BAR __builtin_amdgcn_s_barrier()
#define PG8_SCHED __builtin_amdgcn_sched_barrier(0)
    Unit cur, nxt; int ui = 0;
    if (!S.next(0, cur)) return;
    f32x4 acc[2][2][4][2];
#pragma unroll
    for (int a = 0; a < 2; ++a)
#pragma unroll
        for (int b = 0; b < 2; ++b)
#pragma unroll
            for (int m = 0; m < 4; ++m)
#pragma unroll
                for (int n = 0; n < 2; ++n) acc[a][b][m][n] = (f32x4){0.f, 0.f, 0.f, 0.f};
    bf16x8 At[4][2], B0[2][2], B1[2][2];
    const char* cA = (const char*)g.A + (size_t)cur.pm * tstep; const char* cB = (const char*)g.Bt + (size_t)cur.pn * tstep;
    {
        PG8_STAGE(PG8_SB(0, 0), cB, voffB); PG8_STAGE(PG8_SB(0, 1), cB + hstep, voffB); PG8_STAGE(PG8_SA(0, 0), cA, voffA); PG8_STAGE(PG8_SA(0, 1), cA + hstep, voffA);
        if (wr == 1) PG8_BAR;
        PG8_WAIT_V(2); PG8_BAR;
        PG8_STAGE(PG8_SB(1, 0), cB + kstep, voffB); PG8_STAGE(PG8_SA(1, 0), cA + kstep, voffA); PG8_STAGE(PG8_SB(1, 1), cB + hstep + kstep, voffB);
        PG8_WAIT_V(6); PG8_BAR;
    }
    for (;;) {
        const bool has_next = S.next(ui + 1, nxt);
        const char* nA = has_next ? (const char*)g.A + (size_t)nxt.pm * tstep : cA; const char* nB = has_next ? (const char*)g.Bt + (size_t)nxt.pn * tstep : cB;
        for (int t = 0; t < nt; t += 2) {
            const bool last = (t == nt - 2);
            const char* a1 = cA + (size_t)(t + 1) * kstep;
            const char* a2 = last ? nA : cA + (size_t)(t + 2) * kstep; const char* b2 = last ? nB : cB + (size_t)(t + 2) * kstep;
            const char* a3 = a2 + kstep; const char* b3 = b2 + kstep;
            PG8_LDB(B0, 0, 0); PG8_LDB(B1, 0, 1); PG8_SCHED; PG8_LDA(At, 0, 0); PG8_STAGE(PG8_SA(1, 1), a1 + hstep, voffA);
            PG8_WAIT_V(8); PG8_WAIT_L(0); PG8_BAR; PG8_MMA(0, 0, At, B0); PG8_MMA(0, 1, At, B1); PG8_BAR; PG8_SCHED;
            PG8_LDA(At, 0, 1); PG8_STAGE(PG8_SB(0, 0), b2, voffB); PG8_STAGE(PG8_SB(0, 1), b2 + hstep, voffB); PG8_STAGE(PG8_SA(0, 0), a2, voffA);
            PG8_WAIT_V(8); PG8_WAIT_L(0); PG8_BAR; PG8_MMA(1, 0, At, B0); PG8_MMA(1, 1, At, B1); PG8_BAR; PG8_SCHED;
            PG8_LDB(B0, 1, 0); PG8_LDB(B1, 1, 1); PG8_SCHED; PG8_LDA(At, 1, 0); PG8_STAGE(PG8_SA(0, 1), a2 + hstep, voffA);
            PG8_WAIT_V(8); PG8_WAIT_L(0); PG8_BAR; PG8_MMA(0, 0, At, B0); PG8_MMA(0, 1, At, B1); PG8_BAR; PG8_SCHED;
            PG8_LDA(At, 1, 1); PG8_STAGE(PG8_SB(1, 0), b3, voffB); PG8_STAGE(PG8_SB(1, 1), b3 + hstep, voffB); PG8_STAGE(PG8_SA(1, 0), a3, voffA);
            PG8_WAIT_V(8); PG8_WAIT_L(0); PG8_BAR; PG8_MMA(1, 0, At, B0); PG8_MMA(1, 1, At, B1); PG8_BAR; PG8_SCHED;
            if (E.kind == EK_BR0 && (t == 6 || t == 14)) { E.hook(acc, cur, t == 6 ? 0 : 1, wr, wc, fr, fq); PG8_SCHED; }
        }
        if (wr == 0) PG8_BAR;
        E(acc, cur, wr, wc, fr, fq);
        if (!has_next) break;
#pragma unroll
        for (int a = 0; a < 2; ++a)
#pragma unroll
            for (int b = 0; b < 2; ++b)
#pragma unroll
                for (int m = 0; m < 4; ++m)
#pragma unroll
                    for (int n = 0; n < 2; ++n) acc[a][b][m][n] = (f32x4){0.f, 0.f, 0.f, 0.f};
        cur = nxt; cA = nA; cB = nB; ++ui;
        if (wr == 1) PG8_BAR;
    }
    PG8_WAIT_V(0);
    PG8_BAR;
#undef PG8_SA
#undef PG8_SB
#undef PG8_STAGE
#undef PG8_LDA
#undef PG8_LDB
#undef PG8_MMA
#undef PG8_WAIT_V
#undef PG8_WAIT_L
#undef PG8_BAR
#undef PG8_SCHED
}
}

typedef const f32x4 (&AccRef)[2][2][4][2];

struct EpiAny {
    int kind, aux, goff;
    GAS unsigned char* ws; KPC kp;

    DI void swiglu(AccRef acc, const pg8::Unit& u, int wr, int wc, int fr, int fq) const {
        const int lane = fr | (fq << 4); (void)lane;
        const int row0 = u.pm * 256 + wr * 64 + fr, col = u.pn * 128 + wc * 32 + 8 * fq;
        const GAS float* part = (const GAS float*)(ws + WS_PART + (aux ? 2 * SS_STRIDE : 0)); GAS bf16_t* xb = (GAS bf16_t*)(ws + WS_ACT);
        LOAD_RS8(rsv, part, row0);
#pragma unroll
        for (int ai = 0; ai < 2; ++ai)
#pragma unroll
            for (int m = 0; m < 4; ++m) {
                const int row = row0 + ai * 128 + m * 16; const float rs = rsv[ai][m];
                float o[8];
#pragma unroll
                for (int n = 0; n < 2; ++n)
#pragma unroll
                    for (int j = 0; j < 4; ++j) { const float gt = acc[ai][0][m][n][j] * rs, up = acc[ai][1][m][n][j] * rs; o[4 * n + j] = gt * sigmoidf_(gt) * up; }
                u32x4 w; w.x = pkbf(o[0], o[1]); w.y = pkbf(o[2], o[3]); w.z = pkbf(o[4], o[5]); w.w = pkbf(o[6], o[7]);
                *(GAS u32x4*)(xb + (size_t)row * DFF + col) = w;
                if (m & 1) MEMFENCE();
            }
    }
    DI void residual(AccRef acc, const pg8::Unit& u, int wr, int wc, int fr, int fq) const {
        const int lane = fr | (fq << 4); (void)lane;
        const int row0 = goff + u.pm * 256 + wr * 64 + fr, c0 = u.pn * 256 + wc * 32 + 4 * fq;
        const GAS float* resid = ((const GAS float*)kp->x); GAS bf16_t* xb = (GAS bf16_t*)(ws + WS_XB);
        GAS float* partw = (GAS float*)(ws + WS_PART + (size_t)(aux + 1) * SS_STRIDE); const float scale = aux == 1 ? 1.0f : 0.5f;
#pragma unroll
        for (int ai = 0; ai < 2; ++ai) {
            if (aux == 0) {
#pragma unroll
                for (int mh = 0; mh < 2; ++mh) {
                    f32x4 r[2][2][2];
#pragma unroll
                    for (int m2 = 0; m2 < 2; ++m2)
#pragma unroll
                        for (int bj = 0; bj < 2; ++bj)
#pragma unroll
                            for (int n = 0; n < 2; ++n) r[m2][bj][n] = *(const GAS f32x4*)(resid + (size_t)(row0 + ai * 128 + (2 * mh + m2) * 16) * DM + c0 + bj * 128 + n * 16);
#pragma unroll
                    for (int m2 = 0; m2 < 2; ++m2) {
                        const int m = 2 * mh + m2; const int row = row0 + ai * 128 + m * 16; float ssq = 0.f;
#pragma unroll
                        for (int bj = 0; bj < 2; ++bj)
#pragma unroll
                            for (int n = 0; n < 2; ++n) {
                                const f32x4 v = r[m2][bj][n] + acc[ai][bj][m][n] * scale;
                                u32x2 w; w.x = pkbf(v.x, v.y); w.y = pkbf(v.z, v.w); *(GAS u32x2*)(xb + (size_t)row * DM + c0 + bj * 128 + n * 16) = w;
                                ssq += (v.x * v.x + v.y * v.y) + (v.z * v.z + v.w * v.w);
                            }
                        ssq += SHX(ssq, 16); ssq += SHX(ssq, 32);
                        if (fq == 0) unsafeAtomicAdd((float*)(partw + row), ssq);
                    }
                    MEMFENCE();
                }
            } else {
                u32x2 rb[4][2][2];
#pragma unroll
                for (int m = 0; m < 4; ++m)
#pragma unroll
                    for (int bj = 0; bj < 2; ++bj)
#pragma unroll
                        for (int n = 0; n < 2; ++n) rb[m][bj][n] = *(const GAS u32x2*)(xb + (size_t)(row0 + ai * 128 + m * 16) * DM + c0 + bj * 128 + n * 16);
#pragma unroll
                for (int m = 0; m < 4; ++m) {
                    const int row = row0 + ai * 128 + m * 16; float ssq = 0.f;
#pragma unroll
                    for (int bj = 0; bj < 2; ++bj)
#pragma unroll
                        for (int n = 0; n < 2; ++n) {
                            const u32x2 q = rb[m][bj][n];
                            const f32x4 v = (f32x4){bflo(q.x), bfhi(q.x), bflo(q.y), bfhi(q.y)} + acc[ai][bj][m][n] * scale;
                            u32x2 w; w.x = pkbf(v.x, v.y); w.y = pkbf(v.z, v.w); *(GAS u32x2*)(xb + (size_t)row * DM + c0 + bj * 128 + n * 16) = w;
                            ssq += (v.x * v.x + v.y * v.y) + (v.z * v.z + v.w * v.w);
                        }
                    ssq += SHX(ssq, 16); ssq += SHX(ssq, 32);
                    if (fq == 0) unsafeAtomicAdd((float*)(partw + row), ssq);
                }
                MEMFENCE();
            }
        }
    }
    DI void memkv(AccRef acc, const pg8::Unit& u, int wr, int wc, int fr, int fq) const {
        const int lane = fr | (fq << 4); (void)lane;
        const int row0 = u.pm * 256 + wr * 64 + fr, c0 = u.pn * 256 + wc * 32 + 8 * fq;
        const GAS float* part = (const GAS float*)(ws + WS_SSM); GAS bf16_t* xb = (GAS bf16_t*)(ws + WS_CKV);
        LOAD_RS8(rsv, part, row0);
#pragma unroll
        for (int ai = 0; ai < 2; ++ai)
#pragma unroll
            for (int m = 0; m < 4; ++m) {
                const int row = row0 + ai * 128 + m * 16; const float rs = rsv[ai][m];
#pragma unroll
                for (int bj = 0; bj < 2; ++bj) {
                    const f32x4 a = acc[ai][bj][m][0] * rs, b = acc[ai][bj][m][1] * rs;
                    u32x4 w; w.x = pkbf(a.x, a.y); w.y = pkbf(a.z, a.w); w.z = pkbf(b.x, b.y); w.w = pkbf(b.z, b.w);
                    *(GAS u32x4*)(xb + (size_t)row * 1024 + c0 + bj * 128) = w;
                }
            }
    }
    DI void hook(f32x4 (&acc)[2][2][4][2], const pg8::Unit& u, int seg, int wr, int wc, int fr, int fq) const {
        asm volatile("" : "+v"(fr), "+v"(fq));
        const int row0 = u.pm * 256 + wr * 64 + fr, c0 = u.pn * 256 + wc * 32 + 4 * fq;
        const GAS bf16_t* gts = (const GAS bf16_t*)(ws + WS_GTS) + seg * 1024 + (size_t)row0 * 3072 + c0; const GAS float* gbias = ((const GAS float*)kp->mix_gate_b) + seg * 1024 + c0;
#pragma unroll
        for (int bj = 0; bj < 2; ++bj)
#pragma unroll
            for (int n = 0; n < 2; ++n) {
                u32x2 w0[2][4], w1[2][4];
#pragma unroll
                for (int ai = 0; ai < 2; ++ai)
#pragma unroll
                    for (int m = 0; m < 4; ++m) {
                        const GAS bf16_t* gr = gts + (size_t)(ai * 128 + m * 16) * 3072 + bj * 128 + n * 16;
                        w0[ai][m] = *(const GAS u32x2*)gr; w1[ai][m] = *(const GAS u32x2*)(gr + 1024);
                    }
                const f32x4 b0 = *(const GAS f32x4*)(gbias + bj * 128 + n * 16), b1 = *(const GAS f32x4*)(gbias + 1024 + bj * 128 + n * 16);
#pragma unroll
                for (int ai = 0; ai < 2; ++ai)
#pragma unroll
                    for (int m = 0; m < 4; ++m) {
                        const u32x2 a0 = w0[ai][m], a1 = w1[ai][m];
                        f32x4 rt;
                        rt.x = (1.0f + __expf(-(bflo(a1.x) + b1.x))) * frcp(1.0f + __expf(-(bflo(a0.x) + b0.x)));
                        rt.y = (1.0f + __expf(-(bfhi(a1.x) + b1.y))) * frcp(1.0f + __expf(-(bfhi(a0.x) + b0.y)));
                        rt.z = (1.0f + __expf(-(bflo(a1.y) + b1.z))) * frcp(1.0f + __expf(-(bflo(a0.y) + b0.z)));
                        rt.w = (1.0f + __expf(-(bfhi(a1.y) + b1.w))) * frcp(1.0f + __expf(-(bfhi(a0.y) + b0.w)));
                        acc[ai][bj][m][n] = acc[ai][bj][m][n] * rt;
                    }
                MEMFENCE();
            }
    }
    DI void branch_final(AccRef acc, const pg8::Unit& u, int wr, int wc, int fr, int fq) const {
        const int lane = fr | (fq << 4); (void)lane;
        const int row0 = u.pm * 256 + wr * 64 + fr, c0 = u.pn * 256 + wc * 32 + 4 * fq;
        const GAS bf16_t* gts = (const GAS bf16_t*)(ws + WS_GTS) + 2048 + (size_t)row0 * 3072 + c0; const GAS float* gbias = ((const GAS float*)kp->mix_gate_b) + 2048 + c0;
        GAS bf16_t* mb16 = (GAS bf16_t*)((GAS unsigned char*)((GAS float*)kp->out) + 32 * MiB) + (size_t)(goff + row0) * DM + c0;
#pragma unroll
        for (int bj = 0; bj < 2; ++bj) {
            u32x2 gw[2][4][2];
#pragma unroll
            for (int ai = 0; ai < 2; ++ai)
#pragma unroll
                for (int m = 0; m < 4; ++m)
#pragma unroll
                    for (int n = 0; n < 2; ++n) gw[ai][m][n] = *(const GAS u32x2*)(gts + (size_t)(ai * 128 + m * 16) * 3072 + bj * 128 + n * 16);
#pragma unroll
            for (int n = 0; n < 2; ++n) {
                const f32x4 gb = *(const GAS f32x4*)(gbias + bj * 128 + n * 16);
#pragma unroll
                for (int ai = 0; ai < 2; ++ai)
#pragma unroll
                    for (int m = 0; m < 4; ++m) {
                        const u32x2 g2 = gw[ai][m][n];
                        f32x4 gv; gv.x = sigmoidf_(bflo(g2.x) + gb.x); gv.y = sigmoidf_(bfhi(g2.x) + gb.y); gv.z = sigmoidf_(bflo(g2.y) + gb.z); gv.w = sigmoidf_(bfhi(g2.y) + gb.w);
                        const f32x4 v = gv * acc[ai][bj][m][n];
                        u32x2 w; w.x = pkbf(v.x, v.y); w.y = pkbf(v.z, v.w); *(GAS u32x2*)(mb16 + (size_t)(ai * 128 + m * 16) * DM + bj * 128 + n * 16) = w;
                    }
            }
            MEMFENCE();
        }
    }
    DI void win(AccRef acc, const pg8::Unit& u, int wr, int wc, int fr, int fq) const {
        const int lane = fr | (fq << 4); (void)lane;
        const int row0 = u.pm * 256 + wr * 64 + fr; const int pn = u.pn + aux;
        const GAS float* part = (const GAS float*)(ws + WS_PART + SS_STRIDE) + goff;
        if (pn < 12) {
            const int isk = pn >= 6 ? 1 : 0; const int hh = 4 * (pn - 6 * isk) + wc; const int gi = hh >> 3, sh = 2 * gi;
            const GAS float* gain = isk ? ((const GAS float*)kp->att_k_gain) : ((const GAS float*)kp->att_q_gain); const float qs = isk ? 1.0f : 0.125f;
            GAS bf16_t* dst = (GAS bf16_t*)(ws + (isk ? WS_AK : WS_AQ));
            const GAS float* rc = (const GAS float*)(ws + WS_ROPE); const GAS float* rsn = rc + 2048 * 32;
#pragma unroll
            for (int ai = 0; ai < 2; ++ai)
#pragma unroll
                for (int m = 0; m < 4; ++m) {
                    const int row = row0 + ai * 128 + m * 16; const float rs = rstd_part(part, row);
                    const int bl = row >> 11, s = row & 2047;
                    float ss = 0.f;
#pragma unroll
                    for (int bj = 0; bj < 2; ++bj)
#pragma unroll
                        for (int n = 0; n < 2; ++n) { const f32x4 v = acc[ai][bj][m][n]; ss += (v.x * v.x + v.y * v.y) + (v.z * v.z + v.w * v.w); }
                    ss *= rs * rs;
                    ss += SHX(ss, 16); ss += SHX(ss, 32);
                    const float rh = rs * qs * frsq(ss * (1.0f / 64.0f) + EPS);
                    const int perm = ((s & ((1 << sh) - 1)) << (11 - sh)) + (s >> sh);
                    GAS bf16_t* d = dst + ((size_t)(bl * 24 + hh) * 2048 + perm) * 64 + 8 * fq;
                    u32x2 w1[2], w2[2];
#pragma unroll
                    for (int n = 0; n < 2; ++n) {
                        const f32x4 ga = *(const GAS f32x4*)(gain + 8 * fq + 4 * n), gb = *(const GAS f32x4*)(gain + 32 + 8 * fq + 4 * n);
                        const f32x4 c = *(const GAS f32x4*)(rc + s * 32 + 8 * fq + 4 * n), sn = *(const GAS f32x4*)(rsn + s * 32 + 8 * fq + 4 * n);
                        const f32x4 v1 = acc[ai][0][m][n] * ga * rh, v2 = acc[ai][1][m][n] * gb * rh;
                        const f32x4 o1 = v1 * c - v2 * sn, o2 = v2 * c + v1 * sn;
                        w1[n].x = pkbf(o1.x, o1.y); w1[n].y = pkbf(o1.z, o1.w);
                        w2[n].x = pkbf(o2.x, o2.y); w2[n].y = pkbf(o2.z, o2.w);
                    }
                    *(GAS u32x4*)d = (u32x4){w1[0].x, w1[0].y, w1[1].x, w1[1].y}; *(GAS u32x4*)(d + 32) = (u32x4){w2[0].x, w2[0].y, w2[1].x, w2[1].y};
                    MEMFENCE();
                }
        } else if (pn < 18) {
            LOAD_RS8(rsv, part, row0);
            GAS bf16_t* dst = (GAS bf16_t*)(ws + WS_AV);
#pragma unroll
            for (int bj = 0; bj < 2; ++bj) {
                const int hh = 4 * (pn - 12) + 2 * bj + (wc >> 1), d0 = 32 * (wc & 1) + 8 * fq; const int gi = hh >> 3, sh = 2 * gi;
#pragma unroll
                for (int ai = 0; ai < 2; ++ai)
#pragma unroll
                    for (int m = 0; m < 4; ++m) {
                        const int row = row0 + ai * 128 + m * 16; const float rs = rsv[ai][m];
                        const int bl = row >> 11, s = row & 2047;
                        const int perm = ((s & ((1 << sh) - 1)) << (11 - sh)) + (s >> sh);
                        const f32x4 a = acc[ai][bj][m][0] * rs, b = acc[ai][bj][m][1] * rs;
                        u32x4 w; w.x = pkbf(a.x, a.y); w.y = pkbf(a.z, a.w); w.z = pkbf(b.x, b.y); w.w = pkbf(b.z, b.w);
                        *(GAS u32x4*)(dst + ((size_t)(bl * 24 + hh) * 2048 + perm) * 64 + d0) = w;
                        if (m & 1) MEMFENCE();
                    }
            }
        } else if (pn < 40) {
            LOAD_RS8(rsv, part, row0);
            GAS bf16_t* dst; int ld, colt;
            if (pn < 28) { const int seg = (pn - 18) >> 1; dst = (GAS bf16_t*)(ws + WS_MQ) + (size_t)seg * TG * 512; ld = 512; colt = 256 * ((pn - 18) & 1); }
            else { dst = (GAS bf16_t*)(ws + WS_GTS); ld = 3072; colt = 256 * (pn - 28); }
            const int c0 = colt + wc * 32 + 8 * fq;
#pragma unroll
            for (int ai = 0; ai < 2; ++ai)
#pragma unroll
                for (int m = 0; m < 4; ++m) {
                    const int row = row0 + ai * 128 + m * 16; const float rs = rsv[ai][m];
#pragma unroll
                    for (int bj = 0; bj < 2; ++bj) {
                        const f32x4 a = acc[ai][bj][m][0] * rs, b = acc[ai][bj][m][1] * rs;
                        u32x4 w; w.x = pkbf(a.x, a.y); w.y = pkbf(a.z, a.w); w.z = pkbf(b.x, b.y); w.w = pkbf(b.z, b.w);
                        *(GAS u32x4*)(dst + (size_t)row * ld + c0 + bj * 128) = w;
                    }
                    if (m & 1) MEMFENCE();
                }
        } else {
            if (wc == 0 && fq < 2) {
                LOAD_RS8(rsv, part, row0);
                GAS float* dst = (GAS float*)(ws + (goff ? WS_MIF1 : WS_MIF));
#pragma unroll
                for (int ai = 0; ai < 2; ++ai)
#pragma unroll
                    for (int m = 0; m < 4; ++m) {
                        const int row = row0 + ai * 128 + m * 16; const float rs = rsv[ai][m];
                        *(GAS f32x4*)(dst + (size_t)row * 16 + 8 * fq) = acc[ai][0][m][0] * rs;
                        *(GAS f32x4*)(dst + (size_t)row * 16 + 8 * fq + 4) = acc[ai][0][m][1] * rs;
                    }
            }
        }
    }
    DI void operator()(AccRef acc, const pg8::Unit& u, int wr, int wc, int fr, int fq) const {
        asm volatile("" : "+v"(fr), "+v"(fq));
        switch (kind) {
#ifndef NO_E0
            case EK_SWIGLU: swiglu(acc, u, wr, wc, fr, fq); break;
#endif
#ifndef NO_E1
            case EK_RESID: residual(acc, u, wr, wc, fr, fq); break;
#endif
#ifndef NO_E2
            case EK_WIN: win(acc, u, wr, wc, fr, fq); break;
#endif
#ifndef NO_E3
            case EK_MEMKV: memkv(acc, u, wr, wc, fr, fq); break;
#endif
#ifndef NO_E4
            default: branch_final(acc, u, wr, wc, fr, fq); break;
#else
            default: break;
#endif
        }
    }
};

DI int colmap(int mk, int n) {
    if (mk == 0) return n;
    if (mk == 1) { const int pn = n >> 8, bj = (n >> 7) & 1, i0 = n & 127; return bj * DFF + 128 * pn + i0; }
    const int pn = n >> 8, within = n & 255, bj = within >> 7, wc = (within >> 5) & 3, i = within & 31;
    if (pn < 12) { const int seg = pn >= 6 ? 1 : 0; const int hh = 4 * (pn - 6 * seg) + wc; return seg * 1536 + 64 * hh + 32 * bj + i; }
    if (pn < 18) return 3072 + (n - 12 * 256);
    if (pn < 26) return 4608 + (n - 18 * 256);
    if (pn < 28) return 6672 + (n - 26 * 256);
    if (pn < 40) return 7184 + (n - 28 * 256);
    return n < 10256 ? 6656 + (n - 10240) : -1;
}
DI void tr_item64(const GAS float* __restrict__ W, int ldw, int mk, const GAS float* __restrict__ gain, GAS bf16_t* Bt, int K, int n0, int k0, LAS float* scr, int lane) {
    const int nl = (lane & 15) * 4, kr = lane >> 4;
    const int src = colmap(mk, n0 + nl);
    f32x4 v[16];
#pragma unroll
    for (int i = 0; i < 16; ++i) {
        const int k = k0 + kr + 4 * i; v[i] = (f32x4){0.f, 0.f, 0.f, 0.f};
        if (src >= 0) { v[i] = __builtin_nontemporal_load((const GAS f32x4*)(W + (size_t)k * ldw + src)); if (gain) v[i] = v[i] * gain[k]; }
    }
#pragma unroll
    for (int i = 0; i < 16; ++i) { LAS float* d = scr + (kr + 4 * i) * 65 + nl; d[0] = v[i].x; d[1] = v[i].y; d[2] = v[i].z; d[3] = v[i].w; }
    LDS_FENCE();
    const int c = lane & 7;
#pragma unroll
    for (int j = 0; j < 8; ++j) {
        const int n = (lane >> 3) + 8 * j; const LAS float* sp = scr + (8 * c) * 65 + n;
        u32x4 o; o.x = pkbf(sp[0 * 65], sp[1 * 65]); o.y = pkbf(sp[2 * 65], sp[3 * 65]); o.z = pkbf(sp[4 * 65], sp[5 * 65]); o.w = pkbf(sp[6 * 65], sp[7 * 65]);
        *(GAS u32x4*)(Bt + (size_t)(n0 + n) * K + k0 + 8 * c) = o;
    }
    LDS_FENCE();
}
DI void prepass(KPC P, LAS unsigned char* lds, int gw, int NGW, int wave, int lane) {
    LAS float* scr = (LAS float*)(lds + wave * 16640);
    GAS unsigned char* ws = ((GAS unsigned char*)P->ws);
    constexpr int I1 = 16 * 88, I2 = 44 * 16, I3 = 16 * 164, I4 = 16 * 16, I5 = 8 * 16, I6 = 16 * 16;
    constexpr int NIT = I1 + I2 + I3 + I4 + 3 * I5 + I6 + I1 + I2;
    for (int it = gw; it < NIT; it += NGW) {
        int r = it;
        if (r < I1) { const int kb = r / 88, nb = r % 88; tr_item64(((const GAS float*)P->w_ffn1_in), 2 * DFF, 1, ((const GAS float*)P->norm_ffn1), (GAS bf16_t*)(ws + WS_W1), 1024, 64 * nb, 64 * kb, scr, lane); continue; } r -= I1;
        if (r < I2) { const int kb = r / 16, nb = r % 16; tr_item64(((const GAS float*)P->w_ffn1_out), 1024, 0, nullptr, (GAS bf16_t*)(ws + WS_W2), DFF, 64 * nb, 64 * kb, scr, lane); continue; } r -= I2;
        if (r < I3) { const int kb = r / 164, nb = r % 164; tr_item64(((const GAS float*)P->w_in), NIN, 2, ((const GAS float*)P->norm_mix), (GAS bf16_t*)(ws + WS_WIN), 1024, 64 * nb, 64 * kb, scr, lane); continue; } r -= I3;
        if (r < I4) { const int kb = r / 16, nb = r % 16; tr_item64(((const GAS float*)P->w_mem_kv), 1024, 0, ((const GAS float*)P->norm_mem), (GAS bf16_t*)(ws + WS_WMEM), 1024, 64 * nb, 64 * kb, scr, lane); continue; } r -= I4;
        if (r < 3 * I5) { const int b = r / I5, q = r % I5, kb = q / 16, nb = q % 16; const GAS float* w = b == 0 ? ((const GAS float*)P->w_br_att) : (b == 1 ? ((const GAS float*)P->w_br_ml) : ((const GAS float*)P->w_br_cx));
            tr_item64(w, 1024, 0, nullptr, (GAS bf16_t*)(ws + WS_WBR) + (size_t)b * 512, 1536, 64 * nb, 64 * kb, scr, lane); continue; } r -= 3 * I5;
        if (r < I6) { const int kb = r / 16, nb = r % 16; tr_item64(((const GAS float*)P->w_out), 1024, 0, nullptr, (GAS bf16_t*)(ws + WS_WOUT), 1024, 64 * nb, 64 * kb, scr, lane); continue; } r -= I6;
        if (r < I1) { const int kb = r / 88, nb = r % 88; tr_item64(((const GAS float*)P->w_ffn2_in), 2 * DFF, 1, ((const GAS float*)P->norm_ffn2), (GAS bf16_t*)(ws + WS_W3), 1024, 64 * nb, 64 * kb, scr, lane); continue; } r -= I1;
        { const int kb = r / 16, nb = r % 16; tr_item64(((const GAS float*)P->w_ffn2_out), 1024, 0, nullptr, (GAS bf16_t*)(ws + WS_W4), DFF, 64 * nb, 64 * kb, scr, lane); }
    }
    GAS bf16_t* xb = (GAS bf16_t*)(ws + WS_XB); GAS float* part = (GAS float*)(ws + WS_PART);
    GAS bf16_t* memb = (GAS bf16_t*)(ws + WS_MEMB); GAS float* ssm = (GAS float*)(ws + WS_SSM);
    for (int m4 = gw; m4 < (T_ + MEMROWS) / 4; m4 += NGW) {
        const bool isx = m4 < T_ / 4; const int row0 = isx ? 4 * m4 : 4 * m4 - T_;
        const GAS f32x4* xr = (const GAS f32x4*)((isx ? ((const GAS float*)P->x) : ((const GAS float*)P->mem)) + (size_t)row0 * DM) + lane;
        GAS unsigned long long* o8 = (GAS unsigned long long*)((isx ? xb : memb) + (size_t)row0 * DM) + lane;
        f32x4 v[4][4];
#pragma unroll
        for (int rr = 0; rr < 4; ++rr)
#pragma unroll
            for (int j = 0; j < 4; ++j) v[rr][j] = __builtin_nontemporal_load(xr + rr * 256 + 64 * j);
#pragma unroll
        for (int rr = 0; rr < 4; ++rr) {
            float sq = 0.f;
#pragma unroll
            for (int j = 0; j < 4; ++j) { const f32x4 t = v[rr][j]; sq += (t.x * t.x + t.y * t.y) + (t.z * t.z + t.w * t.w);
                o8[rr * 256 + 64 * j] = (unsigned long long)pkbf(t.x, t.y) | ((unsigned long long)pkbf(t.z, t.w) << 32); }
            sq = wave_sum(sq);
            const int row = row0 + rr;
            if (isx) { if (lane < 4) part[(size_t)lane * (SS_STRIDE / 4) + row] = lane == 0 ? sq : 0.f; }
            else if (lane == 0) ssm[row] = sq;
        }
    }
    GAS float* rc = (GAS float*)(ws + WS_ROPE); GAS float* rsn = rc + 2048 * 32;
    for (int i = gw * 64 + lane; i < 2048 * 32; i += NGW * 64) {
        const int sq = i >> 5, d = i & 31; const float inv = powf(10000.0f, -(float)(2 * d) / 64.0f); const float ang = (float)sq * inv;
        rc[i] = cosf(ang); rsn[i] = sinf(ang);
    }
}

DI void cknorm(KPC P, int gw, int NGW, int lane) {
    GAS bf16_t* ckv = (GAS bf16_t*)(((GAS unsigned char*)P->ws) + WS_CKV);
    for (int it = gw; it < MEMROWS * 4; it += NGW) {
        const int row = it >> 2, hd = it & 3; GAS unsigned* p = (GAS unsigned*)(ckv + (size_t)row * 1024 + hd * 128) + lane;
        const unsigned w = *p; const float a = bflo(w), b = bfhi(w);
        const float ss = wave_sum(a * a + b * b); const float rs = frsq(ss * (1.0f / 128.0f) + EPS);
        *p = pkbf(a * rs * ((const GAS float*)P->cx_k_gain)[2 * lane], b * rs * ((const GAS float*)P->cx_k_gain)[2 * lane + 1]);
    }
}

template <int D, int NKB, bool BAND>
DI void attn_pass(const GAS bf16_t* Kb, const GAS bf16_t* Vb, long pitch, unsigned vmask, const bf16x8 (&qf)[D / 16],
                  float& m, float& l, f32x16 (&o)[D / 32], LAS unsigned char* vs, int lane) {
    const int r = lane & 31, h = lane >> 5;
    f32x16 st[NKB];
#pragma unroll
    for (int kb = 0; kb < NKB; ++kb) {
        if (vmask & (1u << kb)) {
            const GAS bf16_t* kr = Kb + (long)(32 * kb + r) * pitch + 8 * h;
            f32x16 a = zero16();
#pragma unroll
            for (int ks = 0; ks < D / 16; ++ks) a = mfma32(*(const GAS bf16x8*)(kr + 16 * ks), qf[ks], a);
            st[kb] = a;
            MEMFENCE();
        } else {
#pragma unroll
            for (int i = 0; i < 16; ++i) st[kb][i] = NEGF;
        }
    }
    if (BAND) {
#pragma unroll
        for (int i = 0; i < 16; ++i) { const int jj = crow(i, h); if (jj < r) st[0][i] = NEGF; if (jj > r) st[NKB - 1][i] = NEGF; }
    }
    float bm = NEGF;
#pragma unroll
    for (int kb = 0; kb < NKB; ++kb)
#pragma unroll
        for (int i = 0; i < 16; ++i) bm = fmaxf(bm, st[kb][i]);
    bm = fmaxf(bm, SHX(bm, 32));
    const float mn = fmaxf(m, bm); const float alpha = __expf(m - mn);
    float ls = 0.f;
#pragma unroll
    for (int kb = 0; kb < NKB; ++kb)
#pragma unroll
        for (int i = 0; i < 16; ++i) { const float p = __expf(st[kb][i] - mn); st[kb][i] = p; ls += p; }
    ls += SHX(ls, 32);
    l = l * alpha + ls; m = mn;
#pragma unroll
    for (int d0 = 0; d0 < D / 32; ++d0)
#pragma unroll
        for (int i = 0; i < 16; ++i) o[d0][i] *= alpha;
    const int q4 = (lane & 15) >> 2, p4 = lane & 3, blk = (lane >> 4) & 1;
    LAS unsigned char* vrd = vs + q4 * (2 * D) + 32 * blk + 8 * p4;
#pragma unroll
    for (int kb = 0; kb < NKB; ++kb) {
        if (vmask & (1u << kb)) {
            constexpr int CPR = D / 8;
#pragma unroll
            for (int t = 0; t < (32 * CPR) / 64; ++t) {
                const int ci = lane + 64 * t, row = ci / CPR, ch = ci % CPR;
                const u32x4 v = *(const GAS u32x4*)(Vb + (long)(32 * kb + row) * pitch + 8 * ch);
                *(LAS u32x4*)(vs + row * (2 * D) + ch * 16) = v;
                if ((t & 3) == 3) MEMFENCE();
            }
            LDS_FENCE();
#pragma unroll
            for (int ks2 = 0; ks2 < 2; ++ks2) {
                const bf16x8 pb = pack8(st[kb], ks2);
#pragma unroll
                for (int d0 = 0; d0 < D / 32; ++d0) {
                    const s16x4 lo = trread(vrd + (16 * ks2 + 4 * h) * (2 * D) + 64 * d0);
                    const s16x4 hi = trread(vrd + (16 * ks2 + 8 + 4 * h) * (2 * D) + 64 * d0);
                    o[d0] = mfma32(cat44(lo, hi), pb, o[d0]);
                }
            }
            LDS_FENCE();
        }
    }
}

DI void att_unit(GAS unsigned char* ws, int u, LAS unsigned char* vs, int lane, bool dry) {
    const int r = lane & 31, h = lane >> 5;
    const int qblk = u & 63, hb = u >> 6, head = hb % 24, bl = hb / 24;
    const int gi = head >> 3, slot = head & 7, sh = 2 * gi, n = 2048 >> sh;
    const int prow = 32 * qblk, c = prow >> (11 - sh), i0 = prow & (n - 1);
    const size_t hbase = (size_t)(bl * 24 + head) * 2048 * 64;
    GAS bf16_t* Q = (GAS bf16_t*)(ws + WS_AQ) + hbase; const GAS bf16_t* K = (const GAS bf16_t*)(ws + WS_AK) + hbase; const GAS bf16_t* V = (const GAS bf16_t*)(ws + WS_AV) + hbase;
    bf16x8 qf[4];
#pragma unroll
    for (int ks = 0; ks < 4; ++ks) qf[ks] = *(const GAS bf16x8*)(Q + (size_t)(prow + r) * 64 + 16 * ks + 8 * h);
    unsigned vmask = 0;
#pragma unroll
    for (int kb = 0; kb < 5; ++kb) { const int j0 = i0 - 64 + 32 * kb; if (j0 >= 0 && j0 < n) vmask |= 1u << kb; }
    vmask = __builtin_amdgcn_readfirstlane(vmask);
    float m = NEGF, l = 0.f; f32x16 o[2]; o[0] = zero16(); o[1] = zero16();
    attn_pass<64, 5, true>(K + (long)(prow - 64) * 64, V + (long)(prow - 64) * 64, 64, vmask, qf, m, l, o, vs, lane);
    if (dry) return;
    const float inv = frcp(l);
    GAS bf16_t* orow = Q + (size_t)(prow + r) * 64;
#pragma unroll
    for (int d0 = 0; d0 < 2; ++d0)
#pragma unroll
        for (int g4 = 0; g4 < 4; ++g4) {
            u32x2 w; w.x = pkbf(o[d0][4 * g4] * inv, o[d0][4 * g4 + 1] * inv); w.y = pkbf(o[d0][4 * g4 + 2] * inv, o[d0][4 * g4 + 3] * inv);
            *(GAS u32x2*)(orow + 32 * d0 + 8 * g4 + 4 * h) = w;
        }
    if (h == 0) {
        const int s = c + ((i0 + r) << sh);
        GAS float* lse = (GAS float*)(ws + WS_LSE);
        lse[((size_t)gi * TG + (size_t)bl * 2048 + s) * 8 + slot] = m + __logf(l);
    }
}

DI void cross_unit(KPC P, int grp, int u, LAS unsigned char* vs, int lane, bool dry) {
    const int r = lane & 31, h = lane >> 5;
    const int qblk = u & 63, head = (u >> 6) & 3, bl = u >> 8;
    GAS bf16_t* qrow = (GAS bf16_t*)(((GAS unsigned char*)P->ws) + WS_CQ) + ((size_t)bl * 2048 + 32 * qblk + r) * 512 + head * 128;
    bf16x8 qf[8]; float ss = 0.f;
#pragma unroll
    for (int ks = 0; ks < 8; ++ks) { qf[ks] = *(const GAS bf16x8*)(qrow + 16 * ks + 8 * h);
        const u32x4 w = __builtin_bit_cast(u32x4, qf[ks]);
        ss += (bflo(w.x) * bflo(w.x) + bfhi(w.x) * bfhi(w.x)) + (bflo(w.y) * bflo(w.y) + bfhi(w.y) * bfhi(w.y)) + (bflo(w.z) * bflo(w.z) + bfhi(w.z) * bfhi(w.z)) + (bflo(w.w) * bflo(w.w) + bfhi(w.w) * bfhi(w.w)); }
    ss += SHX(ss, 32);
    const float rq = (frsq(ss * (1.0f / 128.0f) + EPS)) * 0.08838834764831845f;
#pragma unroll
    for (int ks = 0; ks < 8; ++ks) {
        const u32x4 w = __builtin_bit_cast(u32x4, qf[ks]); const GAS float* g = ((const GAS float*)P->cx_q_gain) + 16 * ks + 8 * h;
        const f32x4 ga = *(const GAS f32x4*)g, gb = *(const GAS f32x4*)(g + 4);
        u32x4 o; o.x = pkbf(bflo(w.x) * rq * ga.x, bfhi(w.x) * rq * ga.y); o.y = pkbf(bflo(w.y) * rq * ga.z, bfhi(w.y) * rq * ga.w);
        o.z = pkbf(bflo(w.z) * rq * gb.x, bfhi(w.z) * rq * gb.y); o.w = pkbf(bflo(w.w) * rq * gb.z, bfhi(w.w) * rq * gb.w);
        qf[ks] = __builtin_bit_cast(bf16x8, o);
    }
    const GAS bf16_t* K = (const GAS bf16_t*)(((GAS unsigned char*)P->ws) + WS_CKV) + (size_t)(grp * BL + bl) * 256 * 1024 + head * 128;
    const GAS bf16_t* V = K + 512;
    float m = NEGF, l = 0.f; f32x16 o[4];
#pragma unroll
    for (int d0 = 0; d0 < 4; ++d0) o[d0] = zero16();
#pragma unroll 1
    for (int ps = 0; ps < 4; ++ps) attn_pass<128, 2, false>(K + (size_t)ps * 64 * 1024, V + (size_t)ps * 64 * 1024, 1024, 0x3u, qf, m, l, o, vs, lane);
    if (dry) return;
    const float inv = frcp(l);
#pragma unroll
    for (int d0 = 0; d0 < 4; ++d0)
#pragma unroll
        for (int g4 = 0; g4 < 4; ++g4) {
            u32x2 w; w.x = pkbf(o[d0][4 * g4] * inv, o[d0][4 * g4 + 1] * inv); w.y = pkbf(o[d0][4 * g4 + 2] * inv, o[d0][4 * g4 + 3] * inv);
            *(GAS u32x2*)(qrow + 32 * d0 + 8 * g4 + 4 * h) = w;
        }
}

DI float scan_add(float v, int lane) {
#pragma unroll
    for (int d = 1; d < 64; d <<= 1) { const float t = shup(v, d, lane); if (lane >= d) v += t; }
    return v;
}
DI float scan_max(float v, int lane) {
#pragma unroll
    for (int d = 1; d < 64; d <<= 1) { const float t = shup(v, d, lane); if (lane >= d) v = fmaxf(v, t); }
    return v;
}
DI float log_sigmoid(float x) { return x >= 0.f ? -log1pf(__expf(-x)) : x - log1pf(__expf(x)); }

template <int D, int NKB, bool BAND>
DI void attn_pass_lds(LAS unsigned char* Kimg, LAS unsigned char* Vimg, unsigned vmask, const bf16x8 (&qf)[D / 16],
                      float& m, float& l, f32x16 (&o)[D / 32], int lane) {
    constexpr int PB = 2 * D + 16;
    constexpr int PBV = (D == 64) ? 192 : 320;
    const int r = lane & 31, h = lane >> 5;
    f32x16 st[NKB];
#pragma unroll
    for (int kb = 0; kb < NKB; ++kb) {
        if (vmask & (1u << kb)) {
            LAS unsigned char* kr = Kimg + (32 * kb + r) * PB + 16 * h;
            f32x16 a = zero16();
#pragma unroll
            for (int ks = 0; ks < D / 16; ++ks) a = mfma32(*(const LAS bf16x8*)(kr + 32 * ks), qf[ks], a);
            st[kb] = a;
        } else {
#pragma unroll
            for (int i = 0; i < 16; ++i) st[kb][i] = NEGF;
        }
    }
    if (BAND) {
#pragma unroll
        for (int i = 0; i < 16; ++i) { const int jj = crow(i, h); if (jj < r) st[0][i] = NEGF; if (jj > r) st[NKB - 1][i] = NEGF; }
    }
    float bm = NEGF;
#pragma unroll
    for (int kb = 0; kb < NKB; ++kb)
#pragma unroll
        for (int i = 0; i < 16; ++i) bm = fmaxf(bm, st[kb][i]);
    bm = fmaxf(bm, SHX(bm, 32));
    const float mn = fmaxf(m, bm); const float alpha = __expf(m - mn);
    float ls = 0.f;
#pragma unroll
    for (int kb = 0; kb < NKB; ++kb)
#pragma unroll
        for (int i = 0; i < 16; ++i) { const float p = __expf(st[kb][i] - mn); st[kb][i] = p; ls += p; }
    ls += SHX(ls, 32);
    l = l * alpha + ls; m = mn;
#pragma unroll
    for (int d0 = 0; d0 < D / 32; ++d0)
#pragma unroll
        for (int i = 0; i < 16; ++i) o[d0][i] *= alpha;
    LAS unsigned char* vrd = Vimg + ((lane & 15) >> 2) * PBV + 32 * ((lane >> 4) & 1) + 8 * (lane & 3);
#pragma unroll
    for (int kb = 0; kb < NKB; ++kb) {
        if (vmask & (1u << kb)) {
#pragma unroll
            for (int ks2 = 0; ks2 < 2; ++ks2) {
                const bf16x8 pb = pack8(st[kb], ks2);
#pragma unroll
                for (int d0 = 0; d0 < D / 32; ++d0) {
                    const s16x4 lo = trread(vrd + (32 * kb + 16 * ks2 + 4 * h) * PBV + 64 * d0);
                    const s16x4 hi = trread(vrd + (32 * kb + 16 * ks2 + 8 + 4 * h) * PBV + 64 * d0);
                    o[d0] = mfma32(cat44(lo, hi), pb, o[d0]);
                }
            }
        }
    }
}

DI void att_wg_loop(GAS unsigned char* ws, LAS unsigned char* lds, int ubeg, int ustep, int uend, const int tid0) {
    int tid = tid0; asm volatile("" : "+v"(tid));
    const int lane = tid & 63, wave = __builtin_amdgcn_readfirstlane(tid0 >> 6), r = lane & 31, h = lane >> 5;
    constexpr int PB = 144, PBV = 192;
    LAS unsigned char* Kimg = lds; LAS unsigned char* Vimg = lds + 384 * PB;
    u32x4 kreg[6], vreg[6];
    auto issue = [&](int u) {
        const int ublk = u & 7, hb = u >> 3, head = hb % 24, bl = hb / 24;
        const size_t hbase = (size_t)(bl * 24 + head) * 2048 * 64;
        const GAS bf16_t* K = (const GAS bf16_t*)(ws + WS_AK) + hbase; const GAS bf16_t* V = (const GAS bf16_t*)(ws + WS_AV) + hbase;
        const int w0 = 256 * ublk - 64;
#pragma unroll
        for (int i = 0; i < 6; ++i) {
            const int ix = tid + 512 * i, row = ix >> 3, ch = ix & 7; const int grow = w0 + row;
            kreg[i] = (u32x4){0u, 0u, 0u, 0u}; vreg[i] = (u32x4){0u, 0u, 0u, 0u};
            if (grow >= 0 && grow < 2048) { kreg[i] = *(const GAS u32x4*)(K + (size_t)grow * 64 + 8 * ch); vreg[i] = *(const GAS u32x4*)(V + (size_t)grow * 64 + 8 * ch); }
        }
    };
    if (ubeg < uend) issue(ubeg);
#pragma unroll 1
    for (int u = ubeg; u < uend; u += ustep) {
#pragma unroll
        for (int i = 0; i < 6; ++i) { const int ix = tid + 512 * i, row = ix >> 3, ch = ix & 7;
            *(LAS u32x4*)(Kimg + row * PB + ch * 16) = kreg[i]; *(LAS u32x4*)(Vimg + row * PBV + ch * 16) = vreg[i]; }
        const int ublk = u & 7, hb = u >> 3, head = hb % 24, bl = hb / 24;
        const int gi = head >> 3, slot = head & 7, sh = 2 * gi, n = 2048 >> sh;
        GAS bf16_t* Q = (GAS bf16_t*)(ws + WS_AQ) + (size_t)(bl * 24 + head) * 2048 * 64;
        const int prow = 256 * ublk + 32 * wave, c = prow >> (11 - sh), i0 = prow & (n - 1);
        bf16x8 qf[4];
#pragma unroll
        for (int ks = 0; ks < 4; ++ks) qf[ks] = *(const GAS bf16x8*)(Q + (size_t)(prow + r) * 64 + 16 * ks + 8 * h);
        unsigned vmask = 0;
#pragma unroll
        for (int kb = 0; kb < 5; ++kb) { const int j0 = i0 - 64 + 32 * kb; if (j0 >= 0 && j0 < n) vmask |= 1u << kb; }
        vmask = __builtin_amdgcn_readfirstlane(vmask);
        __syncthreads();
        if (u + ustep < uend) issue(u + ustep);
        float m = NEGF, l = 0.f; f32x16 o[2]; o[0] = zero16(); o[1] = zero16();
        attn_pass_lds<64, 5, true>(Kimg + 32 * wave * PB, Vimg + 32 * wave * PBV, vmask, qf, m, l, o, lane);
        const float inv = frcp(l);
        GAS bf16_t* orow = Q + (size_t)(prow + r) * 64;
#pragma unroll
        for (int d0 = 0; d0 < 2; ++d0)
#pragma unroll
            for (int g4 = 0; g4 < 4; ++g4) {
                u32x2 w; w.x = pkbf(o[d0][4 * g4] * inv, o[d0][4 * g4 + 1] * inv); w.y = pkbf(o[d0][4 * g4 + 2] * inv, o[d0][4 * g4 + 3] * inv);
                *(GAS u32x2*)(orow + 32 * d0 + 8 * g4 + 4 * h) = w;
            }
        if (h == 0) {
            const int sq = c + ((i0 + r) << sh);
            GAS float* lse = (GAS float*)(ws + WS_LSE);
            lse[((size_t)gi * TG + (size_t)bl * 2048 + sq) * 8 + slot] = m + __logf(l);
        }
        __syncthreads();
    }
}

DI void cross_wg_unit(KPC P, LAS unsigned char* lds, int grp, int u, const int tid0) {
    int tid = tid0; asm volatile("" : "+v"(tid));
    const int lane = tid & 63, wave = __builtin_amdgcn_readfirstlane(tid0 >> 6), r = lane & 31, h = lane >> 5;
    constexpr int PB = 272, PBV = 320;
    GAS unsigned char* ws = ((GAS unsigned char*)P->ws); asm volatile("" : "+s"(ws));
    const int qq = u & 7, head = (u >> 3) & 3, bl = u >> 5;
    const GAS bf16_t* K = (const GAS bf16_t*)(ws + WS_CKV) + (size_t)(grp * BL + bl) * 256 * 1024 + head * 128;
    const GAS bf16_t* V = K + 512;
    LAS unsigned char* Kimg = lds; LAS unsigned char* Vimg = lds + 256 * PB;
#pragma unroll
    for (int i = 0; i < 8; ++i) {
        const int ix = tid + 512 * i, row = ix >> 4, ch = ix & 15;
        *(LAS u32x4*)(Kimg + row * PB + ch * 16) = *(const GAS u32x4*)(K + (size_t)row * 1024 + 8 * ch);
        *(LAS u32x4*)(Vimg + row * PBV + ch * 16) = *(const GAS u32x4*)(V + (size_t)row * 1024 + 8 * ch);
    }
    GAS bf16_t* qrow = (GAS bf16_t*)(ws + WS_CQ) + ((size_t)bl * 2048 + 256 * qq + 32 * wave + r) * 512 + head * 128;
    bf16x8 qf[8]; float ss = 0.f;
#pragma unroll
    for (int ks = 0; ks < 8; ++ks) { qf[ks] = *(const GAS bf16x8*)(qrow + 16 * ks + 8 * h);
        const u32x4 w = __builtin_bit_cast(u32x4, qf[ks]);
        ss += (bflo(w.x) * bflo(w.x) + bfhi(w.x) * bfhi(w.x)) + (bflo(w.y) * bflo(w.y) + bfhi(w.y) * bfhi(w.y)) + (bflo(w.z) * bflo(w.z) + bfhi(w.z) * bfhi(w.z)) + (bflo(w.w) * bflo(w.w) + bfhi(w.w) * bfhi(w.w)); }
    ss += SHX(ss, 32);
    const float rq = (frsq(ss * (1.0f / 128.0f) + EPS)) * 0.08838834764831845f;
#pragma unroll
    for (int ks = 0; ks < 8; ++ks) {
        const u32x4 w = __builtin_bit_cast(u32x4, qf[ks]); const GAS float* g = ((const GAS float*)P->cx_q_gain) + 16 * ks + 8 * h;
        const f32x4 ga = *(const GAS f32x4*)g, gb = *(const GAS f32x4*)(g + 4);
        u32x4 o; o.x = pkbf(bflo(w.x) * rq * ga.x, bfhi(w.x) * rq * ga.y); o.y = pkbf(bflo(w.y) * rq * ga.z, bfhi(w.y) * rq * ga.w);
        o.z = pkbf(bflo(w.z) * rq * gb.x, bfhi(w.z) * rq * gb.y); o.w = pkbf(bflo(w.w) * rq * gb.z, bfhi(w.w) * rq * gb.w);
        qf[ks] = __builtin_bit_cast(bf16x8, o);
    }
    __syncthreads();
    float m = NEGF, l = 0.f; f32x16 o[4];
#pragma unroll
    for (int d0 = 0; d0 < 4; ++d0) o[d0] = zero16();
#pragma unroll 1
    for (int ps = 0; ps < 4; ++ps) attn_pass_lds<128, 2, false>(Kimg + ps * 64 * PB, Vimg + ps * 64 * PBV, 0x3u, qf, m, l, o, lane);
    const float inv = frcp(l);
    GAS bf16_t* orow = (GAS bf16_t*)(ws + WS_YATT) + ((size_t)bl * 2048 + 256 * qq + 32 * wave + r) * 1536 + 1024 + head * 128;
#pragma unroll
    for (int d0 = 0; d0 < 4; ++d0)
#pragma unroll
        for (int g4 = 0; g4 < 4; ++g4) {
            u32x2 w; w.x = pkbf(o[d0][4 * g4] * inv, o[d0][4 * g4 + 1] * inv); w.y = pkbf(o[d0][4 * g4 + 2] * inv, o[d0][4 * g4 + 3] * inv);
            *(GAS u32x2*)(orow + 32 * d0 + 8 * g4 + 4 * h) = w;
        }
    __syncthreads();
}

#ifndef REP_ML
#define REP_ML 1
#endif
constexpr size_t WS_DN = 493 * MiB;
constexpr size_t WS_SCL = 493 * MiB + 512 * 1024;
#define CHAIN_LANES() asm volatile("" : "+v"(tid)); const int lane = tid & 63, r = lane & 31, h = lane >> 5; const int trofs = ((lane & 15) >> 2) * MLP + 32 * ((lane >> 4) & 1) + 8 * (lane & 3); (void)r; (void)h; (void)trofs

DI void ml_conv_item(KPC P, const GAS bf16_t* srcbase, LAS unsigned char* img, int sel, int cg8, int seg, int ci, int dir, size_t rowb, int head) {
    const int tl0 = 128 * ci + 8 * seg;
    const int pmin = dir ? 2047 - (tl0 + 7) : tl0;
    const GAS bf16_t* src = srcbase + head * 128 + 8 * cg8;
    u32x4 raw[12];
#pragma unroll
    for (int i = 0; i < 12; ++i) { const int pp = pmin - 2 + i; raw[i] = (u32x4){0u, 0u, 0u, 0u}; if (pp >= 0 && pp < 2048) raw[i] = *(const GAS u32x4*)(src + (rowb + pp) * 512); }
    const int ch = sel * 512 + head * 128 + 8 * cg8;
    f32x4 wv[5][2];
#pragma unroll
    for (int j = 0; j < 5; ++j) { wv[j][0] = *(const GAS f32x4*)(((const GAS float*)P->ml_conv_w) + j * 1024 + ch); wv[j][1] = *(const GAS f32x4*)(((const GAS float*)P->ml_conv_w) + j * 1024 + ch + 4); }
    const f32x4 b0 = *(const GAS f32x4*)(((const GAS float*)P->ml_conv_b) + ch), b1 = *(const GAS f32x4*)(((const GAS float*)P->ml_conv_b) + ch + 4);
    const float osc = sel ? 1.0f : 0.08838834764831845f;
    LAS unsigned char* dstb = img + cg8 * 16;
#pragma unroll
    for (int i = 0; i < 8; ++i) {
        f32x4 a0 = b0, a1 = b1;
#pragma unroll
        for (int j = 0; j < 5; ++j) {
            const u32x4 w = raw[i + j];
            a0 += wv[j][0] * (f32x4){bflo(w.x), bfhi(w.x), bflo(w.y), bfhi(w.y)};
            a1 += wv[j][1] * (f32x4){bflo(w.z), bfhi(w.z), bflo(w.w), bfhi(w.w)};
        }
        u32x4 o;
        o.x = pkbf(a0.x * sigmoidf_(a0.x) * osc, a0.y * sigmoidf_(a0.y) * osc); o.y = pkbf(a0.z * sigmoidf_(a0.z) * osc, a0.w * sigmoidf_(a0.w) * osc);
        o.z = pkbf(a1.x * sigmoidf_(a1.x) * osc, a1.y * sigmoidf_(a1.y) * osc); o.w = pkbf(a1.z * sigmoidf_(a1.z) * osc, a1.w * sigmoidf_(a1.w) * osc);
        const int tl = dir ? (8 * seg + 7 - i) : (8 * seg + i);
        *(LAS u32x4*)(dstb + tl * MLP) = o;
    }
}

DI void mlstm_p1(KPC P, LAS unsigned char* lds, int grp, int chain, int ci, const int tid0) {
    int tid = tid0; const int wave = __builtin_amdgcn_readfirstlane(tid0 >> 6);
    const int bl = chain >> 3, head = (chain >> 1) & 3, dir = chain & 1;
    GAS unsigned char* ws = ((GAS unsigned char*)P->ws); asm volatile("" : "+s"(ws));
    LAS unsigned char* KI = lds + 128 * MLP; LAS unsigned char* VI = lds + 2 * 128 * MLP; LAS unsigned char* CI = lds + 3 * 128 * MLP;
    LAS float* twk = (LAS float*)(lds + TB_OFF) + 384;
    const size_t rowb = (size_t)bl * 2048;
    {
        CHAIN_LANES();
        if (tid < 256) {
            ml_conv_item(P, (const GAS bf16_t*)(ws + WS_MK), KI, 1, tid & 15, (tid >> 4) & 15, ci, dir, rowb, head);
        } else {
            const int t2 = tid - 256; const int t = t2 >> 1, c0 = (t2 & 1) * 64; const int tau = 128 * ci + t; const int p = dir ? 2047 - tau : tau;
            const GAS bf16_t* vsrc = (const GAS bf16_t*)(ws + WS_MV) + (rowb + p) * 512 + head * 128 + c0;
#pragma unroll
            for (int sub = 0; sub < 8; ++sub) *(LAS u32x4*)(VI + t * MLP + c0 * 2 + sub * 16) = *(const GAS u32x4*)(vsrc + 8 * sub);
            if (wave == 7) {
                const GAS float* MIF = (const GAS float*)(ws + WS_MIF);
                const float bli = ((const GAS float*)P->ml_gate_b)[(dir ? 8 : 0) + head], blf = ((const GAS float*)P->ml_gate_b)[(dir ? 12 : 4) + head];
                const int tau1 = 128 * ci + lane, tau2 = tau1 + 64; const int p1 = dir ? 2047 - tau1 : tau1, p2 = dir ? 2047 - tau2 : tau2;
                const GAS float* r1 = MIF + (rowb + p1) * 16 + head; const GAS float* r2 = MIF + (rowb + p2) * 16 + head;
                const float li1 = r1[dir ? 8 : 0] + bli, li2 = r2[dir ? 8 : 0] + bli;
                const float lf1 = log_sigmoid(r1[dir ? 12 : 4] + blf), lf2 = log_sigmoid(r2[dir ? 12 : 4] + blf);
                const float c1 = scan_add(lf1, lane); const float tot1 = rdlane(c1, 63); const float c2 = scan_add(lf2, lane) + tot1;
                const float g1 = li1 - c1, g2 = li2 - c2;
                float gm = fmaxf(g1, g2);
#pragma unroll
                for (int o = 1; o < 64; o <<= 1) gm = fmaxf(gm, SHX(gm, o));
                const float gtot = rdlane(c2, 63);
                twk[lane] = __expf(g1 - gm); twk[64 + lane] = __expf(g2 - gm);
                if (lane == 0) { GAS float* scl = (GAS float*)(ws + WS_SCL) + ((size_t)chain * 16 + ci) * 4; scl[0] = gtot; scl[1] = gm; }
            }
        }
    }
    __syncthreads();
    {
        CHAIN_LANES();
        const int s = tid >> 2, c0 = (tid & 3) * 32; const float wks = twk[s];
#pragma unroll
        for (int sub = 0; sub < 4; ++sub) {
            LAS u32x4* pp = (LAS u32x4*)(KI + s * MLP + c0 * 2 + sub * 16); const u32x4 w = *pp;
            u32x4 o; o.x = pkbf(bflo(w.x) * wks, bfhi(w.x) * wks); o.y = pkbf(bflo(w.y) * wks, bfhi(w.y) * wks); o.z = pkbf(bflo(w.z) * wks, bfhi(w.z) * wks); o.w = pkbf(bflo(w.w) * wks, bfhi(w.w) * wks);
            *pp = o;
        }
    }
    __syncthreads();
    {
        CHAIN_LANES();
        const int vb = wave >> 1, kh = wave & 1;
        f32x16 cacc[2], ntmp[2]; cacc[0] = zero16(); cacc[1] = zero16(); ntmp[0] = zero16(); ntmp[1] = zero16();
        const bf16x8 ones = (bf16x8){0x3F80, 0x3F80, 0x3F80, 0x3F80, 0x3F80, 0x3F80, 0x3F80, 0x3F80};
#pragma unroll
        for (int ks = 0; ks < 8; ++ks) {
            LAS unsigned char* vp = VI + trofs + (16 * ks + 8 * h) * MLP + 64 * vb;
            const bf16x8 af = cat44(trread(vp), trread(vp + 4 * MLP));
#pragma unroll
            for (int jk = 0; jk < 2; ++jk) {
                LAS unsigned char* kp = KI + trofs + (16 * ks + 8 * h) * MLP + 64 * (2 * kh + jk);
                const bf16x8 bfr = cat44(trread(kp), trread(kp + 4 * MLP));
                cacc[jk] = mfma32(af, bfr, cacc[jk]);
                if (vb == 0) ntmp[jk] = mfma32(ones, bfr, ntmp[jk]);
            }
        }
#pragma unroll
        for (int jk = 0; jk < 2; ++jk) {
            const int kcol = 32 * (2 * kh + jk) + r;
#pragma unroll
            for (int i = 0; i < 16; i += 1) {
                const unsigned short v = (unsigned short)(pkbf(cacc[jk][i], 0.f) & 0xffffu);
                *(LAS unsigned short*)(CI + (32 * vb + crow(i, h)) * MLP + kcol * 2) = v;
            }
            if (vb == 0 && h == 0) ((GAS float*)(ws + WS_DN))[((size_t)chain * 16 + ci) * 128 + kcol] = ntmp[jk][0];
        }
    }
    __syncthreads();
    {
        CHAIN_LANES();
        GAS bf16_t* dc = (GAS bf16_t*)((GAS float*)P->out) + ((size_t)chain * 16 + ci) * 16384;
#pragma unroll
        for (int i = 0; i < 4; ++i) { const int ix = tid + 512 * i; *(GAS u32x4*)(dc + (size_t)ix * 8) = *(LAS u32x4*)(CI + (ix >> 4) * MLP + (ix & 15) * 16); }
    }
}

DI void mlstm_p1f(KPC P, LAS unsigned char* lds, int grp, int bl, int head, int pc, const int tid0) {
    int tid = tid0; const int wave = __builtin_amdgcn_readfirstlane(tid0 >> 6);
    GAS unsigned char* ws = ((GAS unsigned char*)P->ws); asm volatile("" : "+s"(ws));
    LAS unsigned char* KW = lds; LAS unsigned char* KI = lds + 128 * MLT; LAS unsigned char* VI = lds + 128 * MLT + 128 * MLP; LAS unsigned char* CI = lds + 2 * 128 * MLT + 128 * MLP;
    LAS float* twk = (LAS float*)(lds + TB_OFF) + 256;
    const size_t rowb = (size_t)bl * 2048;
    {
        CHAIN_LANES();
        if (tid < 256) {
            ml_conv_item(P, (const GAS bf16_t*)(ws + WS_MK), KI, 1, tid & 15, (tid >> 4) & 15, pc, 0, rowb, head);
        } else {
            const int d = wave == 7 ? 0 : 1;
            const int ci = d ? 15 - pc : pc; const int chain = bl * 8 + head * 2 + d;
            float gl[4] = {0.f, 0.f, 0.f, 0.f};
            if (wave >= 6) {
                const GAS float* MIF = (const GAS float*)(ws + (grp ? WS_MIF1 : WS_MIF));
                const int tau1 = 128 * ci + lane, tau2 = tau1 + 64; const int p1 = d ? 2047 - tau1 : tau1, p2 = d ? 2047 - tau2 : tau2;
                const GAS float* r1 = MIF + (rowb + p1) * 16 + head; const GAS float* r2 = MIF + (rowb + p2) * 16 + head;
                gl[0] = r1[d ? 8 : 0]; gl[1] = r2[d ? 8 : 0]; gl[2] = r1[d ? 12 : 4]; gl[3] = r2[d ? 12 : 4];
            }
            const int t2 = tid - 256; const int t = t2 >> 1, c0 = (t2 & 1) * 64;
            const GAS bf16_t* vsrc = (const GAS bf16_t*)(ws + WS_MV) + (rowb + 128 * pc + t) * 512 + head * 128 + c0;
#pragma unroll
            for (int sub = 0; sub < 8; ++sub) *(LAS u32x4*)(VI + t * MLT + c0 * 2 + sub * 16) = *(const GAS u32x4*)(vsrc + 8 * sub);
            if (wave >= 6) {
                const float bli = ((const GAS float*)P->ml_gate_b)[(d ? 8 : 0) + head], blf = ((const GAS float*)P->ml_gate_b)[(d ? 12 : 4) + head];
                const float li1 = gl[0] + bli, li2 = gl[1] + bli;
                const float lf1 = log_sigmoid(gl[2] + blf), lf2 = log_sigmoid(gl[3] + blf);
                const float c1 = scan_add(lf1, lane); const float tot1 = rdlane(c1, 63); const float c2 = scan_add(lf2, lane) + tot1;
                const float g1 = li1 - c1, g2 = li2 - c2;
                float gm = fmaxf(g1, g2);
#pragma unroll
                for (int o = 1; o < 64; o <<= 1) gm = fmaxf(gm, SHX(gm, o));
                const float gtot = rdlane(c2, 63);
                const int po1 = d ? 127 - lane : lane, po2 = d ? 63 - lane : 64 + lane;
                twk[d * 128 + po1] = __expf(g1 - gm); twk[d * 128 + po2] = __expf(g2 - gm);
                if (lane == 0) { GAS float* scl = (GAS float*)(ws + WS_SCL) + ((size_t)chain * 16 + ci) * 4; scl[0] = gtot; scl[1] = gm; }
            }
        }
    }
    __syncthreads();
#pragma unroll 1
    for (int d = 0; d < 2; ++d) {
        const int ci = d ? 15 - pc : pc; const int chain = bl * 8 + head * 2 + d;
        {
            CHAIN_LANES();
            const int sp = tid >> 2, c0 = (tid & 3) * 32; const float wks = twk[d * 128 + sp];
#pragma unroll
            for (int sub = 0; sub < 4; ++sub) {
                const u32x4 w = *(const LAS u32x4*)(KI + sp * MLP + c0 * 2 + sub * 16);
                u32x4 o; o.x = pkbf(bflo(w.x) * wks, bfhi(w.x) * wks); o.y = pkbf(bflo(w.y) * wks, bfhi(w.y) * wks); o.z = pkbf(bflo(w.z) * wks, bfhi(w.z) * wks); o.w = pkbf(bflo(w.w) * wks, bfhi(w.w) * wks);
                *(LAS u32x4*)(KW + sp * MLT + c0 * 2 + sub * 16) = o;
            }
        }
        __syncthreads();
        {
            CHAIN_LANES();
            const int vb = wave >> 1, kh = wave & 1;
            const int trt = ((lane & 15) >> 2) * MLT + 32 * ((lane >> 4) & 1) + 8 * (lane & 3);
            f32x16 cacc[2], ntmp[2]; cacc[0] = zero16(); cacc[1] = zero16(); ntmp[0] = zero16(); ntmp[1] = zero16();
            const bf16x8 ones = (bf16x8){0x3F80, 0x3F80, 0x3F80, 0x3F80, 0x3F80, 0x3F80, 0x3F80, 0x3F80};
#pragma unroll
            for (int ks = 0; ks < 8; ++ks) {
                LAS unsigned char* vp = VI + trt + (16 * ks + 8 * h) * MLT + 64 * vb;
                const bf16x8 af = cat44(trread(vp), trread(vp + 4 * MLT));
#pragma unroll
                for (int jk = 0; jk < 2; ++jk) {
                    LAS unsigned char* kp = KW + trt + (16 * ks + 8 * h) * MLT + 64 * (2 * kh + jk);
                    const bf16x8 bfr = cat44(trread(kp), trread(kp + 4 * MLT));
                    cacc[jk] = mfma32(af, bfr, cacc[jk]);
                    if (vb == 0) ntmp[jk] = mfma32(ones, bfr, ntmp[jk]);
                }
            }
#pragma unroll
            for (int jk = 0; jk < 2; ++jk) {
                const int kcol = 32 * (2 * kh + jk) + r;
#pragma unroll
                for (int i = 0; i < 16; i += 1) {
                    const unsigned short v = (unsigned short)(pkbf(cacc[jk][i], 0.f) & 0xffffu);
                    *(LAS unsigned short*)(CI + (32 * vb + crow(i, h)) * MLP + kcol * 2) = v;
                }
                if (vb == 0 && h == 0) ((GAS float*)(ws + WS_DN))[((size_t)chain * 16 + ci) * 128 + kcol] = ntmp[jk][0];
            }
        }
        __syncthreads();
        {
            CHAIN_LANES();
            GAS bf16_t* dc = (GAS bf16_t*)((GAS float*)P->out) + ((size_t)chain * 16 + ci) * 16384;
#pragma unroll
            for (int i = 0; i < 4; ++i) { const int ix = tid + 512 * i; *(GAS u32x4*)(dc + (size_t)ix * 8) = *(LAS u32x4*)(CI + (ix >> 4) * MLP + (ix & 15) * 16); }
        }
    }
}

DI void mlstm_scan(GAS unsigned char* ws, GAS float* dcbase, int w, int tid) {
    const int chain = w >> 2, quarter = w & 3;
    GAS float* scl = (GAS float*)(ws + WS_SCL) + (size_t)chain * 64;
    GAS bf16_t* dc = (GAS bf16_t*)dcbase + (size_t)chain * 16 * 16384 + (size_t)(quarter * 512 + tid) * 8;
    GAS float* dn = (GAS float*)(ws + WS_DN) + (size_t)chain * 16 * 128 + (tid & 127);
    const bool isn = quarter == 0 && tid < 128;
    u32x4 d[16]; float nd[16];
#pragma unroll
    for (int c = 0; c < 16; ++c) { d[c] = *(const GAS u32x4*)(dc + (size_t)c * 16384); nd[c] = isn ? dn[c * 128] : 0.f; }
    float C[8]; float nn = 0.f, m = 0.f; float zinit = 0.f; asm volatile("" : "+v"(zinit));
#pragma unroll
    for (int k = 0; k < 8; ++k) C[k] = zinit;
#pragma unroll
    for (int c = 0; c < 16; ++c) {
        u32x4 o; o.x = pkbf(C[0], C[1]); o.y = pkbf(C[2], C[3]); o.z = pkbf(C[4], C[5]); o.w = pkbf(C[6], C[7]);
        *(GAS u32x4*)(dc + (size_t)c * 16384) = o;
        if (isn) dn[c * 128] = nn;
        const float gt = scl[4 * c], gm = scl[4 * c + 1];
        const float mn = gt + fmaxf(m, gm); const float al = __expf(gt + m - mn), be = __expf(gt + gm - mn);
        if (quarter == 0 && tid == 0) scl[4 * c + 2] = m;
        const u32x4 w4 = d[c];
        C[0] = al * C[0] + be * bflo(w4.x); C[1] = al * C[1] + be * bfhi(w4.x); C[2] = al * C[2] + be * bflo(w4.y); C[3] = al * C[3] + be * bfhi(w4.y);
        C[4] = al * C[4] + be * bflo(w4.z); C[5] = al * C[5] + be * bfhi(w4.z); C[6] = al * C[6] + be * bflo(w4.w); C[7] = al * C[7] + be * bfhi(w4.w);
        nn = al * nn + be * nd[c]; m = mn;
    }
}

DI void mlstm_p3(KPC P, LAS unsigned char* lds, int grp, int chain, int ci, const int tid0) {
    int tid = tid0; const int wave = __builtin_amdgcn_readfirstlane(tid0 >> 6);
    const int bl = chain >> 3, head = (chain >> 1) & 3, dir = chain & 1;
    GAS unsigned char* ws = ((GAS unsigned char*)P->ws); asm volatile("" : "+s"(ws));
    LAS unsigned char* QI = lds; LAS unsigned char* KI = lds + 128 * MLP; LAS unsigned char* VI = lds + 2 * 128 * MLP; LAS unsigned char* CI = lds + 3 * 128 * MLP;
    LAS float* tg = (LAS float*)(lds + TB_OFF); LAS float* tM = tg + 128; LAS float* tbc = tg + 256; LAS float* tnv = tg + 512; LAS float* scal = tg + 640;
    const size_t rowb = (size_t)bl * 2048;
    {
        CHAIN_LANES();
        ml_conv_item(P, (const GAS bf16_t*)(ws + (tid >> 8 ? WS_MK : WS_MQ)), (tid >> 8) ? KI : QI, tid >> 8, tid & 15, (tid >> 4) & 15, ci, dir, rowb, head);
        {
            const int t = tid >> 2, c0 = (tid & 3) * 32; const int tau = 128 * ci + t; const int p = dir ? 2047 - tau : tau;
            const GAS bf16_t* vsrc = (const GAS bf16_t*)(ws + WS_MV) + (rowb + p) * 512 + head * 128 + c0;
#pragma unroll
            for (int sub = 0; sub < 4; ++sub) *(LAS u32x4*)(VI + t * MLP + c0 * 2 + sub * 16) = *(const GAS u32x4*)(vsrc + 8 * sub);
            const GAS bf16_t* dc = (const GAS bf16_t*)((GAS float*)P->out) + ((size_t)chain * 16 + ci) * 16384;
#pragma unroll
            for (int i = 0; i < 4; ++i) { const int ix = tid + 512 * i; *(LAS u32x4*)(CI + (ix >> 4) * MLP + (ix & 15) * 16) = *(const GAS u32x4*)(dc + (size_t)ix * 8); }
        }
        if (wave == 1) tnv[lane] = ((const GAS float*)(ws + WS_DN))[((size_t)chain * 16 + ci) * 128 + lane];
        if (wave == 2) tnv[64 + lane] = ((const GAS float*)(ws + WS_DN))[((size_t)chain * 16 + ci) * 128 + 64 + lane];
        if (wave == 0) {
            const GAS float* MIF = (const GAS float*)(ws + WS_MIF);
            const float bli = ((const GAS float*)P->ml_gate_b)[(dir ? 8 : 0) + head], blf = ((const GAS float*)P->ml_gate_b)[(dir ? 12 : 4) + head];
            const float mcur = ((const GAS float*)(ws + WS_SCL))[((size_t)chain * 16 + ci) * 4 + 2];
            const int tau1 = 128 * ci + lane, tau2 = tau1 + 64; const int p1 = dir ? 2047 - tau1 : tau1, p2 = dir ? 2047 - tau2 : tau2;
            const GAS float* r1 = MIF + (rowb + p1) * 16 + head; const GAS float* r2 = MIF + (rowb + p2) * 16 + head;
            const float li1 = r1[dir ? 8 : 0] + bli, li2 = r2[dir ? 8 : 0] + bli;
            const float lf1 = log_sigmoid(r1[dir ? 12 : 4] + blf), lf2 = log_sigmoid(r2[dir ? 12 : 4] + blf);
            const float c1 = scan_add(lf1, lane); const float tot1 = rdlane(c1, 63); const float c2 = scan_add(lf2, lane) + tot1;
            const float g1 = li1 - c1, g2 = li2 - c2;
            const float x1 = scan_max(g1, lane); const float mx1 = rdlane(x1, 63); const float x2 = fmaxf(scan_max(g2, lane), mx1);
            tg[lane] = g1; tg[64 + lane] = g2; tM[lane] = fmaxf(x1, mcur); tM[64 + lane] = fmaxf(x2, mcur); tbc[lane] = c1; tbc[64 + lane] = c2;
            if (lane == 0) scal[0] = mcur;
        }
    }
    __syncthreads();
    {
        CHAIN_LANES();
        GAS bf16_t* Hout = (GAS bf16_t*)(ws + (dir ? WS_HB : WS_HF));
        const int tb = wave >> 1, vh = wave & 1; const int t = 32 * tb + r;
        const float Mt = tM[t], bct = tbc[t], mold = scal[0];
        const float winter = __expf(mold - Mt), flo = __expf(-(Mt + bct));
        bf16x8 qf[8];
#pragma unroll
        for (int ks = 0; ks < 8; ++ks) qf[ks] = *(const LAS bf16x8*)(QI + t * MLP + (16 * ks + 8 * h) * 2);
        f32x16 na[2]; na[0] = zero16(); na[1] = zero16();
        float den = 0.f;
        for (int sb = 0; sb <= tb; ++sb) {
            f32x16 st = zero16();
#pragma unroll
            for (int ks = 0; ks < 8; ++ks) st = mfma32(*(const LAS bf16x8*)(KI + (32 * sb + r) * MLP + (16 * ks + 8 * h) * 2), qf[ks], st);
            MEMFENCE();
#pragma unroll
            for (int i = 0; i < 16; ++i) {
                const int sl = crow(i, h); const float wgt = __expf(tg[32 * sb + sl] - Mt);
                const bool valid = (sb < tb) || (sl <= r);
                const float v = valid ? st[i] * wgt : 0.f; st[i] = v; den += v;
            }
#pragma unroll
            for (int ks2 = 0; ks2 < 2; ++ks2) {
                const bf16x8 pb = pack8(st, ks2);
#pragma unroll
                for (int jv = 0; jv < 2; ++jv) {
                    LAS unsigned char* vp = VI + trofs + (32 * sb + 16 * ks2 + 4 * h) * MLP + 64 * (2 * vh + jv);
                    const s16x4 lo = trread(vp), hi = trread(vp + 8 * MLP);
                    na[jv] = mfma32(cat44(lo, hi), pb, na[jv]);
                }
            }
        }
        den += SHX(den, 32);
        float dq = 0.f;
#pragma unroll
        for (int ks = 0; ks < 8; ++ks) {
            const u32x4 w = __builtin_bit_cast(u32x4, qf[ks]); const LAS float* nv = tnv + 16 * ks + 8 * h;
            const float q0 = bflo(w.x), q1 = bfhi(w.x), q2 = bflo(w.y), q3 = bfhi(w.y), q4_ = bflo(w.z), q5 = bfhi(w.z), q6 = bflo(w.w), q7 = bfhi(w.w);
            dq += (nv[0] * q0 + nv[1] * q1) + (nv[2] * q2 + nv[3] * q3) + (nv[4] * q4_ + nv[5] * q5) + (nv[6] * q6 + nv[7] * q7);
            u32x4 o; o.x = pkbf(q0 * winter, q1 * winter); o.y = pkbf(q2 * winter, q3 * winter); o.z = pkbf(q4_ * winter, q5 * winter); o.w = pkbf(q6 * winter, q7 * winter);
            const bf16x8 qs = __builtin_bit_cast(bf16x8, o);
#pragma unroll
            for (int jv = 0; jv < 2; ++jv)
                na[jv] = mfma32(*(const LAS bf16x8*)(CI + (32 * (2 * vh + jv) + r) * MLP + (16 * ks + 8 * h) * 2), qs, na[jv]);
        }
        dq += SHX(dq, 32);
        den += winter * dq;
        const float inv = frcp(fmaxf(fabsf(den), flo));
        const int tau = 128 * ci + t; const int p = dir ? 2047 - tau : tau;
        GAS bf16_t* dst = Hout + (rowb + p) * 512 + head * 128;
#pragma unroll
        for (int jv = 0; jv < 2; ++jv)
#pragma unroll
            for (int g4 = 0; g4 < 4; ++g4) {
                u32x2 w; w.x = pkbf(na[jv][4 * g4] * inv, na[jv][4 * g4 + 1] * inv); w.y = pkbf(na[jv][4 * g4 + 2] * inv, na[jv][4 * g4 + 3] * inv);
                *(GAS u32x2*)(dst + 32 * (2 * vh + jv) + 8 * g4 + 4 * h) = w;
            }
    }
    __syncthreads();
}

DI void mlstm_p3f(KPC P, LAS unsigned char* lds, int grp, int bl, int head, int pc, const int tid0) {
    int tid = tid0; const int wave = __builtin_amdgcn_readfirstlane(tid0 >> 6);
    GAS unsigned char* ws = ((GAS unsigned char*)P->ws); asm volatile("" : "+s"(ws));
    LAS unsigned char* QI = lds; LAS unsigned char* KI = lds + 128 * MLP; LAS unsigned char* VI = lds + 2 * 128 * MLP; LAS unsigned char* CI = lds + 2 * 128 * MLP + 128 * MLT;
    LAS float* tg = (LAS float*)(lds + TB_OFF); LAS float* tM = tg + 128; LAS float* tbc = tg + 256; LAS float* tnv = tg + 512; LAS float* scal = tg + 640; LAS float* ssx = tg + 656;
    const size_t rowb = (size_t)bl * 2048;
    {
        CHAIN_LANES();
        const int tv = tid >> 2, cv0 = (tid & 3) * 32;
        const GAS bf16_t* vsrc = (const GAS bf16_t*)(ws + WS_MV) + (rowb + 128 * pc + tv) * 512 + head * 128 + cv0;
        u32x4 vr[4];
#pragma unroll
        for (int sub = 0; sub < 4; ++sub) vr[sub] = *(const GAS u32x4*)(vsrc + 8 * sub);
        ml_conv_item(P, (const GAS bf16_t*)(ws + (tid >> 8 ? WS_MK : WS_MQ)), (tid >> 8) ? KI : QI, tid >> 8, tid & 15, (tid >> 4) & 15, pc, 0, rowb, head);
#pragma unroll
        for (int sub = 0; sub < 4; ++sub) *(LAS u32x4*)(VI + tv * MLT + cv0 * 2 + sub * 16) = vr[sub];
    }
#pragma unroll 1
    for (int d = 0; d < 2; ++d) {
        const int ci = d ? 15 - pc : pc; const int chain = bl * 8 + head * 2 + d;
        {
            CHAIN_LANES();
            const GAS bf16_t* dc = (const GAS bf16_t*)((GAS float*)P->out) + ((size_t)chain * 16 + ci) * 16384;
#pragma unroll
            for (int i = 0; i < 4; ++i) { const int ix = tid + 512 * i; *(LAS u32x4*)(CI + (ix >> 4) * MLP + (ix & 15) * 16) = *(const GAS u32x4*)(dc + (size_t)ix * 8); }
            if (wave == 1) tnv[lane] = ((const GAS float*)(ws + WS_DN))[((size_t)chain * 16 + ci) * 128 + lane];
            if (wave == 2) tnv[64 + lane] = ((const GAS float*)(ws + WS_DN))[((size_t)chain * 16 + ci) * 128 + 64 + lane];
            if (wave == 0) {
                const GAS float* MIF = (const GAS float*)(ws + (grp ? WS_MIF1 : WS_MIF));
                const float bli = ((const GAS float*)P->ml_gate_b)[(d ? 8 : 0) + head], blf = ((const GAS float*)P->ml_gate_b)[(d ? 12 : 4) + head];
                const float mcur = ((const GAS float*)(ws + WS_SCL))[((size_t)chain * 16 + ci) * 4 + 2];
                const int tau1 = 128 * ci + lane, tau2 = tau1 + 64; const int p1 = d ? 2047 - tau1 : tau1, p2 = d ? 2047 - tau2 : tau2;
                const GAS float* r1 = MIF + (rowb + p1) * 16 + head; const GAS float* r2 = MIF + (rowb + p2) * 16 + head;
                const float li1 = r1[d ? 8 : 0] + bli, li2 = r2[d ? 8 : 0] + bli;
                const float lf1 = log_sigmoid(r1[d ? 12 : 4] + blf), lf2 = log_sigmoid(r2[d ? 12 : 4] + blf);
                const float c1 = scan_add(lf1, lane); const float tot1 = rdlane(c1, 63); const float c2 = scan_add(lf2, lane) + tot1;
                const float g1 = li1 - c1, g2 = li2 - c2;
                const float x1 = scan_max(g1, lane); const float mx1 = rdlane(x1, 63); const float x2 = fmaxf(scan_max(g2, lane), mx1);
                tg[lane] = g1; tg[64 + lane] = g2; tM[lane] = fmaxf(x1, mcur); tM[64 + lane] = fmaxf(x2, mcur); tbc[lane] = c1; tbc[64 + lane] = c2;
                if (lane == 0) scal[0] = mcur;
            }
        }
        __syncthreads();
        {
            CHAIN_LANES();
            const int q4l = (lane & 15) >> 2, cofs = 32 * ((lane >> 4) & 1) + 8 * (lane & 3);
            const int tb = wave >> 1, vh = wave & 1; const int t = 32 * tb + r;
            const int pot = d ? 127 - t : t;
            const float Mt = tM[t], bct = tbc[t], mold = scal[0];
            const float winter = __expf(mold - Mt), flo = __expf(-(Mt + bct));
            bf16x8 qf[8];
#pragma unroll
            for (int ks = 0; ks < 8; ++ks) qf[ks] = *(const LAS bf16x8*)(QI + pot * MLP + (16 * ks + 8 * h) * 2);
            f32x16 na[2]; na[0] = zero16(); na[1] = zero16();
            float den = 0.f;
            for (int sb = 0; sb <= tb; ++sb) {
                f32x16 st = zero16();
                const int srow = 32 * sb + r; const int pos_s = d ? 127 - srow : srow;
#pragma unroll
                for (int ks = 0; ks < 8; ++ks) st = mfma32(*(const LAS bf16x8*)(KI + pos_s * MLP + (16 * ks + 8 * h) * 2), qf[ks], st);
                MEMFENCE();
#pragma unroll
                for (int i = 0; i < 16; ++i) {
                    const int sl = crow(i, h); const float wgt = __expf(tg[32 * sb + sl] - Mt);
                    const bool valid = (sb < tb) || (sl <= r);
                    const float v = valid ? st[i] * wgt : 0.f; st[i] = v; den += v;
                }
#pragma unroll
                for (int ks2 = 0; ks2 < 2; ++ks2) {
                    const bf16x8 pb = pack8(st, ks2);
                    const int rlo = 32 * sb + 16 * ks2 + 4 * h + q4l, rhi = rlo + 8;
                    const int plo = d ? 127 - rlo : rlo, phi = d ? 127 - rhi : rhi;
#pragma unroll
                    for (int jv = 0; jv < 2; ++jv) {
                        const s16x4 lo = trread(VI + plo * MLT + cofs + 64 * (2 * vh + jv)), hi = trread(VI + phi * MLT + cofs + 64 * (2 * vh + jv));
                        na[jv] = mfma32(cat44(lo, hi), pb, na[jv]);
                    }
                }
            }
            den += SHX(den, 32);
            float dq = 0.f;
#pragma unroll
            for (int ks = 0; ks < 8; ++ks) {
                const u32x4 w = __builtin_bit_cast(u32x4, qf[ks]); const LAS float* nv = tnv + 16 * ks + 8 * h;
                const float q0 = bflo(w.x), q1 = bfhi(w.x), q2 = bflo(w.y), q3 = bfhi(w.y), q4_ = bflo(w.z), q5 = bfhi(w.z), q6 = bflo(w.w), q7 = bfhi(w.w);
                dq += (nv[0] * q0 + nv[1] * q1) + (nv[2] * q2 + nv[3] * q3) + (nv[4] * q4_ + nv[5] * q5) + (nv[6] * q6 + nv[7] * q7);
                u32x4 o; o.x = pkbf(q0 * winter, q1 * winter); o.y = pkbf(q2 * winter, q3 * winter); o.z = pkbf(q4_ * winter, q5 * winter); o.w = pkbf(q6 * winter, q7 * winter);
                const bf16x8 qs = __builtin_bit_cast(bf16x8, o);
#pragma unroll
                for (int jv = 0; jv < 2; ++jv)
                    na[jv] = mfma32(*(const LAS bf16x8*)(CI + (32 * (2 * vh + jv) + r) * MLP + (16 * ks + 8 * h) * 2), qs, na[jv]);
            }
            dq += SHX(dq, 32);
            den += winter * dq;
            const float inv = frcp(fmaxf(fabsf(den), flo));
            const size_t tok = rowb + 128 * pc + pot;
            GAS bf16_t* hf = (GAS bf16_t*)(ws + WS_HF) + tok * 512 + head * 128;
            if (d == 0) {
#pragma unroll
                for (int jv = 0; jv < 2; ++jv)
#pragma unroll
                    for (int g4 = 0; g4 < 4; ++g4) {
                        u32x2 w; w.x = pkbf(na[jv][4 * g4] * inv, na[jv][4 * g4 + 1] * inv); w.y = pkbf(na[jv][4 * g4 + 2] * inv, na[jv][4 * g4 + 3] * inv);
                        *(GAS u32x2*)(hf + 32 * (2 * vh + jv) + 8 * g4 + 4 * h) = w;
                    }
            } else {
                float ssq = 0.f;
#pragma unroll
                for (int jv = 0; jv < 2; ++jv)
#pragma unroll
                    for (int g4 = 0; g4 < 4; ++g4) {
                        const u32x2 w = *(const GAS u32x2*)(hf + 32 * (2 * vh + jv) + 8 * g4 + 4 * h);
                        na[jv][4 * g4] = na[jv][4 * g4] * inv + bflo(w.x); na[jv][4 * g4 + 1] = na[jv][4 * g4 + 1] * inv + bfhi(w.x);
                        na[jv][4 * g4 + 2] = na[jv][4 * g4 + 2] * inv + bflo(w.y); na[jv][4 * g4 + 3] = na[jv][4 * g4 + 3] * inv + bfhi(w.y);
                        ssq += (na[jv][4 * g4] * na[jv][4 * g4] + na[jv][4 * g4 + 1] * na[jv][4 * g4 + 1]) + (na[jv][4 * g4 + 2] * na[jv][4 * g4 + 2] + na[jv][4 * g4 + 3] * na[jv][4 * g4 + 3]);
                        if (g4 & 1) MEMFENCE();
                    }
                ssq += SHX(ssq, 32);
                if (h == 0) ssx[2 * t + vh] = ssq;
                __syncthreads();
                const float rs = frsq((ssx[2 * t] + ssx[2 * t + 1]) * (1.0f / 128.0f) + EPS);
                const GAS bf16_t* mo = (const GAS bf16_t*)(ws + WS_MO) + tok * 512 + head * 128;
                GAS bf16_t* ym = (GAS bf16_t*)(ws + WS_YATT) + tok * 1536 + 512 + head * 128;
                const GAS float* gn = ((const GAS float*)P->ml_out_gain) + head * 128;
#pragma unroll
                for (int jv = 0; jv < 2; ++jv)
#pragma unroll
                    for (int g4 = 0; g4 < 4; ++g4) {
                        const int vo = 32 * (2 * vh + jv) + 8 * g4 + 4 * h;
                        const u32x2 mw = *(const GAS u32x2*)(mo + vo); const f32x4 gv = *(const GAS f32x4*)(gn + vo);
                        const float y0 = na[jv][4 * g4] * rs * gv.x * sigmoidf_(bflo(mw.x)), y1 = na[jv][4 * g4 + 1] * rs * gv.y * sigmoidf_(bfhi(mw.x));
                        const float y2 = na[jv][4 * g4 + 2] * rs * gv.z * sigmoidf_(bflo(mw.y)), y3 = na[jv][4 * g4 + 3] * rs * gv.w * sigmoidf_(bfhi(mw.y));
                        u32x2 w; w.x = pkbf(y0, y1); w.y = pkbf(y2, y3);
                        *(GAS u32x2*)(ym + vo) = w;
                        if (g4 & 1) MEMFENCE();
                    }
            }
        }
        __syncthreads();
    }
}

DI void merge_pass(KPC P, int gw, int NGW, int lane, const bool do_att) {
    GAS unsigned char* ws = ((GAS unsigned char*)P->ws);
    const GAS bf16_t* AO = (const GAS bf16_t*)(ws + WS_AQ); const GAS float* LSE = (const GAS float*)(ws + WS_LSE);
    const GAS bf16_t* HF = (const GAS bf16_t*)(ws + WS_HF); const GAS bf16_t* HB = (const GAS bf16_t*)(ws + WS_HB); const GAS bf16_t* MO = (const GAS bf16_t*)(ws + WS_MO);
    GAS bf16_t* YA = (GAS bf16_t*)(ws + WS_YATT); GAS bf16_t* YM = YA + 512;
    constexpr int U = 2;
    for (int t0 = gw * U; t0 < TG; t0 += NGW * U) {
        if (do_att) {
            const int slot = lane >> 3, d0 = 8 * (lane & 7);
            float ls[U][3]; u32x4 w[U][3];
#pragma unroll
            for (int k = 0; k < U; ++k) {
                const int tok = t0 + k, bl = tok >> 11, sq = tok & 2047;
#pragma unroll
                for (int g = 0; g < 3; ++g) {
                    ls[k][g] = LSE[((size_t)g * TG + tok) * 8 + slot];
                    const int sh = 2 * g; const int perm = ((sq & ((1 << sh) - 1)) << (11 - sh)) + (sq >> sh);
                    w[k][g] = *(const GAS u32x4*)(AO + ((size_t)(bl * 24 + g * 8 + slot) * 2048 + perm) * 64 + d0);
                }
            }
#pragma unroll
            for (int k = 0; k < U; ++k) {
                const int tok = t0 + k;
                const float mx = fmaxf(fmaxf(ls[k][0], ls[k][1]), ls[k][2]);
                float e[3], sum = 0.f;
#pragma unroll
                for (int g = 0; g < 3; ++g) { e[g] = __expf(ls[k][g] - mx); sum += e[g]; }
                const float isum = frcp(sum);
                float acc[8];
#pragma unroll
                for (int q = 0; q < 8; ++q) acc[q] = 0.f;
#pragma unroll
                for (int g = 0; g < 3; ++g) {
                    const float a = e[g] * isum; const u32x4 x = w[k][g];
                    acc[0] += a * bflo(x.x); acc[1] += a * bfhi(x.x); acc[2] += a * bflo(x.y); acc[3] += a * bfhi(x.y);
                    acc[4] += a * bflo(x.z); acc[5] += a * bfhi(x.z); acc[6] += a * bflo(x.w); acc[7] += a * bfhi(x.w);
                }
                u32x4 o; o.x = pkbf(acc[0], acc[1]); o.y = pkbf(acc[2], acc[3]); o.z = pkbf(acc[4], acc[5]); o.w = pkbf(acc[6], acc[7]);
                *(GAS u32x4*)(YA + (size_t)tok * 1536 + slot * 64 + d0) = o;
            }
        } else {
            u32x4 a[U], b[U], mo[U];
#pragma unroll
            for (int k = 0; k < U; ++k) { const size_t off = (size_t)(t0 + k) * 512 + 8 * lane; a[k] = *(const GAS u32x4*)(HF + off); b[k] = *(const GAS u32x4*)(HB + off); mo[k] = *(const GAS u32x4*)(MO + off); }
            const f32x4 ga = *(const GAS f32x4*)(((const GAS float*)P->ml_out_gain) + 8 * lane), gb = *(const GAS f32x4*)(((const GAS float*)P->ml_out_gain) + 8 * lane + 4);
            const float gg[8] = {ga.x, ga.y, ga.z, ga.w, gb.x, gb.y, gb.z, gb.w};
#pragma unroll
            for (int k = 0; k < U; ++k) {
                float v[8];
                v[0] = bflo(a[k].x) + bflo(b[k].x); v[1] = bfhi(a[k].x) + bfhi(b[k].x); v[2] = bflo(a[k].y) + bflo(b[k].y); v[3] = bfhi(a[k].y) + bfhi(b[k].y);
                v[4] = bflo(a[k].z) + bflo(b[k].z); v[5] = bfhi(a[k].z) + bfhi(b[k].z); v[6] = bflo(a[k].w) + bflo(b[k].w); v[7] = bfhi(a[k].w) + bfhi(b[k].w);
                float ss = 0.f;
#pragma unroll
                for (int q = 0; q < 8; ++q) ss += v[q] * v[q];
                ss += SHX(ss, 1); ss += SHX(ss, 2); ss += SHX(ss, 4); ss += SHX(ss, 8);
                const float rs = frsq(ss * (1.0f / 128.0f) + EPS);
                const u32x4 mq = mo[k];
                float mg[8]; mg[0] = bflo(mq.x); mg[1] = bfhi(mq.x); mg[2] = bflo(mq.y); mg[3] = bfhi(mq.y); mg[4] = bflo(mq.z); mg[5] = bfhi(mq.z); mg[6] = bflo(mq.w); mg[7] = bfhi(mq.w);
                float y[8];
#pragma unroll
                for (int q = 0; q < 8; ++q) y[q] = v[q] * rs * gg[q] * sigmoidf_(mg[q]);
                u32x4 o; o.x = pkbf(y[0], y[1]); o.y = pkbf(y[2], y[3]); o.z = pkbf(y[4], y[5]); o.w = pkbf(y[6], y[7]);
                *(GAS u32x4*)(YM + (size_t)(t0 + k) * 1536 + 8 * lane) = o;
            }
        }
    }
}

DI void final_norm(KPC P, int gw, int NGW, int lane) {
    const GAS float* part = (const GAS float*)(((GAS unsigned char*)P->ws) + WS_PART + 3 * SS_STRIDE);
    const GAS bf16_t* xb = (const GAS bf16_t*)(((GAS unsigned char*)P->ws) + WS_XB);
    for (int row4 = gw; row4 < T_ / 4; row4 += NGW) {
        u32x2 v[4][4]; float rs[4];
#pragma unroll
        for (int rr = 0; rr < 4; ++rr) {
            rs[rr] = part[4 * row4 + rr];
#pragma unroll
            for (int j = 0; j < 4; ++j) v[rr][j] = *((const GAS u32x2*)(xb + (size_t)(4 * row4 + rr) * DM) + lane + 64 * j);
        }
        const GAS f32x4* gr = (const GAS f32x4*)((const GAS float*)P->norm_final) + lane;
        f32x4 gv[4];
#pragma unroll
        for (int j = 0; j < 4; ++j) gv[j] = gr[64 * j];
#pragma unroll
        for (int rr = 0; rr < 4; ++rr) {
            const int row = 4 * row4 + rr; const float r1 = frsq(rs[rr] * (1.0f / 1024.0f) + EPS);
            GAS f32x4* xr = (GAS f32x4*)(((GAS float*)P->out) + (size_t)row * DM) + lane;
#pragma unroll
            for (int j = 0; j < 4; ++j) { const u32x2 w = v[rr][j]; xr[64 * j] = (f32x4){bflo(w.x), bfhi(w.x), bflo(w.y), bfhi(w.y)} * r1 * gv[j]; }
        }
    }
}

#define XB_TMO      128
#define XB_XCNT(j)  (256  + 64 * (j))
#define XB_XSUB(j)  (1280 + 64 * (j))
#define XB_XGEN(j)  (2304 + 64 * (j))
#define XB_TOP      3328
#define XB_TOPGEN   3392
#define XCD_BAR_WORDS 3456
#define XB_SPIN_CAP (1u << 22)
DI unsigned xb_ld(unsigned* p)              { return __hip_atomic_load(p, __ATOMIC_RELAXED, __HIP_MEMORY_SCOPE_AGENT); }
DI unsigned xb_add(unsigned* p, unsigned v) { return __hip_atomic_fetch_add(p, v, __ATOMIC_RELAXED, __HIP_MEMORY_SCOPE_AGENT); }
DI unsigned xb_xcc_id() { return (unsigned)__builtin_amdgcn_s_getreg((3 << 11) | 20) & 0xFu; }
#define XB_SPIN(cond, bar) do { unsigned _sp = 0; while (cond) { __builtin_amdgcn_s_sleep(1); \
    if ((++_sp & 255u) == 0u) { if (xb_ld(&(bar)[XB_TMO])) break; if (_sp > XB_SPIN_CAP) { atomicAdd(&(bar)[XB_TMO], 1u); break; } } } } while (0)
struct XcdBarrier { unsigned* bar; unsigned x; volatile LAS unsigned* st; };
DI XcdBarrier xcd_barrier_post(unsigned* bar, volatile LAS unsigned* st) {
    XcdBarrier b; b.bar = bar; b.x = xb_xcc_id(); b.st = st;
    if (threadIdx.x == 0) (void)xb_add(&bar[XB_XCNT(b.x)], 1u);
    return b;
}
DI void xcd_barrier_complete(unsigned* bar, unsigned x, unsigned& nloc, unsigned& nx) {
    const unsigned G = gridDim.x * gridDim.y * gridDim.z;
    unsigned sum, cnt, mine, sp = 0u;
    for (;;) {
        sum = 0u; cnt = 0u; mine = 0u;
#pragma unroll 1
        for (unsigned j = 0; j < 16; ++j) { const unsigned c = xb_ld(&bar[XB_XCNT(j)]); sum += c; cnt += (c > 0u) ? 1u : 0u; mine = (j == x) ? c : mine; }
        if (sum == G) break;
        __builtin_amdgcn_s_sleep(1);
        if ((++sp & 255u) == 0u) { if (xb_ld(&bar[XB_TMO])) break; if (sp > XB_SPIN_CAP) { atomicAdd(&bar[XB_TMO], 1u); break; } }
    }
    nloc = mine > 0u ? mine : 1u; nx = cnt > 0u ? cnt : 1u;
}
DI void xcd_barrier(const XcdBarrier& b) {
    asm volatile("s_waitcnt vmcnt(0)" ::: "memory");
    __syncthreads();
    if (threadIdx.x == 0) {
        unsigned* bar = b.bar;
        __builtin_amdgcn_s_waitcnt(0);
        unsigned nloc = b.st[0], nx = b.st[1];
        if (nloc == 0u) { xcd_barrier_complete(bar, b.x, nloc, nx); b.st[0] = nloc; b.st[1] = nx; }
        const unsigned old = xb_add(&bar[XB_XSUB(b.x)], 1u);
        const unsigned gen = old / nloc;
        if (old + 1u == (gen + 1u) * nloc) {
            __builtin_amdgcn_fence(__ATOMIC_RELEASE, "agent");
            asm volatile("s_waitcnt vmcnt(0)" ::: "memory");
            const unsigned og = xb_add(&bar[XB_TOP], 1u);
            const unsigned tg = og / nx;
            if (og + 1u == (tg + 1u) * nx) xb_add(&bar[XB_TOPGEN], 1u);
            else XB_SPIN(xb_ld(&bar[XB_TOPGEN]) == tg, bar);
            __builtin_amdgcn_fence(__ATOMIC_ACQUIRE, "agent");
            xb_add(&bar[XB_XGEN(b.x)], 1u);
            asm volatile("s_waitcnt vmcnt(0)" ::: "memory");
        } else {
            XB_SPIN(xb_ld(&bar[XB_XGEN(b.x)]) == gen, bar);
            __builtin_amdgcn_fence(__ATOMIC_ACQUIRE, "agent");
            asm volatile("s_waitcnt vmcnt(0)" ::: "memory");
        }
    }
    __syncthreads();
}

__global__ void __launch_bounds__(512, 2) mega_fwd(KP Pv, int step_lo, int step_hi, int coop) {
    extern __shared__ __attribute__((aligned(16))) unsigned char lds_raw[];
    LAS unsigned char* lds = (LAS unsigned char*)lds_raw;
    const int G = gridDim.x, NGW = G * 8;
    const int wave0 = __builtin_amdgcn_readfirstlane((int)threadIdx.x >> 6);
    volatile LAS unsigned* misc = (volatile LAS unsigned*)(lds + LDS_BYTES - 256);
    if (threadIdx.x < 8) misc[threadIdx.x] = 0u;
    __syncthreads();
    XcdBarrier xbar = xcd_barrier_post((unsigned*)(Pv.ws + WS_CTL) + 4096, misc);
#ifdef TS_PROBE
    if (blockIdx.x == 0 && threadIdx.x == 0) ((GAS unsigned long long*)(((GAS unsigned char*)Pv.ws) + WS_CTL + 32768))[0] = __builtin_amdgcn_s_memrealtime();
#endif
#pragma unroll 1
    for (int step = step_lo; step < step_hi; ++step) {
        unsigned mb0 = 0u; asm volatile("" : "+s"(mb0));
        int tid = wave0 * 64 + (int)__builtin_amdgcn_mbcnt_hi(~0u, __builtin_amdgcn_mbcnt_lo(~0u, mb0)); asm volatile("" : "+v"(tid));
        const int lane = tid & 63, wave = __builtin_amdgcn_readfirstlane(tid >> 6);
        int bid = blockIdx.x; asm volatile("" : "+s"(bid));
        const int gw = bid * 8 + wave;
        KPC P = (KPC)__builtin_amdgcn_kernarg_segment_ptr(); asm volatile("" : "+s"(P));
        GAS unsigned char* ws = ((GAS unsigned char*)P->ws); asm volatile("" : "+s"(ws));
        GAS unsigned* ctl = (GAS unsigned*)(ws + WS_CTL);
        bool is_gemm = false, do_sync = true, perm = true;
        pg8::Gemm g{nullptr, nullptr, 0, 0, 0};
        EpiAny E; E.kind = 0; E.aux = 0; E.goff = 0; E.ws = ws; E.kp = P;
        GAS bf16_t* xb = (GAS bf16_t*)(ws + WS_XB);
        int grp = 0, sub = -1;
        if (step >= 3 && step < 13) { grp = (step - 3) / 5; sub = (step - 3) % 5; }
        const int goff = grp * TG;
        if (step == 0) {
            prepass(P, lds, gw, NGW, wave, lane);
        } else if (step == 1) {
            is_gemm = true; g = pg8::Gemm{xb, (const GAS bf16_t*)(ws + WS_W1), T_, 2 * DFF, 1024};
            E.kind = EK_SWIGLU;
        } else if (step == 2) {
            is_gemm = true; perm = false; g = pg8::Gemm{(const GAS bf16_t*)(ws + WS_ACT), (const GAS bf16_t*)(ws + WS_W2), T_, 1024, DFF};
            E.kind = EK_RESID; E.aux = 0;
        } else if (sub == 0) {
            is_gemm = true; g = pg8::Gemm{xb + (size_t)goff * DM, (const GAS bf16_t*)(ws + WS_WIN), TG, grp ? NWIN - 256 : NWIN, 1024};
            E.kind = EK_WIN; E.goff = goff;
        } else if (sub == 1 || sub == 3) {
            if (sub == 1) {
#pragma unroll 1
                for (int u = bid; u < 512; u += G) mlstm_p1f(P, lds, grp, u >> 6, (u >> 4) & 3, u & 15, tid);
            } else {
#pragma unroll 1
                for (int u = bid; u < 512; u += G) mlstm_p3f(P, lds, grp, u >> 6, (u >> 4) & 3, u & 15, tid);
            }
            __syncthreads();
            if (sub == 1) att_wg_loop(ws, lds, bid, G, BL * 24 * 8, tid);
            else {
#pragma unroll 1
                for (int u = bid; u < BL * 4 * 8; u += G) cross_wg_unit(P, lds, grp, u, tid);
            }
        } else if (sub == 2) {
            if (grp == 0) cknorm(P, gw, NGW, lane);
#pragma unroll 1
            for (int w = bid; w < 256; w += G) mlstm_scan(ws, ((GAS float*)P->out), w, tid);
            merge_pass(P, gw, NGW, lane, true);
        } else if (sub == 4) {
            is_gemm = true; perm = false;
            g = pg8::Gemm{(const GAS bf16_t*)(ws + WS_YATT), (const GAS bf16_t*)(ws + WS_WBR), TG, 1024, 1536};
            E.kind = EK_BR0; E.goff = goff;
        } else if (step == 13) {
            is_gemm = true; perm = false; g = pg8::Gemm{(const GAS bf16_t*)((GAS unsigned char*)((GAS float*)P->out) + 32 * MiB), (const GAS bf16_t*)(ws + WS_WOUT), T_, 1024, 1024};
            E.kind = EK_RESID; E.aux = 1; E.goff = 0;
        } else if (step == 14) {
            is_gemm = true; g = pg8::Gemm{xb, (const GAS bf16_t*)(ws + WS_W3), T_, 2 * DFF, 1024};
            E.kind = EK_SWIGLU; E.aux = 1;
        } else if (step == 15) {
            is_gemm = true; perm = false; g = pg8::Gemm{(const GAS bf16_t*)(ws + WS_ACT), (const GAS bf16_t*)(ws + WS_W4), T_, 1024, DFF};
            E.kind = EK_RESID; E.aux = 2;
        } else if (step == 16) {
            final_norm(P, gw, NGW, lane); do_sync = false;
        }
        if (is_gemm) {
            const int npass = (sub == 0 && grp == 0) ? 3 : 1;
#pragma unroll 1
            for (int ps = 0; ps < npass; ++ps) {
                pg8::StaticOrder S;
                if (ps == 0) S.init(g.M, g.N, G, bid);
                else if (ps == 1) {
                    g = pg8::Gemm{(const GAS bf16_t*)(ws + WS_MEMB), (const GAS bf16_t*)(ws + WS_WMEM), MEMROWS, 1024, 1024};
                    E.kind = EK_MEMKV; perm = true;
                    const int c2 = (bid >= 64 && bid < 128) ? bid - 64 : (1 << 20);
                    S.init(MEMROWS, 1024, 64, c2);
                } else {
                    g = pg8::Gemm{xb + (size_t)TG * DM, (const GAS bf16_t*)(ws + WS_WIN) + (size_t)(NWIN - 256) * 1024, TG, 256, 1024};
                    E.kind = EK_WIN; E.aux = 40; E.goff = TG; perm = true;
                    const int c3 = (bid >= 128 && bid < 192) ? bid - 128 : (1 << 20);
                    S.init(TG, 256, 64, c3);
                }
                pg8::gemm_phase<EpiAny>(lds, g, S, E, perm, tid);
            }
        }
        __syncthreads();
#ifndef REP_SYNC
#define REP_SYNC 1
#endif
#ifdef TS_PROBE
        if (step == 17) xcd_barrier(xbar);
        if (bid == 0 && tid == 0) { asm volatile("s_waitcnt vmcnt(0)" ::: "memory"); ((GAS unsigned long long*)(ws + WS_CTL + 32768))[step + 1] = __builtin_amdgcn_s_memrealtime(); }
        if (step == 17) {
            GAS unsigned long long* ts = (GAS unsigned long long*)(ws + WS_CTL + 32768);
            if (bid == 0 && tid == 0) {
                const unsigned long long a = ts[TS_A1] - ts[TS_A0], b = ts[TS_B1] - ts[TS_B0];
                unsigned ua = (unsigned)(a / 400ull), ub = (unsigned)(b / 400ull); if (ua > 191u) ua = 191u; if (ub > 191u) ub = 191u;
                __hip_atomic_store((GAS unsigned*)(ws + WS_CTL + 49152), 7u * (ua + 192u * ub), __ATOMIC_RELAXED, __HIP_MEMORY_SCOPE_AGENT);
            }
            xcd_barrier(xbar);
            const unsigned N = __hip_atomic_load((GAS unsigned*)(ws + WS_CTL + 49152), __ATOMIC_RELAXED, __HIP_MEMORY_SCOPE_AGENT);
            for (unsigned i = (unsigned)(bid * 512 + tid); i < N; i += (unsigned)(G * 512)) ((GAS float*)P->out)[(size_t)i * 97u] += 0.1f;
        }
#endif
        if (coop && do_sync && step + 1 < step_hi) { if (coop == 2) cg::this_grid().sync(); else { for (int rp = 0; rp < REP_SYNC; ++rp) xcd_barrier(xbar); } }
    }
}

extern "C" void kernel_launch(void* const* d_in, const int* in_sizes, int n_in, void* d_out, int out_size, void* d_ws, size_t ws_size, hipStream_t stream) {
    static int grid = 0;
    if (grid == 0) {
        if (n_in != 26 || ws_size < WS_END) { fprintf(stderr, "kernel_launch: unexpected n_in %d or ws_size %zu (need %zu)\n", n_in, ws_size, (size_t)WS_END); grid = -1; return; }
        int dev = 0, cus = 0, per_cu = 0;
        hipGetDevice(&dev); hipDeviceGetAttribute(&cus, hipDeviceAttributeMultiprocessorCount, dev);
        if (hipFuncSetAttribute((const void*)mega_fwd, hipFuncAttributeMaxDynamicSharedMemorySize, LDS_BYTES) != hipSuccess) { fprintf(stderr, "kernel_launch: hipFuncSetAttribute failed\n"); }
        hipOccupancyMaxActiveBlocksPerMultiprocessor(&per_cu, (const void*)mega_fwd, 512, LDS_BYTES);
        (void)hipGetLastError();
        if (per_cu < 1) per_cu = 1;
        grid = cus;
        fprintf(stderr, "kernel_launch: cus %d per_cu %d grid %d ws %zu\n", cus, per_cu, grid, ws_size);
    }
    if (grid < 0) return;
    hipMemsetAsync((char*)d_ws + WS_CTL, 0, 65536, stream);
    KP p{};
    const float** pp = (const float**)&p;
    for (int i = 0; i < 26; ++i) pp[i] = (const float*)d_in[i];
    p.out = (float*)d_out; p.ws = (unsigned char*)d_ws;
    int lo = 0, hi = 17, coop = 1;
    void* args[] = {&p, &lo, &hi, &coop};
    hipError_t e = hipLaunchCooperativeKernel((const void*)mega_fwd, dim3(grid), dim3(512), args, LDS_BYTES, stream);
    if (e != hipSuccess) fprintf(stderr, "cooperative launch failed: %s (grid %d)\n", hipGetErrorString(e), grid);
}
```

```cpp
#include <hip/hip_runtime.h>
#include <hip/hip_cooperative_groups.h>
#include <cstdio>
#include <cstdint>
namespace cg = cooperative_groups;

#define LAS __attribute__((address_space(3)))
#define GAS __attribute__((address_space(1)))
#define DI __device__ __forceinline__
typedef unsigned short bf16_t;
typedef short bf16x8 __attribute__((ext_vector_type(8)));
typedef short s16x4 __attribute__((ext_vector_type(4)));
typedef float f32x4 __attribute__((ext_vector_type(4)));
typedef float f32x16 __attribute__((ext_vector_type(16)));
typedef unsigned u32x4 __attribute__((ext_vector_type(4)));
typedef unsigned u32x2 __attribute__((ext_vector_type(2)));

constexpr int T_ = 32768, TG = 16384, NGRP = 2, BL = 8, S_ = 2048, DM = 1024, DFF = 2816, MEMROWS = 4096;
constexpr int NWIN = 10496, NIN = 10256;
constexpr float EPS = 1e-6f;
constexpr float NEGF = -1e30f;

constexpr size_t MiB = 1u << 20;
constexpr size_t WS_CTL = 0;
constexpr size_t WS_W1 = 1 * MiB, WS_W2 = 12 * MiB, WS_WIN = 18 * MiB, WS_WMEM = 39 * MiB, WS_WBR = 41 * MiB, WS_WOUT = 44 * MiB, WS_W3 = 46 * MiB, WS_W4 = 57 * MiB;
constexpr size_t WS_ROPE = 63 * MiB;
constexpr size_t WS_SSM = 63 * MiB + 512 * 1024;
constexpr size_t WS_PART = 64 * MiB;
constexpr size_t SS_STRIDE = 131072;
constexpr size_t WS_CKV = 66 * MiB;
constexpr size_t WS_XB = 74 * MiB;
constexpr size_t WS_ACT = 138 * MiB;
constexpr size_t WS_AQ = 138 * MiB, WS_AK = 186 * MiB, WS_AV = 234 * MiB;
constexpr size_t WS_MQ = 282 * MiB;
constexpr size_t WS_MK = 298 * MiB, WS_MV = 314 * MiB, WS_MO = 330 * MiB, WS_CQ = 346 * MiB;
constexpr size_t WS_GTS = 362 * MiB;
constexpr size_t WS_MIF1 = 494 * MiB;
constexpr size_t WS_MIF = 458 * MiB;
constexpr size_t WS_LSE = 459 * MiB;
constexpr size_t WS_HF = 461 * MiB, WS_HB = 477 * MiB;
constexpr size_t WS_MEMB = 461 * MiB;
constexpr size_t WS_YATT = 186 * MiB, WS_YML = 202 * MiB, WS_YCX = 218 * MiB;
constexpr size_t WS_M32 = 234 * MiB;
constexpr size_t WS_MB16 = 298 * MiB;
constexpr size_t WS_END = 495 * MiB;

constexpr int LDS_BYTES = 163840;
constexpr int MLP = 272;
constexpr int MLT = 320;
constexpr int TB_OFF = 2 * 128 * MLP + 2 * 128 * MLT;

DI unsigned pkbf(float lo, float hi) {
    typedef float f2 __attribute__((ext_vector_type(2))); typedef __bf16 b2 __attribute__((ext_vector_type(2)));
    f2 v = {lo, hi}; b2 b = __builtin_convertvector(v, b2); return __builtin_bit_cast(unsigned, b);
}
DI float frcp(float x) { return __builtin_amdgcn_rcpf(x); }
DI float frsq(float x) { return __builtin_amdgcn_rsqf(x); }
DI float bflo(unsigned u) { return __uint_as_float(u << 16); }
DI float bfhi(unsigned u) { return __uint_as_float(u & 0xffff0000u); }
DI float shx(float v, int k, int lane) { return __int_as_float(__builtin_amdgcn_ds_bpermute((lane ^ k) << 2, __float_as_int(v))); }
DI float shup(float v, int d, int lane) { return __int_as_float(__builtin_amdgcn_ds_bpermute((lane - d) << 2, __float_as_int(v))); }
DI float rdlane(float v, int l) { return __int_as_float(__builtin_amdgcn_readlane(__float_as_int(v), l)); }
#define SHX(v, k) shx((v), (k), lane)
DI float wave_sum_l(float v, int lane) {
#pragma unroll
    for (int o = 1; o < 64; o <<= 1) v += shx(v, o, lane);
    return v;
}
#define wave_sum(v) wave_sum_l((v), lane)
DI int crow(int i, int h) { return (i & 3) + 8 * (i >> 2) + 4 * h; }
DI f32x16 mfma32(bf16x8 a, bf16x8 b, f32x16 c) { return __builtin_amdgcn_mfma_f32_32x32x16_bf16(a, b, c, 0, 0, 0); }
DI bf16x8 pack8(const f32x16& x, int s) {
    u32x4 p;
    p.x = pkbf(x[8 * s + 0], x[8 * s + 1]); p.y = pkbf(x[8 * s + 2], x[8 * s + 3]);
    p.z = pkbf(x[8 * s + 4], x[8 * s + 5]); p.w = pkbf(x[8 * s + 6], x[8 * s + 7]);
    return __builtin_bit_cast(bf16x8, p);
}
DI f32x16 zero16() { f32x16 z; for (int i = 0; i < 16; ++i) z[i] = 0.f; return z; }
typedef short v4i16_t __attribute__((ext_vector_type(4)));
DI s16x4 trread(LAS unsigned char* p) { return __builtin_bit_cast(s16x4, __builtin_amdgcn_ds_read_tr16_b64_v4i16((LAS v4i16_t*)p)); }
DI bf16x8 cat44(s16x4 lo, s16x4 hi) { return (bf16x8){lo[0], lo[1], lo[2], lo[3], hi[0], hi[1], hi[2], hi[3]}; }
#define LDS_FENCE() asm volatile("s_waitcnt lgkmcnt(0)" ::: "memory")
DI float rstd_part(const GAS float* part, int row) { return frsq(part[row] * (1.0f / 1024.0f) + EPS); }
#define MEMFENCE() asm volatile("" ::: "memory")
#define LOAD_RS8(rsv, part, row0) float rsv[2][4]; _Pragma("unroll") for (int ai_ = 0; ai_ < 2; ++ai_) _Pragma("unroll") for (int m_ = 0; m_ < 4; ++m_) rsv[ai_][m_] = (part)[(row0) + ai_ * 128 + m_ * 16]; \
    _Pragma("unroll") for (int ai_ = 0; ai_ < 2; ++ai_) _Pragma("unroll") for (int m_ = 0; m_ < 4; ++m_) rsv[ai_][m_] = frsq(rsv[ai_][m_] * (1.0f / 1024.0f) + EPS)
DI float sigmoidf_(float v) { return frcp(1.0f + __expf(-v)); }

struct KP {
    const float* x; const float* mem; const float* norm_ffn1; const float* w_ffn1_in; const float* w_ffn1_out;
    const float* norm_mix; const float* norm_mem; const float* w_in; const float* att_q_gain; const float* att_k_gain;
    const float* ml_conv_w; const float* ml_conv_b; const float* ml_gate_b; const float* ml_out_gain;
    const float* cx_q_gain; const float* cx_k_gain; const float* w_mem_kv; const float* mix_gate_b;
    const float* w_br_att; const float* w_br_ml; const float* w_br_cx; const float* w_out;
    const float* norm_ffn2; const float* w_ffn2_in; const float* w_ffn2_out; const float* norm_final;
    float* out; unsigned char* ws;
};
typedef const KP __attribute__((address_space(4)))* KPC;

enum EpiKind { EK_SWIGLU = 0, EK_RESID = 1, EK_WIN = 2, EK_MEMKV = 3, EK_BR0 = 4 };
namespace pg8 {
constexpr int BM = 256, BK = 64, HALF = 128, HTB = HALF * BK * 2, STAGE_BYTES = 8 * HTB, NXCD = 8, WGM = 8;
DI int lds_byte(int r, int c) { const int st = (r >> 4) * 2 + (c >> 5), rr = r & 15, cc = c & 31, ob = rr * 64 + cc * 2; return st * 1024 + (ob ^ (((ob >> 9) & 1) << 5)); }
DI void stage_rc(int b, int& R, int& C) { const int st = b / 1024, sb = b % 1024, swz = sb ^ (((sb >> 9) & 1) << 5); R = (st >> 1) * 16 + swz / 64; C = (st & 1) * 32 + (swz % 64) / 2; }
DI int perm32(int rho) { const int n = rho >> 4, i = rho & 15; return 8 * (i >> 2) + 4 * n + (i & 3); }
struct Unit { int pm, pn; };
struct Gemm { const GAS bf16_t* A; const GAS bf16_t* Bt; int M, N, K; };
struct StaticOrder {
    int nM, nN, nwg, G, c;
    DI void init(int M, int N, int G_, int c_) { nM = M / BM; nN = N / BM; nwg = nM * nN; G = G_; c = c_; }
    DI bool next(int i, Unit& u) const {
        const long L = (long)i * G + c; if (L >= nwg) return false;
        int wgid = (int)L; { const int q = nwg / NXCD, r = nwg % NXCD, xcd = wgid % NXCD, off = wgid / NXCD; wgid = (xcd < r ? xcd * (q + 1) : r * (q + 1) + (xcd - r) * q) + off; }
        const int nig = WGM * nN, gid = wgid / nig, fm = gid * WGM, gsz = (nM - fm) < WGM ? (nM - fm) : WGM;
        u.pm = fm + ((wgid % nig) % gsz); u.pn = (wgid % nig) / gsz; return true;
    }
};
template <class Epi>
DI void gemm_phase(LAS unsigned char* lds, const Gemm g, const StaticOrder& S, const Epi& E, const bool perm, const int tid) {
    const int wid = __builtin_amdgcn_readfirstlane(tid >> 6), lane = tid & 63, wr = wid >> 2, wc = wid & 3, fr = lane & 15, fq = lane >> 4;
    const int K = g.K, nt = K / BK;
    unsigned voffA[2], voffB[2];
#pragma unroll
    for (int i = 0; i < 2; ++i) { int R, C; stage_rc(tid * 16 + i * 8192, R, C); const int Rb = perm ? ((R & ~31) + perm32(R & 31)) : R;
        voffA[i] = (unsigned)(R * K + C) * 2u; voffB[i] = (unsigned)(Rb * K + C) * 2u; }
    const size_t kstep = (size_t)(BK * 2);
    const size_t hstep = (size_t)HALF * K * 2;
    const size_t tstep = 2 * hstep;
    const unsigned ldsw = (unsigned)wid * 1024u;
    const int aoff = lds_byte(wr * 64 + fr, fq * 8), boff = lds_byte(wc * 32 + fr, fq * 8);
#define PG8_SA(b, h) (((b) * 2 + (h)) * HTB)
#define PG8_SB(b, h) ((4 + (b) * 2 + (h)) * HTB)
#define PG8_STAGE(bufoff, gbase, voff) do { _Pragma("unroll") for (int _i = 0; _i < 2; ++_i) \
        __builtin_amdgcn_global_load_lds((const GAS unsigned*)((const char*)(gbase) + (voff)[_i]), (LAS unsigned*)(lds + (bufoff) + ldsw + _i * 8192), 16, 0, 0); } while (0)
#define PG8_LDA(dst, b, h) do { _Pragma("unroll") for (int m = 0; m < 4; ++m) _Pragma("unroll") for (int k = 0; k < 2; ++k) dst[m][k] = *(const LAS bf16x8*)(lds + PG8_SA(b, h) + aoff + m * 2048 + k * 1024); } while (0)
#define PG8_LDB(dst, b, h) do { _Pragma("unroll") for (int n = 0; n < 2; ++n) _Pragma("unroll") for (int k = 0; k < 2; ++k) dst[n][k] = *(const LAS bf16x8*)(lds + PG8_SB(b, h) + boff + n * 2048 + k * 1024); } while (0)
#define PG8_MMA(ai, bj, At, Bt) do { __builtin_amdgcn_s_setprio(1); _Pragma("unroll") for (int m = 0; m < 4; ++m) _Pragma("unroll") for (int n = 0; n < 2; ++n) _Pragma("unroll") for (int k = 0; k < 2; ++k) \
        acc[ai][bj][m][n] = __builtin_amdgcn_mfma_f32_16x16x32_bf16(Bt[n][k], At[m][k], acc[ai][bj][m][n], 0, 0, 0); __builtin_amdgcn_s_setprio(0); } while (0)
#define PG8_WAIT_V(n) asm volatile("s_waitcnt vmcnt(" #n ")" ::: "memory")
#define PG8_WAIT_L(n) asm volatile("s_waitcnt lgkmcnt(" #n ")" ::: "memory")
#define PG8_BAR __builtin_amdgcn_s_barrier()
#define PG8_SCHED __builtin_amdgcn_sched_barrier(0)
    Unit cur, nxt; int ui = 0;
    if (!S.next(0, cur)) return;
    f32x4 acc[2][2][4][2];
#pragma unroll
    for (int a = 0; a < 2; ++a)
#pragma unroll
        for (int b = 0; b < 2; ++b)
#pragma unroll
            for (int m = 0; m < 4; ++m)
#pragma unroll
                for (int n = 0; n < 2; ++n) acc[a][b][m][n] = (f32x4){0.f, 0.f, 0.f, 0.f};
    bf16x8 At[4][2], B0[2][2], B1[2][2];
    const char* cA = (const char*)g.A + (size_t)cur.pm * tstep; const char* cB = (const char*)g.Bt + (size_t)cur.pn * tstep;
    {
        PG8_STAGE(PG8_SB(0, 0), cB, voffB); PG8_STAGE(PG8_SB(0, 1), cB + hstep, voffB); PG8_STAGE(PG8_SA(0, 0), cA, voffA); PG8_STAGE(PG8_SA(0, 1), cA + hstep, voffA);
        if (wr == 1) PG8_BAR;
        PG8_WAIT_V(2); PG8_BAR;
        PG8_STAGE(PG8_SB(1, 0), cB + kstep, voffB); PG8_STAGE(PG8_SA(1, 0), cA + kstep, voffA); PG8_STAGE(PG8_SB(1, 1), cB + hstep + kstep, voffB);
        PG8_WAIT_V(6); PG8_BAR;
    }
    for (;;) {
        const bool has_next = S.next(ui + 1, nxt);
        const char* nA = has_next ? (const char*)g.A + (size_t)nxt.pm * tstep : cA; const char* nB = has_next ? (const char*)g.Bt + (size_t)nxt.pn * tstep : cB;
        for (int t = 0; t < nt; t += 2) {
            const bool last = (t == nt - 2);
            const char* a1 = cA + (size_t)(t + 1) * kstep;
            const char* a2 = last ? nA : cA + (size_t)(t + 2) * kstep; const char* b2 = last ? nB : cB + (size_t)(t + 2) * kstep;
            const char* a3 = a2 + kstep; const char* b3 = b2 + kstep;
            PG8_LDB(B0, 0, 0); PG8_LDB(B1, 0, 1); PG8_SCHED; PG8_LDA(At, 0, 0); PG8_STAGE(PG8_SA(1, 1), a1 + hstep, voffA);
            PG8_WAIT_V(8); PG8_WAIT_L(0); PG8_BAR; PG8_MMA(0, 0, At, B0); PG8_MMA(0, 1, At, B1); PG8_BAR; PG8_SCHED;
            PG8_LDA(At, 0, 1); PG8_STAGE(PG8_SB(0, 0), b2, voffB); PG8_STAGE(PG8_SB(0, 1), b2 + hstep, voffB); PG8_STAGE(PG8_SA(0, 0), a2, voffA);
            PG8_WAIT_V(8); PG8_WAIT_L(0); PG8_BAR; PG8_MMA(1, 0, At, B0); PG8_MMA(1, 1, At, B1); PG8_BAR; PG8_SCHED;
            PG8_LDB(B0, 1, 0); PG8_LDB(B1, 1, 1); PG8_SCHED; PG8_LDA(At, 1, 0); PG8_STAGE(PG8_SA(0, 1), a2 + hstep, voffA);
            PG8_WAIT_V(8); PG8_WAIT_L(0); PG8_BAR; PG8_MMA(0, 0, At, B0); PG8_MMA(0, 1, At, B1); PG8_BAR; PG8_SCHED;
            PG8_LDA(At, 1, 1); PG8_STAGE(PG8_SB(1, 0), b3, voffB); PG8_STAGE(PG8_SB(1, 1), b3 + hstep, voffB); PG8_STAGE(PG8_SA(1, 0), a3, voffA);
            PG8_WAIT_V(8); PG8_WAIT_L(0); PG8_BAR; PG8_MMA(1, 0, At, B0); PG8_MMA(1, 1, At, B1); PG8_BAR; PG8_SCHED;
            if (E.kind == EK_BR0 && (t == 6 || t == 14)) { E.hook(acc, cur, t == 6 ? 0 : 1, wr, wc, fr, fq); PG8_SCHED; }
        }
        if (wr == 0) PG8_BAR;
        E(acc, cur, wr, wc, fr, fq);
        if (!has_next) break;
#pragma unroll
        for (int a = 0; a < 2; ++a)
#pragma unroll
            for (int b = 0; b < 2; ++b)
#pragma unroll
                for (int m = 0; m < 4; ++m)
#pragma unroll
                    for (int n = 0; n < 2; ++n) acc[a][b][m][n] = (f32x4){0.f, 0.f, 0.f, 0.f};
        cur = nxt; cA = nA; cB = nB; ++ui;
        if (wr == 1) PG8_BAR;
    }
    PG8_WAIT_V(0);
    PG8_BAR;
#undef PG8_SA
#undef PG8_SB
#undef PG8_STAGE
#undef PG8_LDA
#undef PG8_LDB
#undef PG8_MMA
#undef PG8_WAIT_V
#undef PG8_WAIT_L
#undef PG8_BAR
#undef PG8_SCHED
}
}

typedef const f32x4 (&AccRef)[2][2][4][2];

struct EpiAny {
    int kind, aux, goff;
    GAS unsigned char* ws; KPC kp;

    DI void swiglu(AccRef acc, const pg8::Unit& u, int wr, int wc, int fr, int fq) const {
        const int lane = fr | (fq << 4); (void)lane;
        const int row0 = u.pm * 256 + wr * 64 + fr, col = u.pn * 128 + wc * 32 + 8 * fq;
        const GAS float* part = (const GAS float*)(ws + WS_PART + (aux ? 2 * SS_STRIDE : 0)); GAS bf16_t* xb = (GAS bf16_t*)(ws + WS_ACT);
        LOAD_RS8(rsv, part, row0);
#pragma unroll
        for (int ai = 0; ai < 2; ++ai)
#pragma unroll
            for (int m = 0; m < 4; ++m) {
                const int row = row0 + ai * 128 + m * 16; const float rs = rsv[ai][m];
                float o[8];
#pragma unroll
                for (int n = 0; n < 2; ++n)
#pragma unroll
                    for (int j = 0; j < 4; ++j) { const float gt = acc[ai][0][m][n][j] * rs, up = acc[ai][1][m][n][j] * rs; o[4 * n + j] = gt * sigmoidf_(gt) * up; }
                u32x4 w; w.x = pkbf(o[0], o[1]); w.y = pkbf(o[2], o[3]); w.z = pkbf(o[4], o[5]); w.w = pkbf(o[6], o[7]);
                *(GAS u32x4*)(xb + (size_t)row * DFF + col) = w;
                if (m & 1) MEMFENCE();
            }
    }
    DI void residual(AccRef acc, const pg8::Unit& u, int wr, int wc, int fr, int fq) const {
        const int lane = fr | (fq << 4); (void)lane;
        const int row0 = goff + u.pm * 256 + wr * 64 + fr, c0 = u.pn * 256 + wc * 32 + 4 * fq;
        const GAS float* resid = ((const GAS float*)kp->x); GAS bf16_t* xb = (GAS bf16_t*)(ws + WS_XB);
        GAS float* partw = (GAS float*)(ws + WS_PART + (size_t)(aux + 1) * SS_STRIDE); const float scale = aux == 1 ? 1.0f : 0.5f;
#pragma unroll
        for (int ai = 0; ai < 2; ++ai) {
            if (aux == 0) {
#pragma unroll
                for (int mh = 0; mh < 2; ++mh) {
                    f32x4 r[2][2][2];
#pragma unroll
                    for (int m2 = 0; m2 < 2; ++m2)
#pragma unroll
                        for (int bj = 0; bj < 2; ++bj)
#pragma unroll
                            for (int n = 0; n < 2; ++n) r[m2][bj][n] = *(const GAS f32x4*)(resid + (size_t)(row0 + ai * 128 + (2 * mh + m2) * 16) * DM + c0 + bj * 128 + n * 16);
#pragma unroll
                    for (int m2 = 0; m2 < 2; ++m2) {
                        const int m = 2 * mh + m2; const int row = row0 + ai * 128 + m * 16; float ssq = 0.f;
#pragma unroll
                        for (int bj = 0; bj < 2; ++bj)
#pragma unroll
                            for (int n = 0; n < 2; ++n) {
                                const f32x4 v = r[m2][bj][n] + acc[ai][bj][m][n] * scale;
                                u32x2 w; w.x = pkbf(v.x, v.y); w.y = pkbf(v.z, v.w); *(GAS u32x2*)(xb + (size_t)row * DM + c0 + bj * 128 + n * 16) = w;
                                ssq += (v.x * v.x + v.y * v.y) + (v.z * v.z + v.w * v.w);
                            }
                        ssq += SHX(ssq, 16); ssq += SHX(ssq, 32);
                        if (fq == 0) unsafeAtomicAdd((float*)(partw + row), ssq);
                    }
                    MEMFENCE();
                }
            } else {
                u32x2 rb[4][2][2];
#pragma unroll
                for (int m = 0; m < 4; ++m)
#pragma unroll
                    for (int bj = 0; bj < 2; ++bj)
#pragma unroll
                        for (int n = 0; n < 2; ++n) rb[m][bj][n] = *(const GAS u32x2*)(xb + (size_t)(row0 + ai * 128 + m * 16) * DM + c0 + bj * 128 + n * 16);
#pragma unroll
                for (int m = 0; m < 4; ++m) {
                    const int row = row0 + ai * 128 + m * 16; float ssq = 0.f;
#pragma unroll
                    for (int bj = 0; bj < 2; ++bj)
#pragma unroll
                        for (int n = 0; n < 2; ++n) {
                            const u32x2 q = rb[m][bj][n];
                            const f32x4 v = (f32x4){bflo(q.x), bfhi(q.x), bflo(q.y), bfhi(q.y)} + acc[ai][bj][m][n] * scale;
                            u32x2 w; w.x = pkbf(v.x, v.y); w.y = pkbf(v.z, v.w); *(GAS u32x2*)(xb + (size_t)row * DM + c0 + bj * 128 + n * 16) = w;
                            ssq += (v.x * v.x + v.y * v.y) + (v.z * v.z + v.w * v.w);
                        }
                    ssq += SHX(ssq, 16); ssq += SHX(ssq, 32);
                    if (fq == 0) unsafeAtomicAdd((float*)(partw + row), ssq);
                }
                MEMFENCE();
            }
        }
    }
    DI void memkv(AccRef acc, const pg8::Unit& u, int wr, int wc, int fr, int fq) const {
        const int lane = fr | (fq << 4); (void)lane;
        const int row0 = u.pm * 256 + wr * 64 + fr, c0 = u.pn * 256 + wc * 32 + 8 * fq;
        const GAS float* part = (const GAS float*)(ws + WS_SSM); GAS bf16_t* xb = (GAS bf16_t*)(ws + WS_CKV);
        LOAD_RS8(rsv, part, row0);
#pragma unroll
        for (int ai = 0; ai < 2; ++ai)
#pragma unroll
            for (int m = 0; m < 4; ++m) {
                const int row = row0 + ai * 128 + m * 16; const float rs = rsv[ai][m];
#pragma unroll
                for (int bj = 0; bj < 2; ++bj) {
                    const f32x4 a = acc[ai][bj][m][0] * rs, b = acc[ai][bj][m][1] * rs;
                    u32x4 w; w.x = pkbf(a.x, a.y); w.y = pkbf(a.z, a.w); w.z = pkbf(b.x, b.y); w.w = pkbf(b.z, b.w);
                    *(GAS u32x4*)(xb + (size_t)row * 1024 + c0 + bj * 128) = w;
                }
            }
    }
    DI void hook(f32x4 (&acc)[2][2][4][2], const pg8::Unit& u, int seg, int wr, int wc, int fr, int fq) const {
        asm volatile("" : "+v"(fr), "+v"(fq));
        const int row0 = u.pm * 256 + wr * 64 + fr, c0 = u.pn * 256 + wc * 32 + 4 * fq;
        const GAS bf16_t* gts = (const GAS bf16_t*)(ws + WS_GTS) + seg * 1024 + (size_t)row0 * 3072 + c0; const GAS float* gbias = ((const GAS float*)kp->mix_gate_b) + seg * 1024 + c0;
#pragma unroll
        for (int bj = 0; bj < 2; ++bj)
#pragma unroll
            for (int n = 0; n < 2; ++n) {
                u32x2 w0[2][4], w1[2][4];
#pragma unroll
                for (int ai = 0; ai < 2; ++ai)
#pragma unroll
                    for (int m = 0; m < 4; ++m) {
                        const GAS bf16_t* gr = gts + (size_t)(ai * 128 + m * 16) * 3072 + bj * 128 + n * 16;
                        w0[ai][m] = *(const GAS u32x2*)gr; w1[ai][m] = *(const GAS u32x2*)(gr + 1024);
                    }
                const f32x4 b0 = *(const GAS f32x4*)(gbias + bj * 128 + n * 16), b1 = *(const GAS f32x4*)(gbias + 1024 + bj * 128 + n * 16);
#pragma unroll
                for (int ai = 0; ai < 2; ++ai)
#pragma unroll
                    for (int m = 0; m < 4; ++m) {
                        const u32x2 a0 = w0[ai][m], a1 = w1[ai][m];
                        f32x4 rt;
                        rt.x = (1.0f + __expf(-(bflo(a1.x) + b1.x))) * frcp(1.0f + __expf(-(bflo(a0.x) + b0.x)));
                        rt.y = (1.0f + __expf(-(bfhi(a1.x) + b1.y))) * frcp(1.0f + __expf(-(bfhi(a0.x) + b0.y)));
                        rt.z = (1.0f + __expf(-(bflo(a1.y) + b1.z))) * frcp(1.0f + __expf(-(bflo(a0.y) + b0.z)));
                        rt.w = (1.0f + __expf(-(bfhi(a1.y) + b1.w))) * frcp(1.0f + __expf(-(bfhi(a0.y) + b0.w)));
                        acc[ai][bj][m][n] = acc[ai][bj][m][n] * rt;
                    }
                MEMFENCE();
            }
    }
    DI void branch_final(AccRef acc, const pg8::Unit& u, int wr, int wc, int fr, int fq) const {
        const int lane = fr | (fq << 4); (void)lane;
        const int row0 = u.pm * 256 + wr * 64 + fr, c0 = u.pn * 256 + wc * 32 + 4 * fq;
        const GAS bf16_t* gts = (const GAS bf16_t*)(ws + WS_GTS) + 2048 + (size_t)row0 * 3072 + c0; const GAS float* gbias = ((const GAS float*)kp->mix_gate_b) + 2048 + c0;
        GAS bf16_t* mb16 = (GAS bf16_t*)((GAS unsigned char*)((GAS float*)kp->out) + 32 * MiB) + (size_t)(goff + row0) * DM + c0;
#pragma unroll
        for (int bj = 0; bj < 2; ++bj) {
            u32x2 gw[2][4][2];
#pragma unroll
            for (int ai = 0; ai < 2; ++ai)
#pragma unroll
                for (int m = 0; m < 4; ++m)
#pragma unroll
                    for (int n = 0; n < 2; ++n) gw[ai][m][n] = *(const GAS u32x2*)(gts + (size_t)(ai * 128 + m * 16) * 3072 + bj * 128 + n * 16);
#pragma unroll
            for (int n = 0; n < 2; ++n) {
                const f32x4 gb = *(const GAS f32x4*)(gbias + bj * 128 + n * 16);
#pragma unroll
                for (int ai = 0; ai < 2; ++ai)
#pragma unroll
                    for (int m = 0; m < 4; ++m) {
                        const u32x2 g2 = gw[ai][m][n];
                        f32x4 gv; gv.x = sigmoidf_(bflo(g2.x) + gb.x); gv.y = sigmoidf_(bfhi(g2.x) + gb.y); gv.z = sigmoidf_(bflo(g2.y) + gb.z); gv.w = sigmoidf_(bfhi(g2.y) + gb.w);
                        const f32x4 v = gv * acc[ai][bj][m][n];
                        u32x2 w; w.x = pkbf(v.x, v.y); w.y = pkbf(v.z, v.w); *(GAS u32x2*)(mb16 + (size_t)(ai * 128 + m * 16) * DM + bj * 128 + n * 16) = w;
                    }
            }
            MEMFENCE();
        }
    }
    DI void win(AccRef acc, const pg8::Unit& u, int wr, int wc, int fr, int fq) const {
        const int lane = fr | (fq << 4); (void)lane;
        const int row0 = u.pm * 256 + wr * 64 + fr; const int pn = u.pn + aux;
        const GAS float* part = (const GAS float*)(ws + WS_PART + SS_STRIDE) + goff;
        if (pn < 12) {
            const int isk = pn >= 6 ? 1 : 0; const int hh = 4 * (pn - 6 * isk) + wc; const int gi = hh >> 3, sh = 2 * gi;
            const GAS float* gain = isk ? ((const GAS float*)kp->att_k_gain) : ((const GAS float*)kp->att_q_gain); const float qs = isk ? 1.0f : 0.125f;
            GAS bf16_t* dst = (GAS bf16_t*)(ws + (isk ? WS_AK : WS_AQ));
            const GAS float* rc = (const GAS float*)(ws + WS_ROPE); const GAS float* rsn = rc + 2048 * 32;
#pragma unroll
            for (int ai = 0; ai < 2; ++ai)
#pragma unroll
                for (int m = 0; m < 4; ++m) {
                    const int row = row0 + ai * 128 + m * 16; const float rs = rstd_part(part, row);
                    const int bl = row >> 11, s = row & 2047;
                    float ss = 0.f;
#pragma unroll
                    for (int bj = 0; bj < 2; ++bj)
#pragma unroll
                        for (int n = 0; n < 2; ++n) { const f32x4 v = acc[ai][bj][m][n]; ss += (v.x * v.x + v.y * v.y) + (v.z * v.z + v.w * v.w); }
                    ss *= rs * rs;
                    ss += SHX(ss, 16); ss += SHX(ss, 32);
                    const float rh = rs * qs * frsq(ss * (1.0f / 64.0f) + EPS);
                    const int perm = ((s & ((1 << sh) - 1)) << (11 - sh)) + (s >> sh);
                    GAS bf16_t* d = dst + ((size_t)(bl * 24 + hh) * 2048 + perm) * 64 + 8 * fq;
                    u32x2 w1[2], w2[2];
#pragma unroll
                    for (int n = 0; n < 2; ++n) {
                        const f32x4 ga = *(const GAS f32x4*)(gain + 8 * fq + 4 * n), gb = *(const GAS f32x4*)(gain + 32 + 8 * fq + 4 * n);
                        const f32x4 c = *(const GAS f32x4*)(rc + s * 32 + 8 * fq + 4 * n), sn = *(const GAS f32x4*)(rsn + s * 32 + 8 * fq + 4 * n);
                        const f32x4 v1 = acc[ai][0][m][n] * ga * rh, v2 = acc[ai][1][m][n] * gb * rh;
                        const f32x4 o1 = v1 * c - v2 * sn, o2 = v2 * c + v1 * sn;
                        w1[n].x = pkbf(o1.x, o1.y); w1[n].y = pkbf(o1.z, o1.w);
                        w2[n].x = pkbf(o2.x, o2.y); w2[n].y = pkbf(o2.z, o2.w);
                    }
                    *(GAS u32x4*)d = (u32x4){w1[0].x, w1[0].y, w1[1].x, w1[1].y}; *(GAS u32x4*)(d + 32) = (u32x4){w2[0].x, w2[0].y, w2[1].x, w2[1].y};
                    MEMFENCE();
                }
        } else if (pn < 18) {
            LOAD_RS8(rsv, part, row0);
            GAS bf16_t* dst = (GAS bf16_t*)(ws + WS_AV);
#pragma unroll
            for (int bj = 0; bj < 2; ++bj) {
                const int hh = 4 * (pn - 12) + 2 * bj + (wc >> 1), d0 = 32 * (wc & 1) + 8 * fq; const int gi = hh >> 3, sh = 2 * gi;
#pragma unroll
                for (int ai = 0; ai < 2; ++ai)
#pragma unroll
                    for (int m = 0; m < 4; ++m) {
                        const int row = row0 + ai * 128 + m * 16; const float rs = rsv[ai][m];
                        const int bl = row >> 11, s = row & 2047;
                        const int perm = ((s & ((1 << sh) - 1)) << (11 - sh)) + (s >> sh);
                        const f32x4 a = acc[ai][bj][m][0] * rs, b = acc[ai][bj][m][1] * rs;
                        u32x4 w; w.x = pkbf(a.x, a.y); w.y = pkbf(a.z, a.w); w.z = pkbf(b.x, b.y); w.w = pkbf(b.z, b.w);
                        *(GAS u32x4*)(dst + ((size_t)(bl * 24 + hh) * 2048 + perm) * 64 + d0) = w;
                        if (m & 1) MEMFENCE();
                    }
            }
        } else if (pn < 40) {
            LOAD_RS8(rsv, part, row0);
            GAS bf16_t* dst; int ld, colt;
            if (pn < 28) { const int seg = (pn - 18) >> 1; dst = (GAS bf16_t*)(ws + WS_MQ) + (size_t)seg * TG * 512; ld = 512; colt = 256 * ((pn - 18) & 1); }
            else { dst = (GAS bf16_t*)(ws + WS_GTS); ld = 3072; colt = 256 * (pn - 28); }
            const int c0 = colt + wc * 32 + 8 * fq;
#pragma unroll
            for (int ai = 0; ai < 2; ++ai)
#pragma unroll
                for (int m = 0; m < 4; ++m) {
                    const int row = row0 + ai * 128 + m * 16; const float rs = rsv[ai][m];
#pragma unroll
                    for (int bj = 0; bj < 2; ++bj) {
                        const f32x4 a = acc[ai][bj][m][0] * rs, b = acc[ai][bj][m][1] * rs;
                        u32x4 w; w.x = pkbf(a.x, a.y); w.y = pkbf(a.z, a.w); w.z = pkbf(b.x, b.y); w.w = pkbf(b.z, b.w);
                        if (pn >= 28) __builtin_nontemporal_store(w, (GAS u32x4*)(dst + (size_t)row * ld + c0 + bj * 128));
                        else *(GAS u32x4*)(dst + (size_t)row * ld + c0 + bj * 128) = w;
                    }
                    if (m & 1) MEMFENCE();
                }
        } else {
            if (wc == 0 && fq < 2) {
                LOAD_RS8(rsv, part, row0);
                GAS float* dst = (GAS float*)(ws + (goff ? WS_MIF1 : WS_MIF));
#pragma unroll
                for (int ai = 0; ai < 2; ++ai)
#pragma unroll
                    for (int m = 0; m < 4; ++m) {
                        const int row = row0 + ai * 128 + m * 16; const float rs = rsv[ai][m];
                        *(GAS f32x4*)(dst + (size_t)row * 16 + 8 * fq) = acc[ai][0][m][0] * rs;
                        *(GAS f32x4*)(dst + (size_t)row * 16 + 8 * fq + 4) = acc[ai][0][m][1] * rs;
                    }
            }
        }
    }
    DI void operator()(AccRef acc, const pg8::Unit& u, int wr, int wc, int fr, int fq) const {
        asm volatile("" : "+v"(fr), "+v"(fq));
        switch (kind) {
#ifndef NO_E0
            case EK_SWIGLU: swiglu(acc, u, wr, wc, fr, fq); break;
#endif
#ifndef NO_E1
            case EK_RESID: residual(acc, u, wr, wc, fr, fq); break;
#endif
#ifndef NO_E2
            case EK_WIN: win(acc, u, wr, wc, fr, fq); break;
#endif
#ifndef NO_E3
            case EK_MEMKV: memkv(acc, u, wr, wc, fr, fq); break;
#endif
#ifndef NO_E4
            default: branch_final(acc, u, wr, wc, fr, fq); break;
#else
            default: break;
#endif
        }
    }
};

DI int colmap(int mk, int n) {
    if (mk == 0) return n;
    if (mk == 1) { const int pn = n >> 8, bj = (n >> 7) & 1, i0 = n & 127; return bj * DFF + 128 * pn + i0; }
    const int pn = n >> 8, within = n & 255, bj = within >> 7, wc = (within >> 5) & 3, i = within & 31;
    if (pn < 12) { const int seg = pn >= 6 ? 1 : 0; const int hh = 4 * (pn - 6 * seg) + wc; return seg * 1536 + 64 * hh + 32 * bj + i; }
    if (pn < 18) return 3072 + (n - 12 * 256);
    if (pn < 26) return 4608 + (n - 18 * 256);
    if (pn < 28) return 6672 + (n - 26 * 256);
    if (pn < 40) return 7184 + (n - 28 * 256);
    return n < 10256 ? 6656 + (n - 10240) : -1;
}
DI void tr_item64(const GAS float* __restrict__ W, int ldw, int mk, const GAS float* __restrict__ gain, GAS bf16_t* Bt, int K, int n0, int k0, LAS float* scr, int lane) {
    const int nl = (lane & 15) * 4, kr = lane >> 4;
    const int src = colmap(mk, n0 + nl);
    f32x4 v[16];
#pragma unroll
    for (int i = 0; i < 16; ++i) {
        const int k = k0 + kr + 4 * i; v[i] = (f32x4){0.f, 0.f, 0.f, 0.f};
        if (src >= 0) { v[i] = __builtin_nontemporal_load((const GAS f32x4*)(W + (size_t)k * ldw + src)); if (gain) v[i] = v[i] * gain[k]; }
    }
#pragma unroll
    for (int i = 0; i < 16; ++i) { LAS float* d = scr + (kr + 4 * i) * 65 + nl; d[0] = v[i].x; d[1] = v[i].y; d[2] = v[i].z; d[3] = v[i].w; }
    LDS_FENCE();
    const int c = lane & 7;
#pragma unroll
    for (int j = 0; j < 8; ++j) {
        const int n = (lane >> 3) + 8 * j; const LAS float* sp = scr + (8 * c) * 65 + n;
        u32x4 o; o.x = pkbf(sp[0 * 65], sp[1 * 65]); o.y = pkbf(sp[2 * 65], sp[3 * 65]); o.z = pkbf(sp[4 * 65], sp[5 * 65]); o.w = pkbf(sp[6 * 65], sp[7 * 65]);
        *(GAS u32x4*)(Bt + (size_t)(n0 + n) * K + k0 + 8 * c) = o;
    }
    LDS_FENCE();
}
DI void prepass(KPC P, LAS unsigned char* lds, int gw, int NGW, int wave, int lane) {
    LAS float* scr = (LAS float*)(lds + wave * 16640);
    GAS unsigned char* ws = ((GAS unsigned char*)P->ws);
    constexpr int I1 = 16 * 88, I2 = 44 * 16, I3 = 16 * 164, I4 = 16 * 16, I5 = 8 * 16, I6 = 16 * 16;
    constexpr int NIT = I1 + I2 + I3 + I4 + 3 * I5 + I6 + I1 + I2;
    for (int it = gw; it < NIT; it += NGW) {
        int r = it;
        if (r < I1) { const int kb = r / 88, nb = r % 88; tr_item64(((const GAS float*)P->w_ffn1_in), 2 * DFF, 1, ((const GAS float*)P->norm_ffn1), (GAS bf16_t*)(ws + WS_W1), 1024, 64 * nb, 64 * kb, scr, lane); continue; } r -= I1;
        if (r < I2) { const int kb = r / 16, nb = r % 16; tr_item64(((const GAS float*)P->w_ffn1_out), 1024, 0, nullptr, (GAS bf16_t*)(ws + WS_W2), DFF, 64 * nb, 64 * kb, scr, lane); continue; } r -= I2;
        if (r < I3) { const int kb = r / 164, nb = r % 164; tr_item64(((const GAS float*)P->w_in), NIN, 2, ((const GAS float*)P->norm_mix), (GAS bf16_t*)(ws + WS_WIN), 1024, 64 * nb, 64 * kb, scr, lane); continue; } r -= I3;
        if (r < I4) { const int kb = r / 16, nb = r % 16; tr_item64(((const GAS float*)P->w_mem_kv), 1024, 0, ((const GAS float*)P->norm_mem), (GAS bf16_t*)(ws + WS_WMEM), 1024, 64 * nb, 64 * kb, scr, lane); continue; } r -= I4;
        if (r < 3 * I5) { const int b = r / I5, q = r % I5, kb = q / 16, nb = q % 16; const GAS float* w = b == 0 ? ((const GAS float*)P->w_br_att) : (b == 1 ? ((const GAS float*)P->w_br_ml) : ((const GAS float*)P->w_br_cx));
            tr_item64(w, 1024, 0, nullptr, (GAS bf16_t*)(ws + WS_WBR) + (size_t)b * 512, 1536, 64 * nb, 64 * kb, scr, lane); continue; } r -= 3 * I5;
        if (r < I6) { const int kb = r / 16, nb = r % 16; tr_item64(((const GAS float*)P->w_out), 1024, 0, nullptr, (GAS bf16_t*)(ws + WS_WOUT), 1024, 64 * nb, 64 * kb, scr, lane); continue; } r -= I6;
        if (r < I1) { const int kb = r / 88, nb = r % 88; tr_item64(((const GAS float*)P->w_ffn2_in), 2 * DFF, 1, ((const GAS float*)P->norm_ffn2), (GAS bf16_t*)(ws + WS_W3), 1024, 64 * nb, 64 * kb, scr, lane); continue; } r -= I1;
        { const int kb = r / 16, nb = r % 16; tr_item64(((const GAS float*)P->w_ffn2_out), 1024, 0, nullptr, (GAS bf16_t*)(ws + WS_W4), DFF, 64 * nb, 64 * kb, scr, lane); }
    }
    GAS bf16_t* xb = (GAS bf16_t*)(ws + WS_XB); GAS float* part = (GAS float*)(ws + WS_PART);
    GAS bf16_t* memb = (GAS bf16_t*)(ws + WS_MEMB); GAS float* ssm = (GAS float*)(ws + WS_SSM);
    for (int m4 = gw; m4 < (T_ + MEMROWS) / 4; m4 += NGW) {
        const bool isx = m4 < T_ / 4; const int row0 = isx ? 4 * m4 : 4 * m4 - T_;
        const GAS f32x4* xr = (const GAS f32x4*)((isx ? ((const GAS float*)P->x) : ((const GAS float*)P->mem)) + (size_t)row0 * DM) + lane;
        GAS unsigned long long* o8 = (GAS unsigned long long*)((isx ? xb : memb) + (size_t)row0 * DM) + lane;
        f32x4 v[4][4];
#pragma unroll
        for (int rr = 0; rr < 4; ++rr)
#pragma unroll
            for (int j = 0; j < 4; ++j) v[rr][j] = __builtin_nontemporal_load(xr + rr * 256 + 64 * j);
#pragma unroll
        for (int rr = 0; rr < 4; ++rr) {
            float sq = 0.f;
#pragma unroll
            for (int j = 0; j < 4; ++j) { const f32x4 t = v[rr][j]; sq += (t.x * t.x + t.y * t.y) + (t.z * t.z + t.w * t.w);
                o8[rr * 256 + 64 * j] = (unsigned long long)pkbf(t.x, t.y) | ((unsigned long long)pkbf(t.z, t.w) << 32); }
            sq = wave_sum(sq);
            const int row = row0 + rr;
            if (isx) { if (lane < 4) part[(size_t)lane * (SS_STRIDE / 4) + row] = lane == 0 ? sq : 0.f; }
            else if (lane == 0) ssm[row] = sq;
        }
    }
    GAS float* rc = (GAS float*)(ws + WS_ROPE); GAS float* rsn = rc + 2048 * 32;
    for (int i = gw * 64 + lane; i < 2048 * 32; i += NGW * 64) {
        const int sq = i >> 5, d = i & 31; const float inv = powf(10000.0f, -(float)(2 * d) / 64.0f); const float ang = (float)sq * inv;
        rc[i] = cosf(ang); rsn[i] = sinf(ang);
    }
}

DI void cknorm(KPC P, int gw, int NGW, int lane) {
    GAS bf16_t* ckv = (GAS bf16_t*)(((GAS unsigned char*)P->ws) + WS_CKV);
    for (int it = gw; it < MEMROWS * 4; it += NGW) {
        const int row = it >> 2, hd = it & 3; GAS unsigned* p = (GAS unsigned*)(ckv + (size_t)row * 1024 + hd * 128) + lane;
        const unsigned w = *p; const float a = bflo(w), b = bfhi(w);
        const float ss = wave_sum(a * a + b * b); const float rs = frsq(ss * (1.0f / 128.0f) + EPS);
        *p = pkbf(a * rs * ((const GAS float*)P->cx_k_gain)[2 * lane], b * rs * ((const GAS float*)P->cx_k_gain)[2 * lane + 1]);
    }
}

template <int D, int NKB, bool BAND>
DI void attn_pass(const GAS bf16_t* Kb, const GAS bf16_t* Vb, long pitch, unsigned vmask, const bf16x8 (&qf)[D / 16],
                  float& m, float& l, f32x16 (&o)[D / 32], LAS unsigned char* vs, int lane) {
    const int r = lane & 31, h = lane >> 5;
    f32x16 st[NKB];
#pragma unroll
    for (int kb = 0; kb < NKB; ++kb) {
        if (vmask & (1u << kb)) {
            const GAS bf16_t* kr = Kb + (long)(32 * kb + r) * pitch + 8 * h;
            f32x16 a = zero16();
#pragma unroll
            for (int ks = 0; ks < D / 16; ++ks) a = mfma32(*(const GAS bf16x8*)(kr + 16 * ks), qf[ks], a);
            st[kb] = a;
            MEMFENCE();
        } else {
#pragma unroll
            for (int i = 0; i < 16; ++i) st[kb][i] = NEGF;
        }
    }
    if (BAND) {
#pragma unroll
        for (int i = 0; i < 16; ++i) { const int jj = crow(i, h); if (jj < r) st[0][i] = NEGF; if (jj > r) st[NKB - 1][i] = NEGF; }
    }
    float bm = NEGF;
#pragma unroll
    for (int kb = 0; kb < NKB; ++kb)
#pragma unroll
        for (int i = 0; i < 16; ++i) bm = fmaxf(bm, st[kb][i]);
    bm = fmaxf(bm, SHX(bm, 32));
    const float mn = fmaxf(m, bm); const float alpha = __expf(m - mn);
    float ls = 0.f;
#pragma unroll
    for (int kb = 0; kb < NKB; ++kb)
#pragma unroll
        for (int i = 0; i < 16; ++i) { const float p = __expf(st[kb][i] - mn); st[kb][i] = p; ls += p; }
    ls += SHX(ls, 32);
    l = l * alpha + ls; m = mn;
#pragma unroll
    for (int d0 = 0; d0 < D / 32; ++d0)
#pragma unroll
        for (int i = 0; i < 16; ++i) o[d0][i] *= alpha;
    const int q4 = (lane & 15) >> 2, p4 = lane & 3, blk = (lane >> 4) & 1;
    LAS unsigned char* vrd = vs + q4 * (2 * D) + 32 * blk + 8 * p4;
#pragma unroll
    for (int kb = 0; kb < NKB; ++kb) {
        if (vmask & (1u << kb)) {
            constexpr int CPR = D / 8;
#pragma unroll
            for (int t = 0; t < (32 * CPR) / 64; ++t) {
                const int ci = lane + 64 * t, row = ci / CPR, ch = ci % CPR;
                const u32x4 v = *(const GAS u32x4*)(Vb + (long)(32 * kb + row) * pitch + 8 * ch);
                *(LAS u32x4*)(vs + row * (2 * D) + ch * 16) = v;
                if ((t & 3) == 3) MEMFENCE();
            }
            LDS_FENCE();
#pragma unroll
            for (int ks2 = 0; ks2 < 2; ++ks2) {
                const bf16x8 pb = pack8(st[kb], ks2);
#pragma unroll
                for (int d0 = 0; d0 < D / 32; ++d0) {
                    const s16x4 lo = trread(vrd + (16 * ks2 + 4 * h) * (2 * D) + 64 * d0);
                    const s16x4 hi = trread(vrd + (16 * ks2 + 8 + 4 * h) * (2 * D) + 64 * d0);
                    o[d0] = mfma32(cat44(lo, hi), pb, o[d0]);
                }
            }
            LDS_FENCE();
        }
    }
}

DI void att_unit(GAS unsigned char* ws, int u, LAS unsigned char* vs, int lane, bool dry) {
    const int r = lane & 31, h = lane >> 5;
    const int qblk = u & 63, hb = u >> 6, head = hb % 24, bl = hb / 24;
    const int gi = head >> 3, slot = head & 7, sh = 2 * gi, n = 2048 >> sh;
    const int prow = 32 * qblk, c = prow >> (11 - sh), i0 = prow & (n - 1);
    const size_t hbase = (size_t)(bl * 24 + head) * 2048 * 64;
    GAS bf16_t* Q = (GAS bf16_t*)(ws + WS_AQ) + hbase; const GAS bf16_t* K = (const GAS bf16_t*)(ws + WS_AK) + hbase; const GAS bf16_t* V = (const GAS bf16_t*)(ws + WS_AV) + hbase;
    bf16x8 qf[4];
#pragma unroll
    for (int ks = 0; ks < 4; ++ks) qf[ks] = *(const GAS bf16x8*)(Q + (size_t)(prow + r) * 64 + 16 * ks + 8 * h);
    unsigned vmask = 0;
#pragma unroll
    for (int kb = 0; kb < 5; ++kb) { const int j0 = i0 - 64 + 32 * kb; if (j0 >= 0 && j0 < n) vmask |= 1u << kb; }
    vmask = __builtin_amdgcn_readfirstlane(vmask);
    float m = NEGF, l = 0.f; f32x16 o[2]; o[0] = zero16(); o[1] = zero16();
    attn_pass<64, 5, true>(K + (long)(prow - 64) * 64, V + (long)(prow - 64) * 64, 64, vmask, qf, m, l, o, vs, lane);
    if (dry) return;
    const float inv = frcp(l);
    GAS bf16_t* orow = Q + (size_t)(prow + r) * 64;
#pragma unroll
    for (int d0 = 0; d0 < 2; ++d0)
#pragma unroll
        for (int g4 = 0; g4 < 4; ++g4) {
            u32x2 w; w.x = pkbf(o[d0][4 * g4] * inv, o[d0][4 * g4 + 1] * inv); w.y = pkbf(o[d0][4 * g4 + 2] * inv, o[d0][4 * g4 + 3] * inv);
            *(GAS u32x2*)(orow + 32 * d0 + 8 * g4 + 4 * h) = w;
        }
    if (h == 0) {
        const int s = c + ((i0 + r) << sh);
        GAS float* lse = (GAS float*)(ws + WS_LSE);
        lse[((size_t)gi * TG + (size_t)bl * 2048 + s) * 8 + slot] = m + __logf(l);
    }
}

DI void cross_unit(KPC P, int grp, int u, LAS unsigned char* vs, int lane, bool dry) {
    const int r = lane & 31, h = lane >> 5;
    const int qblk = u & 63, head = (u >> 6) & 3, bl = u >> 8;
    GAS bf16_t* qrow = (GAS bf16_t*)(((GAS unsigned char*)P->ws) + WS_CQ) + ((size_t)bl * 2048 + 32 * qblk + r) * 512 + head * 128;
    bf16x8 qf[8]; float ss = 0.f;
#pragma unroll
    for (int ks = 0; ks < 8; ++ks) { qf[ks] = *(const GAS bf16x8*)(qrow + 16 * ks + 8 * h);
        const u32x4 w = __builtin_bit_cast(u32x4, qf[ks]);
        ss += (bflo(w.x) * bflo(w.x) + bfhi(w.x) * bfhi(w.x)) + (bflo(w.y) * bflo(w.y) + bfhi(w.y) * bfhi(w.y)) + (bflo(w.z) * bflo(w.z) + bfhi(w.z) * bfhi(w.z)) + (bflo(w.w) * bflo(w.w) + bfhi(w.w) * bfhi(w.w)); }
    ss += SHX(ss, 32);
    const float rq = (frsq(ss * (1.0f / 128.0f) + EPS)) * 0.08838834764831845f;
#pragma unroll
    for (int ks = 0; ks < 8; ++ks) {
        const u32x4 w = __builtin_bit_cast(u32x4, qf[ks]); const GAS float* g = ((const GAS float*)P->cx_q_gain) + 16 * ks + 8 * h;
        const f32x4 ga = *(const GAS f32x4*)g, gb = *(const GAS f32x4*)(g + 4);
        u32x4 o; o.x = pkbf(bflo(w.x) * rq * ga.x, bfhi(w.x) * rq * ga.y); o.y = pkbf(bflo(w.y) * rq * ga.z, bfhi(w.y) * rq * ga.w);
        o.z = pkbf(bflo(w.z) * rq * gb.x, bfhi(w.z) * rq * gb.y); o.w = pkbf(bflo(w.w) * rq * gb.z, bfhi(w.w) * rq * gb.w);
        qf[ks] = __builtin_bit_cast(bf16x8, o);
    }
    const GAS bf16_t* K = (const GAS bf16_t*)(((GAS unsigned char*)P->ws) + WS_CKV) + (size_t)(grp * BL + bl) * 256 * 1024 + head * 128;
    const GAS bf16_t* V = K + 512;
    float m = NEGF, l = 0.f; f32x16 o[4];
#pragma unroll
    for (int d0 = 0; d0 < 4; ++d0) o[d0] = zero16();
#pragma unroll 1
    for (int ps = 0; ps < 4; ++ps) attn_pass<128, 2, false>(K + (size_t)ps * 64 * 1024, V + (size_t)ps * 64 * 1024, 1024, 0x3u, qf, m, l, o, vs, lane);
    if (dry) return;
    const float inv = frcp(l);
#pragma unroll
    for (int d0 = 0; d0 < 4; ++d0)
#pragma unroll
        for (int g4 = 0; g4 < 4; ++g4) {
            u32x2 w; w.x = pkbf(o[d0][4 * g4] * inv, o[d0][4 * g4 + 1] * inv); w.y = pkbf(o[d0][4 * g4 + 2] * inv, o[d0][4 * g4 + 3] * inv);
            *(GAS u32x2*)(qrow + 32 * d0 + 8 * g4 + 4 * h) = w;
        }
}

DI float scan_add(float v, int lane) {
#pragma unroll
    for (int d = 1; d < 64; d <<= 1) { const float t = shup(v, d, lane); if (lane >= d) v += t; }
    return v;
}
DI float scan_max(float v, int lane) {
#pragma unroll
    for (int d = 1; d < 64; d <<= 1) { const float t = shup(v, d, lane); if (lane >= d) v = fmaxf(v, t); }
    return v;
}
DI float log_sigmoid(float x) { return x >= 0.f ? -log1pf(__expf(-x)) : x - log1pf(__expf(x)); }

template <int D, int NKB, bool BAND>
DI void attn_pass_lds(LAS unsigned char* Kimg, LAS unsigned char* Vimg, unsigned vmask, const bf16x8 (&qf)[D / 16],
                      float& m, float& l, f32x16 (&o)[D / 32], int lane) {
    constexpr int PB = 2 * D + 16;
    constexpr int PBV = (D == 64) ? 192 : 320;
    const int r = lane & 31, h = lane >> 5;
    f32x16 st[NKB];
#pragma unroll
    for (int kb = 0; kb < NKB; ++kb) {
        if (vmask & (1u << kb)) {
            LAS unsigned char* kr = Kimg + (32 * kb + r) * PB + 16 * h;
            f32x16 a = zero16();
#pragma unroll
            for (int ks = 0; ks < D / 16; ++ks) a = mfma32(*(const LAS bf16x8*)(kr + 32 * ks), qf[ks], a);
            st[kb] = a;
        } else {
#pragma unroll
            for (int i = 0; i < 16; ++i) st[kb][i] = NEGF;
        }
    }
    if (BAND) {
#pragma unroll
        for (int i = 0; i < 16; ++i) { const int jj = crow(i, h); if (jj < r) st[0][i] = NEGF; if (jj > r) st[NKB - 1][i] = NEGF; }
    }
    float bm = NEGF;
#pragma unroll
    for (int kb = 0; kb < NKB; ++kb)
#pragma unroll
        for (int i = 0; i < 16; ++i) bm = fmaxf(bm, st[kb][i]);
    bm = fmaxf(bm, SHX(bm, 32));
    const float mn = fmaxf(m, bm); const float alpha = __expf(m - mn);
    float ls = 0.f;
#pragma unroll
    for (int kb = 0; kb < NKB; ++kb)
#pragma unroll
        for (int i = 0; i < 16; ++i) { const float p = __expf(st[kb][i] - mn); st[kb][i] = p; ls += p; }
    ls += SHX(ls, 32);
    l = l * alpha + ls; m = mn;
#pragma unroll
    for (int d0 = 0; d0 < D / 32; ++d0)
#pragma unroll
        for (int i = 0; i < 16; ++i) o[d0][i] *= alpha;
    LAS unsigned char* vrd = Vimg + ((lane & 15) >> 2) * PBV + 32 * ((lane >> 4) & 1) + 8 * (lane & 3);
#pragma unroll
    for (int kb = 0; kb < NKB; ++kb) {
        if (vmask & (1u << kb)) {
#pragma unroll
            for (int ks2 = 0; ks2 < 2; ++ks2) {
                const bf16x8 pb = pack8(st[kb], ks2);
#pragma unroll
                for (int d0 = 0; d0 < D / 32; ++d0) {
                    const s16x4 lo = trread(vrd + (32 * kb + 16 * ks2 + 4 * h) * PBV + 64 * d0);
                    const s16x4 hi = trread(vrd + (32 * kb + 16 * ks2 + 8 + 4 * h) * PBV + 64 * d0);
                    o[d0] = mfma32(cat44(lo, hi), pb, o[d0]);
                }
            }
        }
    }
}

DI void att_wg_loop(GAS unsigned char* ws, LAS unsigned char* lds, int ubeg, int ustep, int uend, const int tid0) {
    int tid = tid0; asm volatile("" : "+v"(tid));
    const int lane = tid & 63, wave = __builtin_amdgcn_readfirstlane(tid0 >> 6), r = lane & 31, h = lane >> 5;
    constexpr int PB = 144, PBV = 192;
    LAS unsigned char* Kimg = lds; LAS unsigned char* Vimg = lds + 384 * PB;
    u32x4 kreg[6], vreg[6];
    auto issue = [&](int u) {
        const int ublk = u & 7, hb = u >> 3, head = hb % 24, bl = hb / 24;
        const size_t hbase = (size_t)(bl * 24 + head) * 2048 * 64;
        const GAS bf16_t* K = (const GAS bf16_t*)(ws + WS_AK) + hbase; const GAS bf16_t* V = (const GAS bf16_t*)(ws + WS_AV) + hbase;
        const int w0 = 256 * ublk - 64;
#pragma unroll
        for (int i = 0; i < 6; ++i) {
            const int ix = tid + 512 * i, row = ix >> 3, ch = ix & 7; const int grow = w0 + row;
            kreg[i] = (u32x4){0u, 0u, 0u, 0u}; vreg[i] = (u32x4){0u, 0u, 0u, 0u};
            if (grow >= 0 && grow < 2048) { kreg[i] = *(const GAS u32x4*)(K + (size_t)grow * 64 + 8 * ch); vreg[i] = *(const GAS u32x4*)(V + (size_t)grow * 64 + 8 * ch); }
        }
    };
    if (ubeg < uend) issue(ubeg);
#pragma unroll 1
    for (int u = ubeg; u < uend; u += ustep) {
#pragma unroll
        for (int i = 0; i < 6; ++i) { const int ix = tid + 512 * i, row = ix >> 3, ch = ix & 7;
            *(LAS u32x4*)(Kimg + row * PB + ch * 16) = kreg[i]; *(LAS u32x4*)(Vimg + row * PBV + ch * 16) = vreg[i]; }
        const int ublk = u & 7, hb = u >> 3, head = hb % 24, bl = hb / 24;
        const int gi = head >> 3, slot = head & 7, sh = 2 * gi, n = 2048 >> sh;
        GAS bf16_t* Q = (GAS bf16_t*)(ws + WS_AQ) + (size_t)(bl * 24 + head) * 2048 * 64;
        const int prow = 256 * ublk + 32 * wave, c = prow >> (11 - sh), i0 = prow & (n - 1);
        bf16x8 qf[4];
#pragma unroll
        for (int ks = 0; ks < 4; ++ks) qf[ks] = *(const GAS bf16x8*)(Q + (size_t)(prow + r) * 64 + 16 * ks + 8 * h);
        unsigned vmask = 0;
#pragma unroll
        for (int kb = 0; kb < 5; ++kb) { const int j0 = i0 - 64 + 32 * kb; if (j0 >= 0 && j0 < n) vmask |= 1u << kb; }
        vmask = __builtin_amdgcn_readfirstlane(vmask);
        __syncthreads();
        if (u + ustep < uend) issue(u + ustep);
        float m = NEGF, l = 0.f; f32x16 o[2]; o[0] = zero16(); o[1] = zero16();
        attn_pass_lds<64, 5, true>(Kimg + 32 * wave * PB, Vimg + 32 * wave * PBV, vmask, qf, m, l, o, lane);
        const float inv = frcp(l);
        GAS bf16_t* orow = Q + (size_t)(prow + r) * 64;
#pragma unroll
        for (int d0 = 0; d0 < 2; ++d0)
#pragma unroll
            for (int g4 = 0; g4 < 4; ++g4) {
                u32x2 w; w.x = pkbf(o[d0][4 * g4] * inv, o[d0][4 * g4 + 1] * inv); w.y = pkbf(o[d0][4 * g4 + 2] * inv, o[d0][4 * g4 + 3] * inv);
                *(GAS u32x2*)(orow + 32 * d0 + 8 * g4 + 4 * h) = w;
            }
        if (h == 0) {
            const int sq = c + ((i0 + r) << sh);
            GAS float* lse = (GAS float*)(ws + WS_LSE);
            lse[((size_t)gi * TG + (size_t)bl * 2048 + sq) * 8 + slot] = m + __logf(l);
        }
        __syncthreads();
    }
}

DI void cross_wg_unit(KPC P, LAS unsigned char* lds, int grp, int u, const int tid0) {
    int tid = tid0; asm volatile("" : "+v"(tid));
    const int lane = tid & 63, wave = __builtin_amdgcn_readfirstlane(tid0 >> 6), r = lane & 31, h = lane >> 5;
    constexpr int PB = 272, PBV = 320;
    GAS unsigned char* ws = ((GAS unsigned char*)P->ws); asm volatile("" : "+s"(ws));
    const int qq = u & 7, head = (u >> 3) & 3, bl = u >> 5;
    const GAS bf16_t* K = (const GAS bf16_t*)(ws + WS_CKV) + (size_t)(grp * BL + bl) * 256 * 1024 + head * 128;
    const GAS bf16_t* V = K + 512;
    LAS unsigned char* Kimg = lds; LAS unsigned char* Vimg = lds + 256 * PB;
#pragma unroll
    for (int i = 0; i < 8; ++i) {
        const int ix = tid + 512 * i, row = ix >> 4, ch = ix & 15;
        *(LAS u32x4*)(Kimg + row * PB + ch * 16) = *(const GAS u32x4*)(K + (size_t)row * 1024 + 8 * ch);
        *(LAS u32x4*)(Vimg + row * PBV + ch * 16) = *(const GAS u32x4*)(V + (size_t)row * 1024 + 8 * ch);
    }
    GAS bf16_t* qrow = (GAS bf16_t*)(ws + WS_CQ) + ((size_t)bl * 2048 + 256 * qq + 32 * wave + r) * 512 + head * 128;
    bf16x8 qf[8]; float ss = 0.f;
#pragma unroll
    for (int ks = 0; ks < 8; ++ks) { qf[ks] = *(const GAS bf16x8*)(qrow + 16 * ks + 8 * h);
        const u32x4 w = __builtin_bit_cast(u32x4, qf[ks]);
        ss += (bflo(w.x) * bflo(w.x) + bfhi(w.x) * bfhi(w.x)) + (bflo(w.y) * bflo(w.y) + bfhi(w.y) * bfhi(w.y)) + (bflo(w.z) * bflo(w.z) + bfhi(w.z) * bfhi(w.z)) + (bflo(w.w) * bflo(w.w) + bfhi(w.w) * bfhi(w.w)); }
    ss += SHX(ss, 32);
    const float rq = (frsq(ss * (1.0f / 128.0f) + EPS)) * 0.08838834764831845f;
#pragma unroll
    for (int ks = 0; ks < 8; ++ks) {
        const u32x4 w = __builtin_bit_cast(u32x4, qf[ks]); const GAS float* g = ((const GAS float*)P->cx_q_gain) + 16 * ks + 8 * h;
        const f32x4 ga = *(const GAS f32x4*)g, gb = *(const GAS f32x4*)(g + 4);
        u32x4 o; o.x = pkbf(bflo(w.x) * rq * ga.x, bfhi(w.x) * rq * ga.y); o.y = pkbf(bflo(w.y) * rq * ga.z, bfhi(w.y) * rq * ga.w);
        o.z = pkbf(bflo(w.z) * rq * gb.x, bfhi(w.z) * rq * gb.y); o.w = pkbf(bflo(w.w) * rq * gb.z, bfhi(w.w) * rq * gb.w);
        qf[ks] = __builtin_bit_cast(bf16x8, o);
    }
    __syncthreads();
    float m = NEGF, l = 0.f; f32x16 o[4];
#pragma unroll
    for (int d0 = 0; d0 < 4; ++d0) o[d0] = zero16();
#pragma unroll 1
    for (int ps = 0; ps < 4; ++ps) attn_pass_lds<128, 2, false>(Kimg + ps * 64 * PB, Vimg + ps * 64 * PBV, 0x3u, qf, m, l, o, lane);
    const float inv = frcp(l);
    GAS bf16_t* orow = (GAS bf16_t*)(ws + WS_YATT) + ((size_t)bl * 2048 + 256 * qq + 32 * wave + r) * 1536 + 1024 + head * 128;
#pragma unroll
    for (int d0 = 0; d0 < 4; ++d0)
#pragma unroll
        for (int g4 = 0; g4 < 4; ++g4) {
            u32x2 w; w.x = pkbf(o[d0][4 * g4] * inv, o[d0][4 * g4 + 1] * inv); w.y = pkbf(o[d0][4 * g4 + 2] * inv, o[d0][4 * g4 + 3] * inv);
            *(GAS u32x2*)(orow + 32 * d0 + 8 * g4 + 4 * h) = w;
        }
    __syncthreads();
}

#ifndef REP_ML
#define REP_ML 1
#endif
constexpr size_t WS_DN = 493 * MiB;
constexpr size_t WS_SCL = 493 * MiB + 512 * 1024;
#define CHAIN_LANES() asm volatile("" : "+v"(tid)); const int lane = tid & 63, r = lane & 31, h = lane >> 5; const int trofs = ((lane & 15) >> 2) * MLP + 32 * ((lane >> 4) & 1) + 8 * (lane & 3); (void)r; (void)h; (void)trofs

DI void ml_conv_item(KPC P, const GAS bf16_t* srcbase, LAS unsigned char* img, int sel, int cg8, int seg, int ci, int dir, size_t rowb, int head) {
    const int tl0 = 128 * ci + 8 * seg;
    const int pmin = dir ? 2047 - (tl0 + 7) : tl0;
    const GAS bf16_t* src = srcbase + head * 128 + 8 * cg8;
    u32x4 raw[12];
#pragma unroll
    for (int i = 0; i < 12; ++i) { const int pp = pmin - 2 + i; raw[i] = (u32x4){0u, 0u, 0u, 0u}; if (pp >= 0 && pp < 2048) raw[i] = *(const GAS u32x4*)(src + (rowb + pp) * 512); }
    const int ch = sel * 512 + head * 128 + 8 * cg8;
    f32x4 wv[5][2];
#pragma unroll
    for (int j = 0; j < 5; ++j) { wv[j][0] = *(const GAS f32x4*)(((const GAS float*)P->ml_conv_w) + j * 1024 + ch); wv[j][1] = *(const GAS f32x4*)(((const GAS float*)P->ml_conv_w) + j * 1024 + ch + 4); }
    const f32x4 b0 = *(const GAS f32x4*)(((const GAS float*)P->ml_conv_b) + ch), b1 = *(const GAS f32x4*)(((const GAS float*)P->ml_conv_b) + ch + 4);
    const float osc = sel ? 1.0f : 0.08838834764831845f;
    LAS unsigned char* dstb = img + cg8 * 16;
#pragma unroll
    for (int i = 0; i < 8; ++i) {
        f32x4 a0 = b0, a1 = b1;
#pragma unroll
        for (int j = 0; j < 5; ++j) {
            const u32x4 w = raw[i + j];
            a0 += wv[j][0] * (f32x4){bflo(w.x), bfhi(w.x), bflo(w.y), bfhi(w.y)};
            a1 += wv[j][1] * (f32x4){bflo(w.z), bfhi(w.z), bflo(w.w), bfhi(w.w)};
        }
        u32x4 o;
        o.x = pkbf(a0.x * sigmoidf_(a0.x) * osc, a0.y * sigmoidf_(a0.y) * osc); o.y = pkbf(a0.z * sigmoidf_(a0.z) * osc, a0.w * sigmoidf_(a0.w) * osc);
        o.z = pkbf(a1.x * sigmoidf_(a1.x) * osc, a1.y * sigmoidf_(a1.y) * osc); o.w = pkbf(a1.z * sigmoidf_(a1.z) * osc, a1.w * sigmoidf_(a1.w) * osc);
        const int tl = dir ? (8 * seg + 7 - i) : (8 * seg + i);
        *(LAS u32x4*)(dstb + tl * MLP) = o;
    }
}

DI void mlstm_p1(KPC P, LAS unsigned char* lds, int grp, int chain, int ci, const int tid0) {
    int tid = tid0; const int wave = __builtin_amdgcn_readfirstlane(tid0 >> 6);
    const int bl = chain >> 3, head = (chain >> 1) & 3, dir = chain & 1;
    GAS unsigned char* ws = ((GAS unsigned char*)P->ws); asm volatile("" : "+s"(ws));
    LAS unsigned char* KI = lds + 128 * MLP; LAS unsigned char* VI = lds + 2 * 128 * MLP; LAS unsigned char* CI = lds + 3 * 128 * MLP;
    LAS float* twk = (LAS float*)(lds + TB_OFF) + 384;
    const size_t rowb = (size_t)bl * 2048;
    {
        CHAIN_LANES();
        if (tid < 256) {
            ml_conv_item(P, (const GAS bf16_t*)(ws + WS_MK), KI, 1, tid & 15, (tid >> 4) & 15, ci, dir, rowb, head);
        } else {
            const int t2 = tid - 256; const int t = t2 >> 1, c0 = (t2 & 1) * 64; const int tau = 128 * ci + t; const int p = dir ? 2047 - tau : tau;
            const GAS bf16_t* vsrc = (const GAS bf16_t*)(ws + WS_MV) + (rowb + p) * 512 + head * 128 + c0;
#pragma unroll
            for (int sub = 0; sub < 8; ++sub) *(LAS u32x4*)(VI + t * MLP + c0 * 2 + sub * 16) = *(const GAS u32x4*)(vsrc + 8 * sub);
            if (wave == 7) {
                const GAS float* MIF = (const GAS float*)(ws + WS_MIF);
                const float bli = ((const GAS float*)P->ml_gate_b)[(dir ? 8 : 0) + head], blf = ((const GAS float*)P->ml_gate_b)[(dir ? 12 : 4) + head];
                const int tau1 = 128 * ci + lane, tau2 = tau1 + 64; const int p1 = dir ? 2047 - tau1 : tau1, p2 = dir ? 2047 - tau2 : tau2;
                const GAS float* r1 = MIF + (rowb + p1) * 16 + head; const GAS float* r2 = MIF + (rowb + p2) * 16 + head;
                const float li1 = r1[dir ? 8 : 0] + bli, li2 = r2[dir ? 8 : 0] + bli;
                const float lf1 = log_sigmoid(r1[dir ? 12 : 4] + blf), lf2 = log_sigmoid(r2[dir ? 12 : 4] + blf);
                const float c1 = scan_add(lf1, lane); const float tot1 = rdlane(c1, 63); const float c2 = scan_add(lf2, lane) + tot1;
                const float g1 = li1 - c1, g2 = li2 - c2;
                float gm = fmaxf(g1, g2);
#pragma unroll
                for (int o = 1; o < 64; o <<= 1) gm = fmaxf(gm, SHX(gm, o));
                const float gtot = rdlane(c2, 63);
                twk[lane] = __expf(g1 - gm); twk[64 + lane] = __expf(g2 - gm);
                if (lane == 0) { GAS float* scl = (GAS float*)(ws + WS_SCL) + ((size_t)chain * 16 + ci) * 4; scl[0] = gtot; scl[1] = gm; }
            }
        }
    }
    __syncthreads();
    {
        CHAIN_LANES();
        const int s = tid >> 2, c0 = (tid & 3) * 32; const float wks = twk[s];
#pragma unroll
        for (int sub = 0; sub < 4; ++sub) {
            LAS u32x4* pp = (LAS u32x4*)(KI + s * MLP + c0 * 2 + sub * 16); const u32x4 w = *pp;
            u32x4 o; o.x = pkbf(bflo(w.x) * wks, bfhi(w.x) * wks); o.y = pkbf(bflo(w.y) * wks, bfhi(w.y) * wks); o.z = pkbf(bflo(w.z) * wks, bfhi(w.z) * wks); o.w = pkbf(bflo(w.w) * wks, bfhi(w.w) * wks);
            *pp = o;
        }
    }
    __syncthreads();
    {
        CHAIN_LANES();
        const int vb = wave >> 1, kh = wave & 1;
        f32x16 cacc[2], ntmp[2]; cacc[0] = zero16(); cacc[1] = zero16(); ntmp[0] = zero16(); ntmp[1] = zero16();
        const bf16x8 ones = (bf16x8){0x3F80, 0x3F80, 0x3F80, 0x3F80, 0x3F80, 0x3F80, 0x3F80, 0x3F80};
#pragma unroll
        for (int ks = 0; ks < 8; ++ks) {
            LAS unsigned char* vp = VI + trofs + (16 * ks + 8 * h) * MLP + 64 * vb;
            const bf16x8 af = cat44(trread(vp), trread(vp + 4 * MLP));
#pragma unroll
            for (int jk = 0; jk < 2; ++jk) {
                LAS unsigned char* kp = KI + trofs + (16 * ks + 8 * h) * MLP + 64 * (2 * kh + jk);
                const bf16x8 bfr = cat44(trread(kp), trread(kp + 4 * MLP));
                cacc[jk] = mfma32(af, bfr, cacc[jk]);
                if (vb == 0) ntmp[jk] = mfma32(ones, bfr, ntmp[jk]);
            }
        }
#pragma unroll
        for (int jk = 0; jk < 2; ++jk) {
            const int kcol = 32 * (2 * kh + jk) + r;
#pragma unroll
            for (int i = 0; i < 16; i += 1) {
                const unsigned short v = (unsigned short)(pkbf(cacc[jk][i], 0.f) & 0xffffu);
                *(LAS unsigned short*)(CI + (32 * vb + crow(i, h)) * MLP + kcol * 2) = v;
            }
            if (vb == 0 && h == 0) ((GAS float*)(ws + WS_DN))[((size_t)chain * 16 + ci) * 128 + kcol] = ntmp[jk][0];
        }
    }
    __syncthreads();
    {
        CHAIN_LANES();
        GAS bf16_t* dc = (GAS bf16_t*)((GAS float*)P->out) + ((size_t)chain * 16 + ci) * 16384;
#pragma unroll
        for (int i = 0; i < 4; ++i) { const int ix = tid + 512 * i; *(GAS u32x4*)(dc + (size_t)ix * 8) = *(LAS u32x4*)(CI + (ix >> 4) * MLP + (ix & 15) * 16); }
    }
}

DI void mlstm_p1f(KPC P, LAS unsigned char* lds, int grp, int bl, int head, int pc, const int tid0) {
    int tid = tid0; const int wave = __builtin_amdgcn_readfirstlane(tid0 >> 6);
    GAS unsigned char* ws = ((GAS unsigned char*)P->ws); asm volatile("" : "+s"(ws));
    LAS unsigned char* KW = lds; LAS unsigned char* KI = lds + 128 * MLT; LAS unsigned char* VI = lds + 128 * MLT + 128 * MLP; LAS unsigned char* CI = lds + 2 * 128 * MLT + 128 * MLP;
    LAS float* twk = (LAS float*)(lds + TB_OFF) + 256;
    const size_t rowb = (size_t)bl * 2048;
    {
        CHAIN_LANES();
        if (tid < 256) {
            ml_conv_item(P, (const GAS bf16_t*)(ws + WS_MK), KI, 1, tid & 15, (tid >> 4) & 15, pc, 0, rowb, head);
        } else {
            const int d = wave == 7 ? 0 : 1;
            const int ci = d ? 15 - pc : pc; const int chain = bl * 8 + head * 2 + d;
            float gl[4] = {0.f, 0.f, 0.f, 0.f};
            if (wave >= 6) {
                const GAS float* MIF = (const GAS float*)(ws + (grp ? WS_MIF1 : WS_MIF));
                const int tau1 = 128 * ci + lane, tau2 = tau1 + 64; const int p1 = d ? 2047 - tau1 : tau1, p2 = d ? 2047 - tau2 : tau2;
                const GAS float* r1 = MIF + (rowb + p1) * 16 + head; const GAS float* r2 = MIF + (rowb + p2) * 16 + head;
                gl[0] = r1[d ? 8 : 0]; gl[1] = r2[d ? 8 : 0]; gl[2] = r1[d ? 12 : 4]; gl[3] = r2[d ? 12 : 4];
            }
            const int t2 = tid - 256; const int t = t2 >> 1, c0 = (t2 & 1) * 64;
            const GAS bf16_t* vsrc = (const GAS bf16_t*)(ws + WS_MV) + (rowb + 128 * pc + t) * 512 + head * 128 + c0;
#pragma unroll
            for (int sub = 0; sub < 8; ++sub) *(LAS u32x4*)(VI + t * MLT + c0 * 2 + sub * 16) = *(const GAS u32x4*)(vsrc + 8 * sub);
            if (wave >= 6) {
                const float bli = ((const GAS float*)P->ml_gate_b)[(d ? 8 : 0) + head], blf = ((const GAS float*)P->ml_gate_b)[(d ? 12 : 4) + head];
                const float li1 = gl[0] + bli, li2 = gl[1] + bli;
                const float lf1 = log_sigmoid(gl[2] + blf), lf2 = log_sigmoid(gl[3] + blf);
                const float c1 = scan_add(lf1, lane); const float tot1 = rdlane(c1, 63); const float c2 = scan_add(lf2, lane) + tot1;
                const float g1 = li1 - c1, g2 = li2 - c2;
                float gm = fmaxf(g1, g2);
#pragma unroll
                for (int o = 1; o < 64; o <<= 1) gm = fmaxf(gm, SHX(gm, o));
                const float gtot = rdlane(c2, 63);
                const int po1 = d ? 127 - lane : lane, po2 = d ? 63 - lane : 64 + lane;
                twk[d * 128 + po1] = __expf(g1 - gm); twk[d * 128 + po2] = __expf(g2 - gm);
                if (lane == 0) { GAS float* scl = (GAS float*)(ws + WS_SCL) + ((size_t)chain * 16 + ci) * 4; scl[0] = gtot; scl[1] = gm; }
            }
        }
    }
    __syncthreads();
#pragma unroll 1
    for (int d = 0; d < 2; ++d) {
        const int ci = d ? 15 - pc : pc; const int chain = bl * 8 + head * 2 + d;
        {
            CHAIN_LANES();
            const int sp = tid >> 2, c0 = (tid & 3) * 32; const float wks = twk[d * 128 + sp];
#pragma unroll
            for (int sub = 0; sub < 4; ++sub) {
                const u32x4 w = *(const LAS u32x4*)(KI + sp * MLP + c0 * 2 + sub * 16);
                u32x4 o; o.x = pkbf(bflo(w.x) * wks, bfhi(w.x) * wks); o.y = pkbf(bflo(w.y) * wks, bfhi(w.y) * wks); o.z = pkbf(bflo(w.z) * wks, bfhi(w.z) * wks); o.w = pkbf(bflo(w.w) * wks, bfhi(w.w) * wks);
                *(LAS u32x4*)(KW + sp * MLT + c0 * 2 + sub * 16) = o;
            }
        }
        __syncthreads();
        {
            CHAIN_LANES();
            const int vb = wave >> 1, kh = wave & 1;
            const int trt = ((lane & 15) >> 2) * MLT + 32 * ((lane >> 4) & 1) + 8 * (lane & 3);
            f32x16 cacc[2], ntmp[2]; cacc[0] = zero16(); cacc[1] = zero16(); ntmp[0] = zero16(); ntmp[1] = zero16();
            const bf16x8 ones = (bf16x8){0x3F80, 0x3F80, 0x3F80, 0x3F80, 0x3F80, 0x3F80, 0x3F80, 0x3F80};
#pragma unroll
            for (int ks = 0; ks < 8; ++ks) {
                LAS unsigned char* vp = VI + trt + (16 * ks + 8 * h) * MLT + 64 * vb;
                const bf16x8 af = cat44(trread(vp), trread(vp + 4 * MLT));
#pragma unroll
                for (int jk = 0; jk < 2; ++jk) {
                    LAS unsigned char* kp = KW + trt + (16 * ks + 8 * h) * MLT + 64 * (2 * kh + jk);
                    const bf16x8 bfr = cat44(trread(kp), trread(kp + 4 * MLT));
                    cacc[jk] = mfma32(af, bfr, cacc[jk]);
                    if (vb == 0) ntmp[jk] = mfma32(ones, bfr, ntmp[jk]);
                }
            }
#pragma unroll
            for (int jk = 0; jk < 2; ++jk) {
                const int kcol = 32 * (2 * kh + jk) + r;
#pragma unroll
                for (int i = 0; i < 16; i += 1) {
                    const unsigned short v = (unsigned short)(pkbf(cacc[jk][i], 0.f) & 0xffffu);
                    *(LAS unsigned short*)(CI + (32 * vb + crow(i, h)) * MLP + kcol * 2) = v;
                }
                if (vb == 0 && h == 0) ((GAS float*)(ws + WS_DN))[((size_t)chain * 16 + ci) * 128 + kcol] = ntmp[jk][0];
            }
        }
        __syncthreads();
        {
            CHAIN_LANES();
            GAS bf16_t* dc = (GAS bf16_t*)((GAS float*)P->out) + ((size_t)chain * 16 + ci) * 16384;
#pragma unroll
            for (int i = 0; i < 4; ++i) { const int ix = tid + 512 * i; *(GAS u32x4*)(dc + (size_t)ix * 8) = *(LAS u32x4*)(CI + (ix >> 4) * MLP + (ix & 15) * 16); }
        }
    }
}

DI void mlstm_scan(GAS unsigned char* ws, GAS float* dcbase, int w, int tid) {
    const int chain = w >> 2, quarter = w & 3;
    GAS float* scl = (GAS float*)(ws + WS_SCL) + (size_t)chain * 64;
    GAS bf16_t* dc = (GAS bf16_t*)dcbase + (size_t)chain * 16 * 16384 + (size_t)(quarter * 512 + tid) * 8;
    GAS float* dn = (GAS float*)(ws + WS_DN) + (size_t)chain * 16 * 128 + (tid & 127);
    const bool isn = quarter == 0 && tid < 128;
    u32x4 d[16]; float nd[16];
#pragma unroll
    for (int c = 0; c < 16; ++c) { d[c] = *(const GAS u32x4*)(dc + (size_t)c * 16384); nd[c] = isn ? dn[c * 128] : 0.f; }
    float C[8]; float nn = 0.f, m = 0.f; float zinit = 0.f; asm volatile("" : "+v"(zinit));
#pragma unroll
    for (int k = 0; k < 8; ++k) C[k] = zinit;
#pragma unroll
    for (int c = 0; c < 16; ++c) {
        u32x4 o; o.x = pkbf(C[0], C[1]); o.y = pkbf(C[2], C[3]); o.z = pkbf(C[4], C[5]); o.w = pkbf(C[6], C[7]);
        *(GAS u32x4*)(dc + (size_t)c * 16384) = o;
        if (isn) dn[c * 128] = nn;
        const float gt = scl[4 * c], gm = scl[4 * c + 1];
        const float mn = gt + fmaxf(m, gm); const float al = __expf(gt + m - mn), be = __expf(gt + gm - mn);
        if (quarter == 0 && tid == 0) scl[4 * c + 2] = m;
        const u32x4 w4 = d[c];
        C[0] = al * C[0] + be * bflo(w4.x); C[1] = al * C[1] + be * bfhi(w4.x); C[2] = al * C[2] + be * bflo(w4.y); C[3] = al * C[3] + be * bfhi(w4.y);
        C[4] = al * C[4] + be * bflo(w4.z); C[5] = al * C[5] + be * bfhi(w4.z); C[6] = al * C[6] + be * bflo(w4.w); C[7] = al * C[7] + be * bfhi(w4.w);
        nn = al * nn + be * nd[c]; m = mn;
    }
}

DI void mlstm_p3(KPC P, LAS unsigned char* lds, int grp, int chain, int ci, const int tid0) {
    int tid = tid0; const int wave = __builtin_amdgcn_readfirstlane(tid0 >> 6);
    const int bl = chain >> 3, head = (chain >> 1) & 3, dir = chain & 1;
    GAS unsigned char* ws = ((GAS unsigned char*)P->ws); asm volatile("" : "+s"(ws));
    LAS unsigned char* QI = lds; LAS unsigned char* KI = lds + 128 * MLP; LAS unsigned char* VI = lds + 2 * 128 * MLP; LAS unsigned char* CI = lds + 3 * 128 * MLP;
    LAS float* tg = (LAS float*)(lds + TB_OFF); LAS float* tM = tg + 128; LAS float* tbc = tg + 256; LAS float* tnv = tg + 512; LAS float* scal = tg + 640;
    const size_t rowb = (size_t)bl * 2048;
    {
        CHAIN_LANES();
        ml_conv_item(P, (const GAS bf16_t*)(ws + (tid >> 8 ? WS_MK : WS_MQ)), (tid >> 8) ? KI : QI, tid >> 8, tid & 15, (tid >> 4) & 15, ci, dir, rowb, head);
        {
            const int t = tid >> 2, c0 = (tid & 3) * 32; const int tau = 128 * ci + t; const int p = dir ? 2047 - tau : tau;
            const GAS bf16_t* vsrc = (const GAS bf16_t*)(ws + WS_MV) + (rowb + p) * 512 + head * 128 + c0;
#pragma unroll
            for (int sub = 0; sub < 4; ++sub) *(LAS u32x4*)(VI + t * MLP + c0 * 2 + sub * 16) = *(const GAS u32x4*)(vsrc + 8 * sub);
            const GAS bf16_t* dc = (const GAS bf16_t*)((GAS float*)P->out) + ((size_t)chain * 16 + ci) * 16384;
#pragma unroll
            for (int i = 0; i < 4; ++i) { const int ix = tid + 512 * i; *(LAS u32x4*)(CI + (ix >> 4) * MLP + (ix & 15) * 16) = *(const GAS u32x4*)(dc + (size_t)ix * 8); }
        }
        if (wave == 1) tnv[lane] = ((const GAS float*)(ws + WS_DN))[((size_t)chain * 16 + ci) * 128 + lane];
        if (wave == 2) tnv[64 + lane] = ((const GAS float*)(ws + WS_DN))[((size_t)chain * 16 + ci) * 128 + 64 + lane];
        if (wave == 0) {
            const GAS float* MIF = (const GAS float*)(ws + WS_MIF);
            const float bli = ((const GAS float*)P->ml_gate_b)[(dir ? 8 : 0) + head], blf = ((const GAS float*)P->ml_gate_b)[(dir ? 12 : 4) + head];
            const float mcur = ((const GAS float*)(ws + WS_SCL))[((size_t)chain * 16 + ci) * 4 + 2];
            const int tau1 = 128 * ci + lane, tau2 = tau1 + 64; const int p1 = dir ? 2047 - tau1 : tau1, p2 = dir ? 2047 - tau2 : tau2;
            const GAS float* r1 = MIF + (rowb + p1) * 16 + head; const GAS float* r2 = MIF + (rowb + p2) * 16 + head;
            const float li1 = r1[dir ? 8 : 0] + bli, li2 = r2[dir ? 8 : 0] + bli;
            const float lf1 = log_sigmoid(r1[dir ? 12 : 4] + blf), lf2 = log_sigmoid(r2[dir ? 12 : 4] + blf);
            const float c1 = scan_add(lf1, lane); const float tot1 = rdlane(c1, 63); const float c2 = scan_add(lf2, lane) + tot1;
            const float g1 = li1 - c1, g2 = li2 - c2;
            const float x1 = scan_max(g1, lane); const float mx1 = rdlane(x1, 63); const float x2 = fmaxf(scan_max(g2, lane), mx1);
            tg[lane] = g1; tg[64 + lane] = g2; tM[lane] = fmaxf(x1, mcur); tM[64 + lane] = fmaxf(x2, mcur); tbc[lane] = c1; tbc[64 + lane] = c2;
            if (lane == 0) scal[0] = mcur;
        }
    }
    __syncthreads();
    {
        CHAIN_LANES();
        GAS bf16_t* Hout = (GAS bf16_t*)(ws + (dir ? WS_HB : WS_HF));
        const int tb = wave >> 1, vh = wave & 1; const int t = 32 * tb + r;
        const float Mt = tM[t], bct = tbc[t], mold = scal[0];
        const float winter = __expf(mold - Mt), flo = __expf(-(Mt + bct));
        bf16x8 qf[8];
#pragma unroll
        for (int ks = 0; ks < 8; ++ks) qf[ks] = *(const LAS bf16x8*)(QI + t * MLP + (16 * ks + 8 * h) * 2);
        f32x16 na[2]; na[0] = zero16(); na[1] = zero16();
        float den = 0.f;
        for (int sb = 0; sb <= tb; ++sb) {
            f32x16 st = zero16();
#pragma unroll
            for (int ks = 0; ks < 8; ++ks) st = mfma32(*(const LAS bf16x8*)(KI + (32 * sb + r) * MLP + (16 * ks + 8 * h) * 2), qf[ks], st);
            MEMFENCE();
#pragma unroll
            for (int i = 0; i < 16; ++i) {
                const int sl = crow(i, h); const float wgt = __expf(tg[32 * sb + sl] - Mt);
                const bool valid = (sb < tb) || (sl <= r);
                const float v = valid ? st[i] * wgt : 0.f; st[i] = v; den += v;
            }
#pragma unroll
            for (int ks2 = 0; ks2 < 2; ++ks2) {
                const bf16x8 pb = pack8(st, ks2);
#pragma unroll
                for (int jv = 0; jv < 2; ++jv) {
                    LAS unsigned char* vp = VI + trofs + (32 * sb + 16 * ks2 + 4 * h) * MLP + 64 * (2 * vh + jv);
                    const s16x4 lo = trread(vp), hi = trread(vp + 8 * MLP);
                    na[jv] = mfma32(cat44(lo, hi), pb, na[jv]);
                }
            }
        }
        den += SHX(den, 32);
        float dq = 0.f;
#pragma unroll
        for (int ks = 0; ks < 8; ++ks) {
            const u32x4 w = __builtin_bit_cast(u32x4, qf[ks]); const LAS float* nv = tnv + 16 * ks + 8 * h;
            const float q0 = bflo(w.x), q1 = bfhi(w.x), q2 = bflo(w.y), q3 = bfhi(w.y), q4_ = bflo(w.z), q5 = bfhi(w.z), q6 = bflo(w.w), q7 = bfhi(w.w);
            dq += (nv[0] * q0 + nv[1] * q1) + (nv[2] * q2 + nv[3] * q3) + (nv[4] * q4_ + nv[5] * q5) + (nv[6] * q6 + nv[7] * q7);
            u32x4 o; o.x = pkbf(q0 * winter, q1 * winter); o.y = pkbf(q2 * winter, q3 * winter); o.z = pkbf(q4_ * winter, q5 * winter); o.w = pkbf(q6 * winter, q7 * winter);
            const bf16x8 qs = __builtin_bit_cast(bf16x8, o);
#pragma unroll
            for (int jv = 0; jv < 2; ++jv)
                na[jv] = mfma32(*(const LAS bf16x8*)(CI + (32 * (2 * vh + jv) + r) * MLP + (16 * ks + 8 * h) * 2), qs, na[jv]);
        }
        dq += SHX(dq, 32);
        den += winter * dq;
        const float inv = frcp(fmaxf(fabsf(den), flo));
        const int tau = 128 * ci + t; const int p = dir ? 2047 - tau : tau;
        GAS bf16_t* dst = Hout + (rowb + p) * 512 + head * 128;
#pragma unroll
        for (int jv = 0; jv < 2; ++jv)
#pragma unroll
            for (int g4 = 0; g4 < 4; ++g4) {
                u32x2 w; w.x = pkbf(na[jv][4 * g4] * inv, na[jv][4 * g4 + 1] * inv); w.y = pkbf(na[jv][4 * g4 + 2] * inv, na[jv][4 * g4 + 3] * inv);
                *(GAS u32x2*)(dst + 32 * (2 * vh + jv) + 8 * g4 + 4 * h) = w;
            }
    }
    __syncthreads();
}

DI void mlstm_p3f(KPC P, LAS unsigned char* lds, int grp, int bl, int head, int pc, const int tid0) {
    int tid = tid0; const int wave = __builtin_amdgcn_readfirstlane(tid0 >> 6);
    GAS unsigned char* ws = ((GAS unsigned char*)P->ws); asm volatile("" : "+s"(ws));
    LAS unsigned char* QI = lds; LAS unsigned char* KI = lds + 128 * MLP; LAS unsigned char* VI = lds + 2 * 128 * MLP; LAS unsigned char* CI = lds + 2 * 128 * MLP + 128 * MLT;
    LAS float* tg = (LAS float*)(lds + TB_OFF); LAS float* tM = tg + 128; LAS float* tbc = tg + 256; LAS float* tnv = tg + 512; LAS float* scal = tg + 640; LAS float* ssx = tg + 656;
    const size_t rowb = (size_t)bl * 2048;
    {
        CHAIN_LANES();
        const int tv = tid >> 2, cv0 = (tid & 3) * 32;
        const GAS bf16_t* vsrc = (const GAS bf16_t*)(ws + WS_MV) + (rowb + 128 * pc + tv) * 512 + head * 128 + cv0;
        u32x4 vr[4];
#pragma unroll
        for (int sub = 0; sub < 4; ++sub) vr[sub] = *(const GAS u32x4*)(vsrc + 8 * sub);
        ml_conv_item(P, (const GAS bf16_t*)(ws + (tid >> 8 ? WS_MK : WS_MQ)), (tid >> 8) ? KI : QI, tid >> 8, tid & 15, (tid >> 4) & 15, pc, 0, rowb, head);
#pragma unroll
        for (int sub = 0; sub < 4; ++sub) *(LAS u32x4*)(VI + tv * MLT + cv0 * 2 + sub * 16) = vr[sub];
    }
#pragma unroll 1
    for (int d = 0; d < 2; ++d) {
        const int ci = d ? 15 - pc : pc; const int chain = bl * 8 + head * 2 + d;
        {
            CHAIN_LANES();
            const GAS bf16_t* dc = (const GAS bf16_t*)((GAS float*)P->out) + ((size_t)chain * 16 + ci) * 16384;
#pragma unroll
            for (int i = 0; i < 4; ++i) { const int ix = tid + 512 * i; *(LAS u32x4*)(CI + (ix >> 4) * MLP + (ix & 15) * 16) = *(const GAS u32x4*)(dc + (size_t)ix * 8); }
            if (wave == 1) tnv[lane] = ((const GAS float*)(ws + WS_DN))[((size_t)chain * 16 + ci) * 128 + lane];
            if (wave == 2) tnv[64 + lane] = ((const GAS float*)(ws + WS_DN))[((size_t)chain * 16 + ci) * 128 + 64 + lane];
            if (wave == 0) {
                const GAS float* MIF = (const GAS float*)(ws + (grp ? WS_MIF1 : WS_MIF));
                const float bli = ((const GAS float*)P->ml_gate_b)[(d ? 8 : 0) + head], blf = ((const GAS float*)P->ml_gate_b)[(d ? 12 : 4) + head];
                const float mcur = ((const GAS float*)(ws + WS_SCL))[((size_t)chain * 16 + ci) * 4 + 2];
                const int tau1 = 128 * ci + lane, tau2 = tau1 + 64; const int p1 = d ? 2047 - tau1 : tau1, p2 = d ? 2047 - tau2 : tau2;
                const GAS float* r1 = MIF + (rowb + p1) * 16 + head; const GAS float* r2 = MIF + (rowb + p2) * 16 + head;
                const float li1 = r1[d ? 8 : 0] + bli, li2 = r2[d ? 8 : 0] + bli;
                const float lf1 = log_sigmoid(r1[d ? 12 : 4] + blf), lf2 = log_sigmoid(r2[d ? 12 : 4] + blf);
                const float c1 = scan_add(lf1, lane); const float tot1 = rdlane(c1, 63); const float c2 = scan_add(lf2, lane) + tot1;
                const float g1 = li1 - c1, g2 = li2 - c2;
                const float x1 = scan_max(g1, lane); const float mx1 = rdlane(x1, 63); const float x2 = fmaxf(scan_max(g2, lane), mx1);
                tg[lane] = g1; tg[64 + lane] = g2; tM[lane] = fmaxf(x1, mcur); tM[64 + lane] = fmaxf(x2, mcur); tbc[lane] = c1; tbc[64 + lane] = c2;
                if (lane == 0) scal[0] = mcur;
            }
        }
        __syncthreads();
        {
            CHAIN_LANES();
            const int q4l = (lane & 15) >> 2, cofs = 32 * ((lane >> 4) & 1) + 8 * (lane & 3);
            const int tb = wave >> 1, vh = wave & 1; const int t = 32 * tb + r;
            const int pot = d ? 127 - t : t;
            const float Mt = tM[t], bct = tbc[t], mold = scal[0];
            const float winter = __expf(mold - Mt), flo = __expf(-(Mt + bct));
            bf16x8 qf[8];
#pragma unroll
            for (int ks = 0; ks < 8; ++ks) qf[ks] = *(const LAS bf16x8*)(QI + pot * MLP + (16 * ks + 8 * h) * 2);
            f32x16 na[2]; na[0] = zero16(); na[1] = zero16();
            float den = 0.f;
            for (int sb = 0; sb <= tb; ++sb) {
                f32x16 st = zero16();
                const int srow = 32 * sb + r; const int pos_s = d ? 127 - srow : srow;
#pragma unroll
                for (int ks = 0; ks < 8; ++ks) st = mfma32(*(const LAS bf16x8*)(KI + pos_s * MLP + (16 * ks + 8 * h) * 2), qf[ks], st);
                MEMFENCE();
#pragma unroll
                for (int i = 0; i < 16; ++i) {
                    const int sl = crow(i, h); const float wgt = __expf(tg[32 * sb + sl] - Mt);
                    const bool valid = (sb < tb) || (sl <= r);
                    const float v = valid ? st[i] * wgt : 0.f; st[i] = v; den += v;
                }
#pragma unroll
                for (int ks2 = 0; ks2 < 2; ++ks2) {
                    const bf16x8 pb = pack8(st, ks2);
                    const int rlo = 32 * sb + 16 * ks2 + 4 * h + q4l, rhi = rlo + 8;
                    const int plo = d ? 127 - rlo : rlo, phi = d ? 127 - rhi : rhi;
#pragma unroll
                    for (int jv = 0; jv < 2; ++jv) {
                        const s16x4 lo = trread(VI + plo * MLT + cofs + 64 * (2 * vh + jv)), hi = trread(VI + phi * MLT + cofs + 64 * (2 * vh + jv));
                        na[jv] = mfma32(cat44(lo, hi), pb, na[jv]);
                    }
                }
            }
            den += SHX(den, 32);
            float dq = 0.f;
#pragma unroll
            for (int ks = 0; ks < 8; ++ks) {
                const u32x4 w = __builtin_bit_cast(u32x4, qf[ks]); const LAS float* nv = tnv + 16 * ks + 8 * h;
                const float q0 = bflo(w.x), q1 = bfhi(w.x), q2 = bflo(w.y), q3 = bfhi(w.y), q4_ = bflo(w.z), q5 = bfhi(w.z), q6 = bflo(w.w), q7 = bfhi(w.w);
                dq += (nv[0] * q0 + nv[1] * q1) + (nv[2] * q2 + nv[3] * q3) + (nv[4] * q4_ + nv[5] * q5) + (nv[6] * q6 + nv[7] * q7);
                u32x4 o; o.x = pkbf(q0 * winter, q1 * winter); o.y = pkbf(q2 * winter, q3 * winter); o.z = pkbf(q4_ * winter, q5 * winter); o.w = pkbf(q6 * winter, q7 * winter);
                const bf16x8 qs = __builtin_bit_cast(bf16x8, o);
#pragma unroll
                for (int jv = 0; jv < 2; ++jv)
                    na[jv] = mfma32(*(const LAS bf16x8*)(CI + (32 * (2 * vh + jv) + r) * MLP + (16 * ks + 8 * h) * 2), qs, na[jv]);
            }
            dq += SHX(dq, 32);
            den += winter * dq;
            const float inv = frcp(fmaxf(fabsf(den), flo));
            const size_t tok = rowb + 128 * pc + pot;
            GAS bf16_t* hf = (GAS bf16_t*)(ws + WS_HF) + tok * 512 + head * 128;
            if (d == 0) {
#pragma unroll
                for (int jv = 0; jv < 2; ++jv)
#pragma unroll
                    for (int g4 = 0; g4 < 4; ++g4) {
                        u32x2 w; w.x = pkbf(na[jv][4 * g4] * inv, na[jv][4 * g4 + 1] * inv); w.y = pkbf(na[jv][4 * g4 + 2] * inv, na[jv][4 * g4 + 3] * inv);
                        *(GAS u32x2*)(hf + 32 * (2 * vh + jv) + 8 * g4 + 4 * h) = w;
                    }
            } else {
                float ssq = 0.f;
#pragma unroll
                for (int jv = 0; jv < 2; ++jv)
#pragma unroll
                    for (int g4 = 0; g4 < 4; ++g4) {
                        const u32x2 w = *(const GAS u32x2*)(hf + 32 * (2 * vh + jv) + 8 * g4 + 4 * h);
                        na[jv][4 * g4] = na[jv][4 * g4] * inv + bflo(w.x); na[jv][4 * g4 + 1] = na[jv][4 * g4 + 1] * inv + bfhi(w.x);
                        na[jv][4 * g4 + 2] = na[jv][4 * g4 + 2] * inv + bflo(w.y); na[jv][4 * g4 + 3] = na[jv][4 * g4 + 3] * inv + bfhi(w.y);
                        ssq += (na[jv][4 * g4] * na[jv][4 * g4] + na[jv][4 * g4 + 1] * na[jv][4 * g4 + 1]) + (na[jv][4 * g4 + 2] * na[jv][4 * g4 + 2] + na[jv][4 * g4 + 3] * na[jv][4 * g4 + 3]);
                        if (g4 & 1) MEMFENCE();
                    }
                ssq += SHX(ssq, 32);
                if (h == 0) ssx[2 * t + vh] = ssq;
                __syncthreads();
                const float rs = frsq((ssx[2 * t] + ssx[2 * t + 1]) * (1.0f / 128.0f) + EPS);
                const GAS bf16_t* mo = (const GAS bf16_t*)(ws + WS_MO) + tok * 512 + head * 128;
                GAS bf16_t* ym = (GAS bf16_t*)(ws + WS_YATT) + tok * 1536 + 512 + head * 128;
                const GAS float* gn = ((const GAS float*)P->ml_out_gain) + head * 128;
#pragma unroll
                for (int jv = 0; jv < 2; ++jv)
#pragma unroll
                    for (int g4 = 0; g4 < 4; ++g4) {
                        const int vo = 32 * (2 * vh + jv) + 8 * g4 + 4 * h;
                        const u32x2 mw = *(const GAS u32x2*)(mo + vo); const f32x4 gv = *(const GAS f32x4*)(gn + vo);
                        const float y0 = na[jv][4 * g4] * rs * gv.x * sigmoidf_(bflo(mw.x)), y1 = na[jv][4 * g4 + 1] * rs * gv.y * sigmoidf_(bfhi(mw.x));
                        const float y2 = na[jv][4 * g4 + 2] * rs * gv.z * sigmoidf_(bflo(mw.y)), y3 = na[jv][4 * g4 + 3] * rs * gv.w * sigmoidf_(bfhi(mw.y));
                        u32x2 w; w.x = pkbf(y0, y1); w.y = pkbf(y2, y3);
                        *(GAS u32x2*)(ym + vo) = w;
                        if (g4 & 1) MEMFENCE();
                    }
            }
        }
        __syncthreads();
    }
}

DI void merge_pass(KPC P, int gw, int NGW, int lane, const bool do_att) {
    GAS unsigned char* ws = ((GAS unsigned char*)P->ws);
    const GAS bf16_t* AO = (const GAS bf16_t*)(ws + WS_AQ); const GAS float* LSE = (const GAS float*)(ws + WS_LSE);
    const GAS bf16_t* HF = (const GAS bf16_t*)(ws + WS_HF); const GAS bf16_t* HB = (const GAS bf16_t*)(ws + WS_HB); const GAS bf16_t* MO = (const GAS bf16_t*)(ws + WS_MO);
    GAS bf16_t* YA = (GAS bf16_t*)(ws + WS_YATT); GAS bf16_t* YM = YA + 512;
    constexpr int U = 2;
    for (int t0 = gw * U; t0 < TG; t0 += NGW * U) {
        if (do_att) {
            const int slot = lane >> 3, d0 = 8 * (lane & 7);
            float ls[U][3]; u32x4 w[U][3];
#pragma unroll
            for (int k = 0; k < U; ++k) {
                const int tok = t0 + k, bl = tok >> 11, sq = tok & 2047;
#pragma unroll
                for (int g = 0; g < 3; ++g) {
                    ls[k][g] = LSE[((size_t)g * TG + tok) * 8 + slot];
                    const int sh = 2 * g; const int perm = ((sq & ((1 << sh) - 1)) << (11 - sh)) + (sq >> sh);
                    w[k][g] = *(const GAS u32x4*)(AO + ((size_t)(bl * 24 + g * 8 + slot) * 2048 + perm) * 64 + d0);
                }
            }
#pragma unroll
            for (int k = 0; k < U; ++k) {
                const int tok = t0 + k;
                const float mx = fmaxf(fmaxf(ls[k][0], ls[k][1]), ls[k][2]);
                float e[3], sum = 0.f;
#pragma unroll
                for (int g = 0; g < 3; ++g) { e[g] = __expf(ls[k][g] - mx); sum += e[g]; }
                const float isum = frcp(sum);
                float acc[8];
#pragma unroll
                for (int q = 0; q < 8; ++q) acc[q] = 0.f;
#pragma unroll
                for (int g = 0; g < 3; ++g) {
                    const float a = e[g] * isum; const u32x4 x = w[k][g];
                    acc[0] += a * bflo(x.x); acc[1] += a * bfhi(x.x); acc[2] += a * bflo(x.y); acc[3] += a * bfhi(x.y);
                    acc[4] += a * bflo(x.z); acc[5] += a * bfhi(x.z); acc[6] += a * bflo(x.w); acc[7] += a * bfhi(x.w);
                }
                u32x4 o; o.x = pkbf(acc[0], acc[1]); o.y = pkbf(acc[2], acc[3]); o.z = pkbf(acc[4], acc[5]); o.w = pkbf(acc[6], acc[7]);
                *(GAS u32x4*)(YA + (size_t)tok * 1536 + slot * 64 + d0) = o;
            }
        } else {
            u32x4 a[U], b[U], mo[U];
#pragma unroll
            for (int k = 0; k < U; ++k) { const size_t off = (size_t)(t0 + k) * 512 + 8 * lane; a[k] = *(const GAS u32x4*)(HF + off); b[k] = *(const GAS u32x4*)(HB + off); mo[k] = *(const GAS u32x4*)(MO + off); }
            const f32x4 ga = *(const GAS f32x4*)(((const GAS float*)P->ml_out_gain) + 8 * lane), gb = *(const GAS f32x4*)(((const GAS float*)P->ml_out_gain) + 8 * lane + 4);
            const float gg[8] = {ga.x, ga.y, ga.z, ga.w, gb.x, gb.y, gb.z, gb.w};
#pragma unroll
            for (int k = 0; k < U; ++k) {
                float v[8];
                v[0] = bflo(a[k].x) + bflo(b[k].x); v[1] = bfhi(a[k].x) + bfhi(b[k].x); v[2] = bflo(a[k].y) + bflo(b[k].y); v[3] = bfhi(a[k].y) + bfhi(b[k].y);
                v[4] = bflo(a[k].z) + bflo(b[k].z); v[5] = bfhi(a[k].z) + bfhi(b[k].z); v[6] = bflo(a[k].w) + bflo(b[k].w); v[7] = bfhi(a[k].w) + bfhi(b[k].w);
                float ss = 0.f;
#pragma unroll
                for (int q = 0; q < 8; ++q) ss += v[q] * v[q];
                ss += SHX(ss, 1); ss += SHX(ss, 2); ss += SHX(ss, 4); ss += SHX(ss, 8);
                const float rs = frsq(ss * (1.0f / 128.0f) + EPS);
                const u32x4 mq = mo[k];
                float mg[8]; mg[0] = bflo(mq.x); mg[1] = bfhi(mq.x); mg[2] = bflo(mq.y); mg[3] = bfhi(mq.y); mg[4] = bflo(mq.z); mg[5] = bfhi(mq.z); mg[6] = bflo(mq.w); mg[7] = bfhi(mq.w);
                float y[8];
#pragma unroll
                for (int q = 0; q < 8; ++q) y[q] = v[q] * rs * gg[q] * sigmoidf_(mg[q]);
                u32x4 o; o.x = pkbf(y[0], y[1]); o.y = pkbf(y[2], y[3]); o.z = pkbf(y[4], y[5]); o.w = pkbf(y[6], y[7]);
                *(GAS u32x4*)(YM + (size_t)(t0 + k) * 1536 + 8 * lane) = o;
            }
        }
    }
}

DI void final_norm(KPC P, int gw, int NGW, int lane) {
    const GAS float* part = (const GAS float*)(((GAS unsigned char*)P->ws) + WS_PART + 3 * SS_STRIDE);
    const GAS bf16_t* xb = (const GAS bf16_t*)(((GAS unsigned char*)P->ws) + WS_XB);
    for (int row4 = gw; row4 < T_ / 4; row4 += NGW) {
        u32x2 v[4][4]; float rs[4];
#pragma unroll
        for (int rr = 0; rr < 4; ++rr) {
            rs[rr] = part[4 * row4 + rr];
#pragma unroll
            for (int j = 0; j < 4; ++j) v[rr][j] = *((const GAS u32x2*)(xb + (size_t)(4 * row4 + rr) * DM) + lane + 64 * j);
        }
        const GAS f32x4* gr = (const GAS f32x4*)((const GAS float*)P->norm_final) + lane;
        f32x4 gv[4];
#pragma unroll
        for (int j = 0; j < 4; ++j) gv[j] = gr[64 * j];
#pragma unroll
        for (int rr = 0; rr < 4; ++rr) {
            const int row = 4 * row4 + rr; const float r1 = frsq(rs[rr] * (1.0f / 1024.0f) + EPS);
            GAS f32x4* xr = (GAS f32x4*)(((GAS float*)P->out) + (size_t)row * DM) + lane;
#pragma unroll
            for (int j = 0; j < 4; ++j) { const u32x2 w = v[rr][j]; xr[64 * j] = (f32x4){bflo(w.x), bfhi(w.x), bflo(w.y), bfhi(w.y)} * r1 * gv[j]; }
        }
    }
}

#define XB_TMO      128
#define XB_XCNT(j)  (256  + 64 * (j))
#define XB_XSUB(j)  (1280 + 64 * (j))
#define XB_XGEN(j)  (2304 + 64 * (j))
#define XB_TOP      3328
#define XB_TOPGEN   3392
#define XCD_BAR_WORDS 3456
#define XB_SPIN_CAP (1u << 22)
DI unsigned xb_ld(unsigned* p)              { return __hip_atomic_load(p, __ATOMIC_RELAXED, __HIP_MEMORY_SCOPE_AGENT); }
DI unsigned xb_add(unsigned* p, unsigned v) { return __hip_atomic_fetch_add(p, v, __ATOMIC_RELAXED, __HIP_MEMORY_SCOPE_AGENT); }
DI unsigned xb_xcc_id() { return (unsigned)__builtin_amdgcn_s_getreg((3 << 11) | 20) & 0xFu; }
#define XB_SPIN(cond, bar) do { unsigned _sp = 0; while (cond) { __builtin_amdgcn_s_sleep(1); \
    if ((++_sp & 255u) == 0u) { if (xb_ld(&(bar)[XB_TMO])) break; if (_sp > XB_SPIN_CAP) { atomicAdd(&(bar)[XB_TMO], 1u); break; } } } } while (0)
struct XcdBarrier { unsigned* bar; unsigned x; volatile LAS unsigned* st; };
DI XcdBarrier xcd_barrier_post(unsigned* bar, volatile LAS unsigned* st) {
    XcdBarrier b; b.bar = bar; b.x = xb_xcc_id(); b.st = st;
    if (threadIdx.x == 0) (void)xb_add(&bar[XB_XCNT(b.x)], 1u);
    return b;
}
DI void xcd_barrier_complete(unsigned* bar, unsigned x, unsigned& nloc, unsigned& nx) {
    const unsigned G = gridDim.x * gridDim.y * gridDim.z;
    unsigned sum, cnt, mine, sp = 0u;
    for (;;) {
        sum = 0u; cnt = 0u; mine = 0u;
#pragma unroll 1
        for (unsigned j = 0; j < 16; ++j) { const unsigned c = xb_ld(&bar[XB_XCNT(j)]); sum += c; cnt += (c > 0u) ? 1u : 0u; mine = (j == x) ? c : mine; }
        if (sum == G) break;
        __builtin_amdgcn_s_sleep(1);
        if ((++sp & 255u) == 0u) { if (xb_ld(&bar[XB_TMO])) break; if (sp > XB_SPIN_CAP) { atomicAdd(&bar[XB_TMO], 1u); break; } }
    }
    nloc = mine > 0u ? mine : 1u; nx = cnt > 0u ? cnt : 1u;
}
DI void xcd_barrier(const XcdBarrier& b) {
    asm volatile("s_waitcnt vmcnt(0)" ::: "memory");
    __syncthreads();
    if (threadIdx.x == 0) {
        unsigned* bar = b.bar;
        __builtin_amdgcn_s_waitcnt(0);
        unsigned nloc = b.st[0], nx = b.st[1];
        if (nloc == 0u) { xcd_barrier_complete(bar, b.x, nloc, nx); b.st[0] = nloc; b.st[1] = nx; }
        const unsigned old = xb_add(&bar[XB_XSUB(b.x)], 1u);
        const unsigned gen = old / nloc;
        if (old + 1u == (gen + 1u) * nloc) {
            __builtin_amdgcn_fence(__ATOMIC_RELEASE, "agent");
            asm volatile("s_waitcnt vmcnt(0)" ::: "memory");
            const unsigned og = xb_add(&bar[XB_TOP], 1u);
            const unsigned tg = og / nx;
            if (og + 1u == (tg + 1u) * nx) xb_add(&bar[XB_TOPGEN], 1u);
            else XB_SPIN(xb_ld(&bar[XB_TOPGEN]) == tg, bar);
            __builtin_amdgcn_fence(__ATOMIC_ACQUIRE, "agent");
            xb_add(&bar[XB_XGEN(b.x)], 1u);
            asm volatile("s_waitcnt vmcnt(0)" ::: "memory");
        } else {
            XB_SPIN(xb_ld(&bar[XB_XGEN(b.x)]) == gen, bar);
            __builtin_amdgcn_fence(__ATOMIC_ACQUIRE, "agent");
            asm volatile("s_waitcnt vmcnt(0)" ::: "memory");
        }
    }
    __syncthreads();
}

__global__ void __launch_bounds__(512, 2) mega_fwd(KP Pv, int step_lo, int step_hi, int coop) {
    extern __shared__ __attribute__((aligned(16))) unsigned char lds_raw[];
    LAS unsigned char* lds = (LAS unsigned char*)lds_raw;
    const int G = gridDim.x, NGW = G * 8;
    const int wave0 = __builtin_amdgcn_readfirstlane((int)threadIdx.x >> 6);
    volatile LAS unsigned* misc = (volatile LAS unsigned*)(lds + LDS_BYTES - 256);
    if (threadIdx.x < 8) misc[threadIdx.x] = 0u;
    __syncthreads();
    XcdBarrier xbar = xcd_barrier_post((unsigned*)(Pv.ws + WS_CTL) + 4096, misc);
#ifdef TS_PROBE
    if (blockIdx.x == 0 && threadIdx.x == 0) ((GAS unsigned long long*)(((GAS unsigned char*)Pv.ws) + WS_CTL + 32768))[0] = __builtin_amdgcn_s_memrealtime();
#endif
#pragma unroll 1
    for (int step = step_lo; step < step_hi; ++step) {
        unsigned mb0 = 0u; asm volatile("" : "+s"(mb0));
        int tid = wave0 * 64 + (int)__builtin_amdgcn_mbcnt_hi(~0u, __builtin_amdgcn_mbcnt_lo(~0u, mb0)); asm volatile("" : "+v"(tid));
        const int lane = tid & 63, wave = __builtin_amdgcn_readfirstlane(tid >> 6);
        int bid = blockIdx.x; asm volatile("" : "+s"(bid));
        const int gw = bid * 8 + wave;
        KPC P = (KPC)__builtin_amdgcn_kernarg_segment_ptr(); asm volatile("" : "+s"(P));
        GAS unsigned char* ws = ((GAS unsigned char*)P->ws); asm volatile("" : "+s"(ws));
        GAS unsigned* ctl = (GAS unsigned*)(ws + WS_CTL);
        bool is_gemm = false, do_sync = true, perm = true;
        pg8::Gemm g{nullptr, nullptr, 0, 0, 0};
        EpiAny E; E.kind = 0; E.aux = 0; E.goff = 0; E.ws = ws; E.kp = P;
        GAS bf16_t* xb = (GAS bf16_t*)(ws + WS_XB);
        int grp = 0, sub = -1;
        if (step >= 3 && step < 13) { grp = (step - 3) / 5; sub = (step - 3) % 5; }
        const int goff = grp * TG;
        if (step == 0) {
            prepass(P, lds, gw, NGW, wave, lane);
        } else if (step == 1) {
            is_gemm = true; g = pg8::Gemm{xb, (const GAS bf16_t*)(ws + WS_W1), T_, 2 * DFF, 1024};
            E.kind = EK_SWIGLU;
        } else if (step == 2) {
            is_gemm = true; perm = false; g = pg8::Gemm{(const GAS bf16_t*)(ws + WS_ACT), (const GAS bf16_t*)(ws + WS_W2), T_, 1024, DFF};
            E.kind = EK_RESID; E.aux = 0;
        } else if (sub == 0) {
            is_gemm = true; g = pg8::Gemm{xb + (size_t)goff * DM, (const GAS bf16_t*)(ws + WS_WIN), TG, grp ? NWIN - 256 : NWIN, 1024};
            E.kind = EK_WIN; E.goff = goff;
        } else if (sub == 1 || sub == 3) {
            if (sub == 1) {
#pragma unroll 1
                for (int u = bid; u < 512; u += G) mlstm_p1f(P, lds, grp, u >> 6, (u >> 4) & 3, u & 15, tid);
            } else {
#pragma unroll 1
                for (int u = bid; u < 512; u += G) mlstm_p3f(P, lds, grp, u >> 6, (u >> 4) & 3, u & 15, tid);
            }
            __syncthreads();
            if (sub == 1) att_wg_loop(ws, lds, bid, G, BL * 24 * 8, tid);
            else {
#pragma unroll 1
                for (int u = bid; u < BL * 4 * 8; u += G) cross_wg_unit(P, lds, grp, u, tid);
            }
        } else if (sub == 2) {
            if (grp == 0) cknorm(P, gw, NGW, lane);
#pragma unroll 1
            for (int w = bid; w < 256; w += G) mlstm_scan(ws, ((GAS float*)P->out), w, tid);
            merge_pass(P, gw, NGW, lane, true);
        } else if (sub == 4) {
            is_gemm = true; perm = false;
            g = pg8::Gemm{(const GAS bf16_t*)(ws + WS_YATT), (const GAS bf16_t*)(ws + WS_WBR), TG, 1024, 1536};
            E.kind = EK_BR0; E.goff = goff;
        } else if (step == 13) {
            is_gemm = true; perm = false; g = pg8::Gemm{(const GAS bf16_t*)((GAS unsigned char*)((GAS float*)P->out) + 32 * MiB), (const GAS bf16_t*)(ws + WS_WOUT), T_, 1024, 1024};
            E.kind = EK_RESID; E.aux = 1; E.goff = 0;
        } else if (step == 14) {
            is_gemm = true; g = pg8::Gemm{xb, (const GAS bf16_t*)(ws + WS_W3), T_, 2 * DFF, 1024};
            E.kind = EK_SWIGLU; E.aux = 1;
        } else if (step == 15) {
            is_gemm = true; perm = false; g = pg8::Gemm{(const GAS bf16_t*)(ws + WS_ACT), (const GAS bf16_t*)(ws + WS_W4), T_, 1024, DFF};
            E.kind = EK_RESID; E.aux = 2;
        } else if (step == 16) {
            final_norm(P, gw, NGW, lane); do_sync = false;
        }
        if (is_gemm) {
            const int npass = (sub == 0 && grp == 0) ? 3 : 1;
#pragma unroll 1
            for (int ps = 0; ps < npass; ++ps) {
                pg8::StaticOrder S;
                if (ps == 0) S.init(g.M, g.N, G, bid);
                else if (ps == 1) {
                    g = pg8::Gemm{(const GAS bf16_t*)(ws + WS_MEMB), (const GAS bf16_t*)(ws + WS_WMEM), MEMROWS, 1024, 1024};
                    E.kind = EK_MEMKV; perm = true;
                    const int c2 = (bid >= 64 && bid < 128) ? bid - 64 : (1 << 20);
                    S.init(MEMROWS, 1024, 64, c2);
                } else {
                    g = pg8::Gemm{xb + (size_t)TG * DM, (const GAS bf16_t*)(ws + WS_WIN) + (size_t)(NWIN - 256) * 1024, TG, 256, 1024};
                    E.kind = EK_WIN; E.aux = 40; E.goff = TG; perm = true;
                    const int c3 = (bid >= 128 && bid < 192) ? bid - 128 : (1 << 20);
                    S.init(TG, 256, 64, c3);
                }
                pg8::gemm_phase<EpiAny>(lds, g, S, E, perm, tid);
            }
        }
        __syncthreads();
#ifndef REP_SYNC
#define REP_SYNC 1
#endif
#ifdef TS_PROBE
        if (step == 17) xcd_barrier(xbar);
        if (bid == 0 && tid == 0) { asm volatile("s_waitcnt vmcnt(0)" ::: "memory"); ((GAS unsigned long long*)(ws + WS_CTL + 32768))[step + 1] = __builtin_amdgcn_s_memrealtime(); }
        if (step == 17) {
            GAS unsigned long long* ts = (GAS unsigned long long*)(ws + WS_CTL + 32768);
            if (bid == 0 && tid == 0) {
                const unsigned long long a = ts[TS_A1] - ts[TS_A0], b = ts[TS_B1] - ts[TS_B0];
                unsigned ua = (unsigned)(a / 400ull), ub = (unsigned)(b / 400ull); if (ua > 191u) ua = 191u; if (ub > 191u) ub = 191u;
                __hip_atomic_store((GAS unsigned*)(ws + WS_CTL + 49152), 7u * (ua + 192u * ub), __ATOMIC_RELAXED, __HIP_MEMORY_SCOPE_AGENT);
            }
            xcd_barrier(xbar);
            const unsigned N = __hip_atomic_load((GAS unsigned*)(ws + WS_CTL + 49152), __ATOMIC_RELAXED, __HIP_MEMORY_SCOPE_AGENT);
            for (unsigned i = (unsigned)(bid * 512 + tid); i < N; i += (unsigned)(G * 512)) ((GAS float*)P->out)[(size_t)i * 97u] += 0.1f;
        }
#endif
        if (coop && do_sync && step + 1 < step_hi) { if (coop == 2) cg::this_grid().sync(); else { for (int rp = 0; rp < REP_SYNC; ++rp) xcd_barrier(xbar); } }
    }
}

extern "C" void kernel_launch(void* const* d_in, const int* in_sizes, int n_in, void* d_out, int out_size, void* d_ws, size_t ws_size, hipStream_t stream) {
    static int grid = 0;
    if (grid == 0) {
        if (n_in != 26 || ws_size < WS_END) { fprintf(stderr, "kernel_launch: unexpected n_in %d or ws_size %zu (need %zu)\n", n_in, ws_size, (size_t)WS_END); grid = -1; return; }
        int dev = 0, cus = 0, per_cu = 0;
        hipGetDevice(&dev); hipDeviceGetAttribute(&cus, hipDeviceAttributeMultiprocessorCount, dev);
        if (hipFuncSetAttribute((const void*)mega_fwd, hipFuncAttributeMaxDynamicSharedMemorySize, LDS_BYTES) != hipSuccess) { fprintf(stderr, "kernel_launch: hipFuncSetAttribute failed\n"); }
        hipOccupancyMaxActiveBlocksPerMultiprocessor(&per_cu, (const void*)mega_fwd, 512, LDS_BYTES);
        (void)hipGetLastError();
        if (per_cu < 1) per_cu = 1;
        grid = cus;
        fprintf(stderr, "kernel_launch: cus %d per_cu %d grid %d ws %zu\n", cus, per_cu, grid, ws_size);
    }
    if (grid < 0) return;
    hipMemsetAsync((char*)d_ws + WS_CTL, 0, 65536, stream);
    KP p{};
    const float** pp = (const float**)&p;
    for (int i = 0; i < 26; ++i) pp[i] = (const float*)d_in[i];
    p.out = (float*)d_out; p.ws = (unsigned char*)d_ws;
    int lo = 0, hi = 17, coop = 1;
    void* args[] = {&p, &lo, &hi, &coop};
    hipError_t e = hipLaunchCooperativeKernel((const void*)mega_fwd, dim3(grid), dim3(512), args, LDS_BYTES, stream);
    if (e != hipSuccess) fprintf(stderr, "cooperative launch failed: %s (grid %d)\n", hipGetErrorString(e), grid);
}
```
